# Optimizing an MI355X kernel written in HIP

```python
import jax
import jax.numpy as jnp
from jax import lax
import numpy as np

D_MODEL = 1024
BATCH = 8
SEQ = 2048
DEPTH = 2

HEAD_DIM = 64
A_GROUPS = 4
A_GROUP_CH = 128
A_WIDTH = A_GROUPS * A_GROUP_CH
CHUNK = 128
DILATED_PATTERNS = ((128, 1), (512, 4), (2048, 16))
B_HEADS_PER_GROUP = 4
B_HEADS = len(DILATED_PATTERNS) * B_HEADS_PER_GROUP
B_WIDTH = B_HEADS * HEAD_DIM
B_OUT = B_HEADS_PER_GROUP * HEAD_DIM
BLOCK = 128
ROPE_THETA = 500000.0
ROPE_DIMS = HEAD_DIM // 4
C_HEADS = 8
C_WIDTH = C_HEADS * HEAD_DIM
W_LORA = 64
A_LORA = 64
V_LORA = 32
G_LORA = 128
RWKV_GN_EPS = HEAD_DIM * 1e-5
IN_SPLIT_WIDTHS = (A_WIDTH, A_WIDTH, B_WIDTH, B_WIDTH, B_WIDTH, C_WIDTH, C_WIDTH, C_WIDTH)
IN_COLS = 2 * A_WIDTH + 3 * B_WIDTH + 3 * C_WIDTH
N_BRANCHES = 3
N_GROUPS = 4
EXPERTS_PER_GROUP = 4
N_EXPERTS = N_GROUPS * EXPERTS_PER_GROUP
EXPERT_FF = 512
TOP_K_IN_GROUP = 2
RMS_EPS = 1e-6
LN_EPS = 1e-5

kernel_name = 'hybrid_gated_mixers_hier_moe'


def rmsnorm(x, g):
    xf = x.astype(jnp.float32)
    y = xf * lax.rsqrt(jnp.mean(xf * xf, axis=-1, keepdims=True) + RMS_EPS)
    return (y * g.astype(jnp.float32)).astype(x.dtype)


def shift_prev(t):
    return jnp.pad(t, ((0, 0), (1, 0), (0, 0)))[:, :-1]


def split_heads(t, n_heads):
    return t.reshape(t.shape[:-1] + (n_heads, HEAD_DIM))


def partial_rotary(t, positions):
    half = ROPE_DIMS // 2
    inv_freq = ROPE_THETA ** (-jnp.arange(half, dtype=jnp.float32) / half)
    ang = positions.astype(jnp.float32)[..., None] * inv_freq
    cos = jnp.cos(ang)[:, :, None, :]
    sin = jnp.sin(ang)[:, :, None, :]
    tr = t[..., :ROPE_DIMS].astype(jnp.float32)
    t1, t2 = tr[..., :half], tr[..., half:]
    rot = jnp.concatenate([t1 * cos - t2 * sin, t2 * cos + t1 * sin], axis=-1).astype(t.dtype)
    return jnp.concatenate([rot, t[..., ROPE_DIMS:]], axis=-1)


def chunked_spatial_gating(u, v, ln_g, ln_b, w_s, b_s):
    Bn, S, _ = u.shape
    vf = v.astype(jnp.float32)
    mu = jnp.mean(vf, axis=-1, keepdims=True)
    var = jnp.mean(jnp.square(vf - mu), axis=-1, keepdims=True)
    vn = ((vf - mu) * lax.rsqrt(var + LN_EPS) * ln_g + ln_b).astype(v.dtype)
    vn = vn.reshape(Bn, S // CHUNK, CHUNK, A_GROUPS, A_GROUP_CH)
    causal = jnp.tril(jnp.ones((CHUNK, CHUNK), dtype=bool))
    w_causal = jnp.where(causal[None], w_s, jnp.zeros_like(w_s))
    mixed = jnp.einsum('gts,bnsgc->bntgc', w_causal, vn) + b_s.T[:, :, None]
    return u * mixed.reshape(Bn, S, A_WIDTH)


def dilated_window_attention(q, k, v, window, dilation):
    Bn, S, H, Dh = q.shape
    L = S // dilation
    nb = -(-L // BLOCK)
    Lp = nb * BLOCK
    steps = window // dilation

    def to_blocks(t):
        t = t.reshape(Bn, L, dilation, H, Dh).transpose(0, 2, 1, 3, 4)
        t = jnp.pad(t, ((0, 0), (0, 0), (0, Lp - L), (0, 0), (0, 0)))
        return t.reshape(Bn, dilation, nb, BLOCK, H, Dh)

    def with_prev(t):
        prev = jnp.pad(t, ((0, 0), (0, 0), (1, 0), (0, 0), (0, 0), (0, 0)))[:, :, :-1]
        return jnp.concatenate([prev, t], axis=3)

    qb = to_blocks(q)
    kw = with_prev(to_blocks(k))
    vw = with_prev(to_blocks(v))
    scores = jnp.einsum('brnqhd,brnkhd->brnhqk', qb, kw,
                        preferred_element_type=jnp.float32) * (Dh ** -0.5)
    qi = jnp.arange(BLOCK)[:, None]
    kj = jnp.arange(2 * BLOCK)[None, :]
    dist = BLOCK + qi - kj
    in_band = (dist >= 0) & (dist <= steps)
    has_key = (jnp.arange(nb) > 0)[:, None, None] | (kj >= BLOCK)[None]
    valid = in_band[None] & has_key
    scores = jnp.where(valid[None, None, :, None], scores, -jnp.inf)
    lse = jax.nn.logsumexp(scores, axis=-1)
    p = jnp.exp(scores - lse[..., None]).astype(v.dtype)
    out = jnp.einsum('brnhqk,brnkhd->brnqhd', p, vw)

    def from_blocks(t):
        tail = t.shape[4:]
        t = t.reshape((Bn, dilation, Lp) + tail)[:, :, :L]
        return jnp.swapaxes(t, 1, 2).reshape((Bn, S) + tail)

    return from_blocks(out), from_blocks(jnp.swapaxes(lse, -1, -2))


def dilated_attention_branch(q, k, v, positions):
    Bn, S = q.shape[:2]
    q = partial_rotary(q, positions)
    k = partial_rotary(k, positions)
    outs, lses = [], []
    for g, (window, dilation) in enumerate(DILATED_PATTERNS):
        hs = slice(g * B_HEADS_PER_GROUP, (g + 1) * B_HEADS_PER_GROUP)
        o, l = dilated_window_attention(q[:, :, hs], k[:, :, hs], v[:, :, hs], window, dilation)
        outs.append(o)
        lses.append(l)
    weights = jax.nn.softmax(jnp.stack(lses, axis=0), axis=0)
    out = jnp.sum(weights[..., None] * jnp.stack(outs, axis=0).astype(jnp.float32), axis=0)
    return out.reshape(Bn, S, B_OUT).astype(q.dtype)


def rwkv7_time_mix(h, r, k, v, v_first, mu_rkv, mu_wag, w0, w1, w2, a0, a1, a2, g1, g2,
                   k_k, k_a, r_k, ln_w, ln_b, vres):
    Bn, S, _ = h.shape
    f32 = jnp.float32
    r = r + (shift_prev(r) - r) * mu_rkv[0]
    k = k + (shift_prev(k) - k) * mu_rkv[1]
    v = v + (shift_prev(v) - v) * mu_rkv[2]
    dh = shift_prev(h) - h
    xw = h + dh * mu_wag[0]
    xa = h + dh * mu_wag[1]
    xg = h + dh * mu_wag[2]
    w_log = -jax.nn.softplus(-(w0 + jnp.tanh(xw @ w1) @ w2).astype(f32)) - 0.5
    decay = jnp.exp(-jnp.exp(w_log))
    a = jax.nn.sigmoid(a0 + (xa @ a1) @ a2)
    g = jax.nn.sigmoid(xg @ g1) @ g2
    if vres is not None:
        mu_v, v0, v1, v2 = vres
        xv = h + dh * mu_v
        v = v + (v_first - v) * jax.nn.sigmoid(v0 + (xv @ v1) @ v2)
    kk = split_heads(k * k_k, C_HEADS).astype(f32)
    kk = kk / jnp.maximum(jnp.sqrt(jnp.sum(kk * kk, axis=-1, keepdims=True)), 1e-12)
    k = k * (1 + (a - 1) * k_a)
    rh = split_heads(r, C_HEADS).astype(f32)
    kh = split_heads(k, C_HEADS).astype(f32)
    vh = split_heads(v, C_HEADS).astype(f32)
    ah = split_heads(a, C_HEADS).astype(f32)
    wh = split_heads(decay, C_HEADS)

    def step(state, inp):
        r_t, w_t, k_t, v_t, kk_t, a_t = inp
        sa = jnp.einsum('bhvk,bhk->bhv', state, -kk_t)
        state = (state * w_t[:, :, None, :] + sa[..., None] * (kk_t * a_t)[:, :, None, :]
                 + v_t[..., None] * k_t[:, :, None, :])
        return state, jnp.einsum('bhvk,bhk->bhv', state, r_t)

    xs = tuple(jnp.moveaxis(t, 1, 0) for t in (rh, wh, kh, vh, kk, ah))
    state0 = jnp.zeros((Bn, C_HEADS, HEAD_DIM, HEAD_DIM), f32)
    _, y = lax.scan(step, state0, xs)
    y = jnp.moveaxis(y, 0, 1)
    mu = jnp.mean(y, axis=-1, keepdims=True)
    var = jnp.mean(jnp.square(y - mu), axis=-1, keepdims=True)
    y = (y - mu) * lax.rsqrt(var + RWKV_GN_EPS)
    y = y * split_heads(ln_w, C_HEADS).astype(f32) + split_heads(ln_b, C_HEADS).astype(f32)
    bonus = jnp.sum(rh * kh * r_k.astype(f32), axis=-1, keepdims=True) * vh
    y = (y + bonus).reshape(Bn, S, C_WIDTH).astype(h.dtype)
    return y * g, v


def hierarchical_moe(x, wg, bg, we, be, w_gate, w_up, w_down):
    Bn, S, D = x.shape
    xt = x.reshape(Bn * S, D)
    group_prob = jax.nn.softmax((xt @ wg + bg).astype(jnp.float32), axis=-1)
    gp, gi = lax.top_k(group_prob, 1)
    expert_logits = (xt @ we + be).astype(jnp.float32).reshape(-1, N_GROUPS, EXPERTS_PER_GROUP)
    sel_logits = jnp.take_along_axis(expert_logits, gi[:, :, None], axis=1)[:, 0]
    ep, ei = lax.top_k(jax.nn.softmax(sel_logits, axis=-1), TOP_K_IN_GROUP)
    ep = ep / jnp.sum(ep, axis=-1, keepdims=True)
    in_group = jnp.sum(jax.nn.one_hot(ei, EXPERTS_PER_GROUP) * ep[..., None], axis=1)
    combine = jax.nn.one_hot(gi[:, 0], N_GROUPS)[:, :, None] * (gp * in_group)[:, None, :]
    combine = combine.reshape(-1, N_EXPERTS).astype(x.dtype)
    out = jnp.zeros_like(xt)
    for g in range(N_GROUPS):
        es = slice(g * EXPERTS_PER_GROUP, (g + 1) * EXPERTS_PER_GROUP)
        hid = (jax.nn.silu(jnp.einsum('nd,edf->nef', xt, w_gate[es]))
               * jnp.einsum('nd,edf->nef', xt, w_up[es]))
        out = out + jnp.einsum('nef,efd->nd', hid * combine[:, es, None], w_down[es])
    return out.reshape(Bn, S, D)


def setup_inputs(seed: int = 0) -> dict:
    key = jax.random.key(seed)
    ks = iter(jax.random.split(key, 48))
    f32 = jnp.float32
    D = D_MODEL
    L = DEPTH

    def normal(shape, scale):
        return jax.random.normal(next(ks), shape, f32) * scale

    def uniform(shape, lo, hi):
        return jax.random.uniform(next(ks), shape, f32, lo, hi)

    x = normal((BATCH, SEQ, D), 1.0)
    start = jax.random.randint(next(ks), (BATCH, 1), 0, 4096, dtype=jnp.int32)
    positions = start + jnp.arange(SEQ, dtype=jnp.int32)[None, :]
    return {
        'x': x,
        'positions': positions,
        'norm_mix_g': 1.0 + normal((L, D), 0.01),
        'w_in': normal((L, D, IN_COLS), D ** -0.5),
        'gmlp_ln_g': 1.0 + normal((L, A_WIDTH), 0.01),
        'gmlp_ln_b': normal((L, A_WIDTH), 0.01),
        'gmlp_ws': normal((L, A_GROUPS, CHUNK, CHUNK), CHUNK ** -0.5),
        'gmlp_bs': 1.0 + normal((L, A_GROUPS, CHUNK), 0.01),
        'rwkv_mu_rkv': uniform((L, 3, C_WIDTH), 0.0, 1.0),
        'rwkv_mu_wag': uniform((L, 3, D), 0.0, 1.0),
        'rwkv_w0': uniform((L, C_WIDTH), -4.0, 1.0),
        'rwkv_w1': normal((L, D, W_LORA), D ** -0.5),
        'rwkv_w2': normal((L, W_LORA, C_WIDTH), 0.1 * W_LORA ** -0.5),
        'rwkv_a0': normal((L, C_WIDTH), 0.5),
        'rwkv_a1': normal((L, D, A_LORA), D ** -0.5),
        'rwkv_a2': normal((L, A_LORA, C_WIDTH), 0.5 * A_LORA ** -0.5),
        'rwkv_g1': normal((L, D, G_LORA), D ** -0.5),
        'rwkv_g2': normal((L, G_LORA, C_WIDTH), G_LORA ** -0.5),
        'rwkv_k_k': 0.85 + normal((L, C_WIDTH), 0.05),
        'rwkv_k_a': 1.0 + normal((L, C_WIDTH), 0.05),
        'rwkv_r_k': normal((L, C_HEADS, HEAD_DIM), 0.1),
        'rwkv_ln_w': 1.0 + normal((L, C_WIDTH), 0.01),
        'rwkv_ln_b': normal((L, C_WIDTH), 0.01),
        'rwkv_mu_v': uniform((L - 1, D), 0.0, 1.0),
        'rwkv_v0': normal((L - 1, C_WIDTH), 0.5),
        'rwkv_v1': normal((L - 1, D, V_LORA), D ** -0.5),
        'rwkv_v2': normal((L - 1, V_LORA, C_WIDTH), 0.5 * V_LORA ** -0.5),
        'w_branch_a': normal((L, A_WIDTH, D), A_WIDTH ** -0.5),
        'w_branch_b': normal((L, B_OUT, D), B_OUT ** -0.5),
        'w_branch_c': normal((L, C_WIDTH, D), C_WIDTH ** -0.5),
        'w_gate': normal((L, D, N_BRANCHES * D), D ** -0.5),
        'b_gate': normal((L, N_BRANCHES * D), 0.01),
        'w_out': normal((L, D, D), D ** -0.5),
        'norm_ffn_g': 1.0 + normal((L, D), 0.01),
        'router_group_w': normal((L, D, N_GROUPS), D ** -0.5),
        'router_group_b': normal((L, N_GROUPS), 0.01),
        'router_expert_w': normal((L, D, N_EXPERTS), D ** -0.5),
        'router_expert_b': normal((L, N_EXPERTS), 0.01),
        'expert_w_gate': normal((L, N_EXPERTS, D, EXPERT_FF), D ** -0.5),
        'expert_w_up': normal((L, N_EXPERTS, D, EXPERT_FF), D ** -0.5),
        'expert_w_down': normal((L, N_EXPERTS, EXPERT_FF, D), EXPERT_FF ** -0.5),
        'final_norm_g': 1.0 + normal((D,), 0.01),
    }


def reference(x, positions, norm_mix_g, w_in, gmlp_ln_g, gmlp_ln_b, gmlp_ws, gmlp_bs,
              rwkv_mu_rkv, rwkv_mu_wag, rwkv_w0, rwkv_w1, rwkv_w2, rwkv_a0, rwkv_a1, rwkv_a2,
              rwkv_g1, rwkv_g2, rwkv_k_k, rwkv_k_a, rwkv_r_k, rwkv_ln_w, rwkv_ln_b,
              rwkv_mu_v, rwkv_v0, rwkv_v1, rwkv_v2, w_branch_a, w_branch_b, w_branch_c,
              w_gate, b_gate, w_out, norm_ffn_g, router_group_w, router_group_b,
              router_expert_w, router_expert_b, expert_w_gate, expert_w_up, expert_w_down,
              final_norm_g):
    Bn, S, D = x.shape
    split_at = np.cumsum(IN_SPLIT_WIDTHS)[:-1].tolist()
    v_first = None
    for l in range(DEPTH):
        h = rmsnorm(x, norm_mix_g[l])
        proj = h @ w_in[l]
        u_a, v_a, q_b, k_b, v_b, r_c, k_c, v_c = jnp.split(proj, split_at, axis=-1)
        y_a = chunked_spatial_gating(jax.nn.gelu(u_a), jax.nn.gelu(v_a), gmlp_ln_g[l],
                                     gmlp_ln_b[l], gmlp_ws[l], gmlp_bs[l])
        y_b = dilated_attention_branch(split_heads(q_b, B_HEADS), split_heads(k_b, B_HEADS),
                                       split_heads(v_b, B_HEADS), positions)
        vres = None if l == 0 else (rwkv_mu_v[l - 1], rwkv_v0[l - 1], rwkv_v1[l - 1], rwkv_v2[l - 1])
        y_c, v_c = rwkv7_time_mix(h, r_c, k_c, v_c, v_first, rwkv_mu_rkv[l], rwkv_mu_wag[l],
                                  rwkv_w0[l], rwkv_w1[l], rwkv_w2[l], rwkv_a0[l], rwkv_a1[l],
                                  rwkv_a2[l], rwkv_g1[l], rwkv_g2[l], rwkv_k_k[l], rwkv_k_a[l],
                                  rwkv_r_k[l], rwkv_ln_w[l], rwkv_ln_b[l], vres)
        if l == 0:
            v_first = v_c
        gates = jax.nn.sigmoid(h @ w_gate[l] + b_gate[l]).reshape(Bn, S, N_BRANCHES, D)
        merged = (gates[:, :, 0] * (y_a @ w_branch_a[l])
                  + gates[:, :, 1] * (y_b @ w_branch_b[l])
                  + gates[:, :, 2] * (y_c @ w_branch_c[l]))
        x = x + merged @ w_out[l]
        x = x + hierarchical_moe(rmsnorm(x, norm_ffn_g[l]), router_group_w[l], router_group_b[l],
                                 router_expert_w[l], router_expert_b[l], expert_w_gate[l],
                                 expert_w_up[l], expert_w_down[l])
    return rmsnorm(x, final_norm_g)
```

```cpp
#include <hip/hip_runtime.h>
#include <hip/hip_cooperative_groups.h>
#include <stdint.h>
#include <cstdio>

#ifndef MK_FUSED
#define MK_FUSED 0
#endif

typedef short bf16x8 __attribute__((ext_vector_type(8)));
typedef short bf16x4 __attribute__((ext_vector_type(4)));
typedef float f32x4 __attribute__((ext_vector_type(4)));
typedef __bf16 bf2_t __attribute__((ext_vector_type(2)));
typedef short v4i16_t __attribute__((ext_vector_type(4)));
typedef _Float16 h2_t __attribute__((ext_vector_type(2)));
typedef unsigned short u16;
#define LAS __attribute__((address_space(3)))

constexpr int NTOK = 16384, DM = 1024, SEQ = 2048;
constexpr int NPH = 24;
constexpr int LDS_BYTES = 66 * 1024;

constexpr size_t OFF_CTRL = 0;
constexpr size_t OFF_ROT  = 65536;
constexpr size_t OFF_WNE  = OFF_ROT + 2 * (size_t)NTOK * 8 * 4;
constexpr size_t WNE_WTC = 0, WNE_WTAB = 4456448, WNE_WGATE = 11272192, WNE_WBRA = 17563648, WNE_WBRB = 18612224,
                 WNE_WBRC = 19136512, WNE_WOUT = 20185088, WNE_W2T = 22282240, WNE_A2T = 22347776, WNE_G2T = 22413312,
                 WNE_V2T = 22544384, WNE_WR = 22577152, WNE_SZ = 22839296;
constexpr size_t OFF_H    = OFF_WNE + 2 * WNE_SZ;
constexpr size_t OFF_V    = OFF_H + (size_t)NTOK * 1024 * 2;
constexpr size_t OFF_KR   = OFF_V + 2 * (size_t)NTOK * 512 * 2;
constexpr size_t OFF_BK   = OFF_KR + (size_t)NTOK * 2048;
constexpr size_t OFF_W    = OFF_BK + (size_t)NTOK * 2048;
constexpr size_t OFF_G    = OFF_W + (size_t)NTOK * 1024;
constexpr size_t OFF_YRAW = OFF_G + (size_t)NTOK * 1024;
constexpr size_t OFF_BONUS= OFF_YRAW + (size_t)NTOK * 1024;
constexpr size_t OFF_LSE  = OFF_BONUS + (size_t)NTOK * 32;
constexpr size_t OFF_R    = OFF_LSE + (size_t)3 * NTOK * 16;
constexpr size_t R_PROJA = 0;
constexpr size_t R_PROJB = (size_t)NTOK * 2048;
constexpr size_t R_PROJC = 0;
constexpr size_t R_LORA1 = (size_t)NTOK * 3072;
constexpr size_t R_WEXP  = 0;
constexpr size_t R_HID   = 50331648;
constexpr size_t R_SZ    = (size_t)NTOK * (2048 + 4608);
constexpr size_t OFF_END  = OFF_R + R_SZ;
constexpr size_t OFF_MERGED = OFF_KR;
constexpr size_t OFF_PERM = OFF_BK;
constexpr size_t OFF_CW   = OFF_BK + (size_t)24 * 16384 * 4;
static_assert(OFF_END <= 356000000, "workspace too large");
static_assert(R_HID + (size_t)19456 * 2048 <= R_SZ, "R region");
constexpr int CT_CNT = 8192;

struct Params {
    const void* in[42];
    float* out;
    char* ws;
    int pad0, pad1;
};

typedef float f2_t __attribute__((ext_vector_type(2)));
__device__ __forceinline__ unsigned pk_bf16(float lo, float hi) { f2_t f; f[0] = lo; f[1] = hi; return __builtin_bit_cast(unsigned, __builtin_convertvector(f, bf2_t)); }
__device__ __forceinline__ float bflo(unsigned u) { return __uint_as_float(u << 16); }
__device__ __forceinline__ float bfhi(unsigned u) { return __uint_as_float(u & 0xffff0000u); }
__device__ __forceinline__ float bf2f(u16 h) { return __uint_as_float(((unsigned)h) << 16); }
__device__ __forceinline__ u16 f2bf(float f) { return (u16)(pk_bf16(f, 0.f) & 0xffffu); }
__device__ __forceinline__ uint2 pk4(f32x4 v) { return make_uint2(pk_bf16(v[0], v[1]), pk_bf16(v[2], v[3])); }
__device__ __forceinline__ f32x4 unpk4(uint2 u) { f32x4 r; r[0] = bflo(u.x); r[1] = bfhi(u.x); r[2] = bflo(u.y); r[3] = bfhi(u.y); return r; }
__device__ __forceinline__ float sigmoidf_(float x) { return 1.f / (1.f + __expf(-x)); }
__device__ __forceinline__ float gelu_tanh(float x) { const float z = 0.7978845608028654f * (x + 0.044715f * x * x * x); return x / (1.f + __expf(-2.f * z)); }
__device__ __forceinline__ float dot2bf(unsigned a, unsigned b, float c) { return __builtin_amdgcn_fdot2_f32_bf16(__builtin_bit_cast(bf2_t, a), __builtin_bit_cast(bf2_t, b), c, false); }
template <int CTRL> __device__ __forceinline__ float dpp_f(float x) { return __builtin_bit_cast(float, __builtin_amdgcn_update_dpp(0, __builtin_bit_cast(int, x), CTRL, 0xf, 0xf, false)); }
__device__ __forceinline__ float rowsum16(float x) { x += dpp_f<0x128>(x); x += dpp_f<0x124>(x); x += dpp_f<0x122>(x); x += dpp_f<0x121>(x); return x; }
__device__ __forceinline__ float wavesum(float x) { x += __shfl_xor(x, 32); x += __shfl_xor(x, 16); x += __shfl_xor(x, 8); x += __shfl_xor(x, 4); x += __shfl_xor(x, 2); x += __shfl_xor(x, 1); return x; }
__device__ __forceinline__ bf16x8 mk8(uint4 u) { return __builtin_bit_cast(bf16x8, u); }
#define MFMA16(a, b, c) __builtin_amdgcn_mfma_f32_16x16x32_bf16(a, b, c, 0, 0, 0)

#define XB_TMO      128
#define XB_XCNT(j)  (256  + 64 * (j))
#define XB_XSUB(j)  (1280 + 64 * (j))
#define XB_XGEN(j)  (2304 + 64 * (j))
#define XB_TOP      3328
#define XB_TOPGEN   3392
#define XCD_BAR_WORDS 3456
#define XB_SPIN_CAP (1u << 22)
__device__ __forceinline__ unsigned xb_ld(unsigned* p)              { return __hip_atomic_load(p, __ATOMIC_RELAXED, __HIP_MEMORY_SCOPE_AGENT); }
__device__ __forceinline__ unsigned xb_add(unsigned* p, unsigned v) { return __hip_atomic_fetch_add(p, v, __ATOMIC_RELAXED, __HIP_MEMORY_SCOPE_AGENT); }
__device__ __forceinline__ unsigned xb_xcc_id() { return (unsigned)__builtin_amdgcn_s_getreg((3 << 11) | 20) & 0xFu; }
#define XB_SPIN(cond, bar) do { unsigned _sp = 0; while (cond) { __builtin_amdgcn_s_sleep(1); \
    if ((++_sp & 255u) == 0u) { if (xb_ld(&(bar)[XB_TMO])) break; if (_sp > XB_SPIN_CAP) { atomicAdd(&(bar)[XB_TMO], 1u); break; } } } } while (0)
struct XcdBarrier { unsigned* bar; unsigned x; volatile LAS unsigned* st; };
__device__ __forceinline__ XcdBarrier xcd_barrier_post(unsigned* bar, volatile LAS unsigned* st) {
    XcdBarrier b; b.bar = bar; b.x = xb_xcc_id(); b.st = st;
    if (threadIdx.x == 0) (void)xb_add(&bar[XB_XCNT(b.x)], 1u);
    return b;
}
__device__ __forceinline__ void xcd_barrier_complete(unsigned* bar, unsigned x, unsigned& nloc, unsigned& nx) {
    const unsigned G = gridDim.x * gridDim.y * gridDim.z;
    unsigned sum, cnt, mine, sp = 0u;
    for (;;) {
        sum = 0u; cnt = 0u; mine = 0u;
#pragma unroll
        for (unsigned j = 0; j < 16; ++j) { const unsigned c = xb_ld(&bar[XB_XCNT(j)]); sum += c; cnt += (c > 0u) ? 1u : 0u; mine = (j == x) ? c : mine; }
        if (sum == G) break;
        __builtin_amdgcn_s_sleep(1);
        if ((++sp & 255u) == 0u) { if (xb_ld(&bar[XB_TMO])) break; if (sp > XB_SPIN_CAP) { atomicAdd(&bar[XB_TMO], 1u); break; } }
    }
    nloc = mine > 0u ? mine : 1u; nx = cnt > 0u ? cnt : 1u;
}
__device__ __forceinline__ void xcd_barrier(const XcdBarrier& b) {
    asm volatile("s_waitcnt vmcnt(0)" ::: "memory");
    __syncthreads();
    if (threadIdx.x == 0) {
        unsigned* bar = b.bar;
        __builtin_amdgcn_s_waitcnt(0);
        unsigned nloc = b.st[0], nx = b.st[1];
        if (nloc == 0u) { xcd_barrier_complete(bar, b.x, nloc, nx); b.st[0] = nloc; b.st[1] = nx; }
        const unsigned old = xb_add(&bar[XB_XSUB(b.x)], 1u);
        const unsigned gen = old / nloc;
        if (old + 1u == (gen + 1u) * nloc) {
            __builtin_amdgcn_fence(__ATOMIC_RELEASE, "agent");
            asm volatile("s_waitcnt vmcnt(0)" ::: "memory");
            const unsigned og = xb_add(&bar[XB_TOP], 1u);
            const unsigned tg = og / nx;
            if (og + 1u == (tg + 1u) * nx) xb_add(&bar[XB_TOPGEN], 1u);
            else XB_SPIN(xb_ld(&bar[XB_TOPGEN]) == tg, bar);
            __builtin_amdgcn_fence(__ATOMIC_ACQUIRE, "agent");
            xb_add(&bar[XB_XGEN(b.x)], 1u);
            asm volatile("s_waitcnt vmcnt(0)" ::: "memory");
        } else {
            XB_SPIN(xb_ld(&bar[XB_XGEN(b.x)]) == gen, bar);
            __builtin_amdgcn_fence(__ATOMIC_ACQUIRE, "agent");
            asm volatile("s_waitcnt vmcnt(0)" ::: "memory");
        }
    }
    __syncthreads();
}

__device__ __forceinline__ int toff(int row, int chunk) { return row * 128 + ((chunk ^ ((row >> 1) & 7)) << 4); }

template <int MT, int NT, class AL, class BL>
__device__ __forceinline__ void gemm_kloop(f32x4 (&acc)[MT][NT], const AL& al, const BL& bl, int nk, char* lds) {
    const int tid = threadIdx.x, lane = tid & 63, w = tid >> 6;
    const int wm = (MT == 4) ? (w >> 1) : w, wn = (MT == 4) ? (w & 1) : 0;
    const int r0 = tid >> 3, ck = tid & 7;
    const int fr = lane & 15, fg = lane >> 4;
    uint4 ra[4], rb[4];
    al(0, ra); bl(0, rb);
#pragma unroll
    for (int i = 0; i < 4; ++i) { *(uint4*)(lds + toff(r0 + 32 * i, ck)) = ra[i]; *(uint4*)(lds + 16384 + toff(r0 + 32 * i, ck)) = rb[i]; }
    __syncthreads();
    for (int kt = 0; kt < nk; ++kt) {
        char* cA = lds + (kt & 1) * 32768; char* cB = cA + 16384;
        if (kt + 1 < nk) { al(kt + 1, ra); bl(kt + 1, rb); }
#pragma unroll
        for (int s = 0; s < 2; ++s) {
            bf16x8 af[MT], bfr[NT];
#pragma unroll
            for (int i = 0; i < MT; ++i) af[i] = *(const bf16x8*)(cA + toff(wm * MT * 16 + i * 16 + fr, s * 4 + fg));
#pragma unroll
            for (int j = 0; j < NT; ++j) bfr[j] = *(const bf16x8*)(cB + toff(wn * NT * 16 + j * 16 + fr, s * 4 + fg));
#pragma unroll
            for (int i = 0; i < MT; ++i)
#pragma unroll
                for (int j = 0; j < NT; ++j) acc[i][j] = MFMA16(bfr[j], af[i], acc[i][j]);
        }
        if (kt + 1 < nk) {
            char* nA = lds + ((kt + 1) & 1) * 32768;
#pragma unroll
            for (int i = 0; i < 4; ++i) { *(uint4*)(nA + toff(r0 + 32 * i, ck)) = ra[i]; *(uint4*)(nA + 16384 + toff(r0 + 32 * i, ck)) = rb[i]; }
        }
        __syncthreads();
    }
}
template <int MT, int NT> __device__ __forceinline__ void acc_zero(f32x4 (&acc)[MT][NT]) {
#pragma unroll
    for (int i = 0; i < MT; ++i)
#pragma unroll
        for (int j = 0; j < NT; ++j) acc[i][j] = (f32x4){0.f, 0.f, 0.f, 0.f};
}
struct RowLoader {
    const u16* base; int ld;
    __device__ __forceinline__ void operator()(int kt, uint4 (&r)[4]) const {
        const int r0 = threadIdx.x >> 3, ck = threadIdx.x & 7;
#pragma unroll
        for (int i = 0; i < 4; ++i) r[i] = *(const uint4*)(base + (size_t)(r0 + 32 * i) * ld + kt * 64 + ck * 8);
    }
};

struct ConvJob { const float* src; int ldsrc; int K; int nc; u16* dst; int ldd; const float* scale; int smode; };
__device__ __forceinline__ void conv_tile(const ConvJob& jb, int tk, int tn, char* lds) {
    float* T = (float*)lds;
    const int tid = threadIdx.x;
    const int k0 = tk * 64, n0 = tn * 64;
    {
        const int nl = tid & 63, kb = tid >> 6;
#pragma unroll
        for (int i = 0; i < 16; ++i) {
            const int kl = kb + 4 * i; const int k = k0 + kl, n = n0 + nl;
            float v = 0.f;
            if (jb.src != nullptr && k < jb.K && n < jb.nc) {
                v = jb.src[(size_t)k * jb.ldsrc + n];
                if (jb.smode == 1) v *= (1.f - jb.scale[k]); else if (jb.smode == 2) v *= jb.scale[k];
            }
            T[kl * 65 + nl] = v;
        }
    }
    __syncthreads();
    {
        const int kp = tid & 31, nb = tid >> 5;
#pragma unroll
        for (int i = 0; i < 8; ++i) {
            const int nl = nb + 8 * i; const int n = n0 + nl, k = k0 + 2 * kp;
            if (n < jb.nc && k < jb.K) {
                const unsigned pv = pk_bf16(T[(2 * kp) * 65 + nl], T[(2 * kp + 1) * 65 + nl]);
                *(unsigned*)(jb.dst + (size_t)n * jb.ldd + k) = pv;
            }
        }
    }
    __syncthreads();
}
constexpr int NE_JOBS = 23;
__device__ __forceinline__ void ne_job_dims(int j, int& K, int& nc) {
    K = 1024; nc = 64;
    switch (j) {
        case 0: nc = 1536; break; case 1: case 2: case 5: case 6: nc = 64; break; case 3: case 7: nc = 128; break; case 4: case 8: nc = 32; break;
        case 9: nc = 64; break; case 10: nc = 3328; break; case 11: nc = 3072; break; case 12: K = 512; nc = 1024; break; case 13: K = 256; nc = 1024; break;
        case 14: K = 512; nc = 1024; break; case 15: nc = 1024; break; case 16: case 17: K = 64; nc = 512; break; case 18: K = 128; nc = 512; break;
        case 19: K = 32; nc = 512; break; case 20: nc = 4; break; case 21: nc = 16; break; case 22: nc = 108; break;
    }
}
__device__ __forceinline__ void ne_job(const Params& p, int l, int j, ConvJob& jb) {
    char* wne = p.ws + OFF_WNE + (size_t)l * WNE_SZ;
    int K, nc; ne_job_dims(j, K, nc);
    jb.K = K; jb.nc = nc; jb.scale = nullptr; jb.smode = 0; jb.ldd = K; jb.src = nullptr; jb.ldsrc = nc; jb.dst = (u16*)wne;
    const float* w_in = (const float*)p.in[3] + (size_t)l * 1024 * 4864;
    const float* muwag = (const float*)p.in[9] + (size_t)l * 3 * 1024;
    const float* muv = (const float*)p.in[23];
    u16* wtc = (u16*)(wne + WNE_WTC);
    switch (j) {
        case 0: jb.src = w_in + 3328; jb.ldsrc = 4864; jb.dst = wtc; break;
        case 1: jb.src = (const float*)p.in[11] + (size_t)l * 1024 * 64; jb.dst = wtc + 1536 * 1024; jb.scale = muwag; jb.smode = 1; break;
        case 2: jb.src = (const float*)p.in[14] + (size_t)l * 1024 * 64; jb.dst = wtc + 1600 * 1024; jb.scale = muwag + 1024; jb.smode = 1; break;
        case 3: jb.src = (const float*)p.in[16] + (size_t)l * 1024 * 128; jb.dst = wtc + 1664 * 1024; jb.scale = muwag + 2048; jb.smode = 1; break;
        case 4: jb.src = (l == 1) ? (const float*)p.in[25] : nullptr; jb.dst = wtc + 1792 * 1024; jb.scale = muv; jb.smode = 1; break;
        case 5: jb.src = (const float*)p.in[11] + (size_t)l * 1024 * 64; jb.dst = wtc + 1824 * 1024; jb.scale = muwag; jb.smode = 2; break;
        case 6: jb.src = (const float*)p.in[14] + (size_t)l * 1024 * 64; jb.dst = wtc + 1888 * 1024; jb.scale = muwag + 1024; jb.smode = 2; break;
        case 7: jb.src = (const float*)p.in[16] + (size_t)l * 1024 * 128; jb.dst = wtc + 1952 * 1024; jb.scale = muwag + 2048; jb.smode = 2; break;
        case 8: jb.src = (l == 1) ? (const float*)p.in[25] : nullptr; jb.dst = wtc + 2080 * 1024; jb.scale = muv; jb.smode = 2; break;
        case 9: jb.src = nullptr; jb.dst = wtc + 2112 * 1024; break;
        case 10: jb.src = w_in; jb.ldsrc = 4864; jb.dst = (u16*)(wne + WNE_WTAB); break;
        case 11: jb.src = (const float*)p.in[30] + (size_t)l * 1024 * 3072; jb.dst = (u16*)(wne + WNE_WGATE); break;
        case 12: jb.src = (const float*)p.in[27] + (size_t)l * 512 * 1024; jb.dst = (u16*)(wne + WNE_WBRA); break;
        case 13: jb.src = (const float*)p.in[28] + (size_t)l * 256 * 1024; jb.dst = (u16*)(wne + WNE_WBRB); break;
        case 14: jb.src = (const float*)p.in[29] + (size_t)l * 512 * 1024; jb.dst = (u16*)(wne + WNE_WBRC); break;
        case 15: jb.src = (const float*)p.in[32] + (size_t)l * 1024 * 1024; jb.dst = (u16*)(wne + WNE_WOUT); break;
        case 16: jb.src = (const float*)p.in[12] + (size_t)l * 64 * 512; jb.dst = (u16*)(wne + WNE_W2T); break;
        case 17: jb.src = (const float*)p.in[15] + (size_t)l * 64 * 512; jb.dst = (u16*)(wne + WNE_A2T); break;
        case 18: jb.src = (const float*)p.in[17] + (size_t)l * 128 * 512; jb.dst = (u16*)(wne + WNE_G2T); break;
        case 19: jb.src = (l == 1) ? (const float*)p.in[26] : nullptr; jb.dst = (u16*)(wne + WNE_V2T); break;
        case 20: jb.src = (const float*)p.in[34] + (size_t)l * 1024 * 4; jb.dst = (u16*)(wne + WNE_WR); break;
        case 21: jb.src = (const float*)p.in[36] + (size_t)l * 1024 * 16; jb.dst = (u16*)(wne + WNE_WR) + 4 * 1024; break;
        case 22: jb.src = nullptr; jb.dst = (u16*)(wne + WNE_WR) + 20 * 1024; break;
    }
}
__device__ __forceinline__ int ne_total_tiles() {
    int tot = 0;
#pragma unroll
    for (int j = 0; j < NE_JOBS; ++j) { int K, nc; ne_job_dims(j, K, nc); tot += ((K + 63) / 64) * ((nc + 63) / 64); }
    return tot;
}
__device__ void phase_conv_ne(const Params& p, char* lds) {
    const int per_layer = ne_total_tiles();
    const int nconv = 2 * per_layer;
    const int nrot = NTOK * 8 / 256;
    for (int u = blockIdx.x; u < nconv + nrot; u += gridDim.x) {
        if (u < nconv) {
            const int l = u / per_layer; int t = u % per_layer; int j = 0;
            for (; j < NE_JOBS; ++j) { int K, nc; ne_job_dims(j, K, nc); const int c = ((K + 63) / 64) * ((nc + 63) / 64); if (t < c) break; t -= c; }
            ConvJob jb; ne_job(p, l, j, jb);
            const int ntn = (jb.nc + 63) / 64;
            conv_tile(jb, t / ntn, t % ntn, lds);
        } else {
            const int e = (u - nconv) * 256 + threadIdx.x;
            const int tok = e >> 3, i = e & 7;
            const float pos = (float)((const int*)p.in[1])[tok];
            const float inv = __expf(-(float)i * (13.122363377404328f / 8.f));
            float sn, cs; sincosf(pos * inv, &sn, &cs);
            ((float*)(p.ws + OFF_ROT))[e] = cs;
            ((float*)(p.ws + OFF_ROT))[(size_t)NTOK * 8 + e] = sn;
        }
    }
}
__device__ __forceinline__ void conv_expert_unit(const Params& p, int l, int u, char* lds) {
    const int mat = u >> 11, e = (u & 2047) >> 7, tile = u & 127;
    ConvJob jb; jb.scale = nullptr; jb.smode = 0;
    u16* wexp = (u16*)(p.ws + OFF_R + R_WEXP);
    if (mat < 2) {
        jb.src = (const float*)p.in[38 + mat] + ((size_t)l * 16 + e) * 1024 * 512; jb.ldsrc = 512; jb.K = 1024; jb.nc = 512;
        jb.dst = wexp + (size_t)mat * 16 * 512 * 1024 + (size_t)e * 512 * 1024; jb.ldd = 1024;
        conv_tile(jb, tile >> 3, tile & 7, lds);
    } else {
        jb.src = (const float*)p.in[40] + ((size_t)l * 16 + e) * 512 * 1024; jb.ldsrc = 1024; jb.K = 512; jb.nc = 1024;
        jb.dst = wexp + (size_t)2 * 16 * 512 * 1024 + (size_t)e * 1024 * 512; jb.ldd = 512;
        conv_tile(jb, tile >> 4, tile & 15, lds);
    }
}

template <bool FINAL>
__device__ void phase_norm(const Params& p, const float* x, const float* g) {
    const int lane = threadIdx.x & 63;
    const int gw = blockIdx.x * 4 + (threadIdx.x >> 6);
    for (int row = gw; row < NTOK; row += gridDim.x * 4) {
        const float4* xr = (const float4*)(x + (size_t)row * 1024);
        float4 v[4]; float ss = 0.f;
#pragma unroll
        for (int i = 0; i < 4; ++i) { v[i] = xr[lane + 64 * i]; ss += v[i].x * v[i].x + v[i].y * v[i].y + v[i].z * v[i].z + v[i].w * v[i].w; }
        ss = wavesum(ss);
        const float rinv = rsqrtf(ss * (1.f / 1024.f) + 1e-6f);
#pragma unroll
        for (int i = 0; i < 4; ++i) {
            const float4 gg = ((const float4*)g)[lane + 64 * i];
            const float a = v[i].x * rinv * gg.x, b = v[i].y * rinv * gg.y, c = v[i].z * rinv * gg.z, d = v[i].w * rinv * gg.w;
            if (FINAL) ((float4*)(p.out + (size_t)row * 1024))[lane + 64 * i] = make_float4(a, b, c, d);
            else ((uint2*)(p.ws + OFF_H + (size_t)row * 2048))[lane + 64 * i] = make_uint2(pk_bf16(a, b), pk_bf16(c, d));
        }
    }
}

__device__ void gemm2a_unit(const Params& p, int l, int u, char* lds) {
    const int mt = u / 17, nt = u % 17;
    const int lane = threadIdx.x & 63, w = threadIdx.x >> 6, wm = w >> 1, wn = w & 1, fr = lane & 15, fg = lane >> 4;
    RowLoader al{(const u16*)(p.ws + OFF_H) + (size_t)mt * 128 * 1024, 1024};
    RowLoader bl{(const u16*)(p.ws + OFF_WNE + (size_t)l * WNE_SZ + WNE_WTC) + (size_t)nt * 128 * 1024, 1024};
    f32x4 acc[4][4]; acc_zero<4, 4>(acc);
    gemm_kloop<4, 4>(acc, al, bl, 16, lds);
    u16* projc = (u16*)(p.ws + OFF_R + R_PROJC); u16* lora1 = (u16*)(p.ws + OFF_R + R_LORA1);
#pragma unroll
    for (int i = 0; i < 4; ++i)
#pragma unroll
        for (int j = 0; j < 4; ++j) {
            const int m = mt * 128 + wm * 64 + i * 16 + fr, n = nt * 128 + wn * 64 + j * 16 + fg * 4;
            const uint2 v = pk4(acc[i][j]);
            if (n < 1536) *(uint2*)(projc + (size_t)m * 1536 + n) = v;
            else if (n < 2112) *(uint2*)(lora1 + (size_t)m * 576 + (n - 1536)) = v;
        }
}
__device__ void gemm2b_unit(const Params& p, int l, int u, char* lds) {
    const int mt = u / 26, nt = u % 26;
    const int lane = threadIdx.x & 63, w = threadIdx.x >> 6, wm = w >> 1, wn = w & 1, fr = lane & 15, fg = lane >> 4;
    RowLoader al{(const u16*)(p.ws + OFF_H) + (size_t)mt * 128 * 1024, 1024};
    RowLoader bl{(const u16*)(p.ws + OFF_WNE + (size_t)l * WNE_SZ + WNE_WTAB) + (size_t)nt * 128 * 1024, 1024};
    f32x4 acc[4][4]; acc_zero<4, 4>(acc);
    gemm_kloop<4, 4>(acc, al, bl, 16, lds);
    u16* proja = (u16*)(p.ws + OFF_R + R_PROJA); u16* projb = (u16*)(p.ws + OFF_R + R_PROJB);
    const float* rc = (const float*)(p.ws + OFF_ROT); const float* rs = rc + (size_t)NTOK * 8;
    const int nbase = nt * 128 + wn * 64;
#pragma unroll
    for (int i = 0; i < 4; ++i) {
        const int m = mt * 128 + wm * 64 + i * 16 + fr;
#pragma unroll
        for (int j = 0; j < 4; ++j) {
            const int n = nbase + j * 16 + fg * 4;
            f32x4 v = acc[i][j];
            if (nbase < 1024) {
#pragma unroll
                for (int q = 0; q < 4; ++q) v[q] = gelu_tanh(v[q]);
                *(uint2*)(proja + (size_t)m * 1024 + n) = pk4(v);
            } else {
                const int nb = n - 1024;
                if (nbase < 1024 + 1536 && j == 0) {
                    f32x4 pv;
#pragma unroll
                    for (int q = 0; q < 4; ++q) pv[q] = __shfl_xor(v[q], 32);
                    const f32x4 cs = *(const f32x4*)(rc + (size_t)m * 8 + (fg & 1) * 4);
                    const f32x4 sn = *(const f32x4*)(rs + (size_t)m * 8 + (fg & 1) * 4);
#pragma unroll
                    for (int q = 0; q < 4; ++q) v[q] = (fg < 2) ? (v[q] * cs[q] - pv[q] * sn[q]) : (v[q] * cs[q] + pv[q] * sn[q]);
                }
                if (nbase < 1024 + 768) { v = v * 0.125f; }
                *(uint2*)(projb + (size_t)m * 2304 + nb) = pk4(v);
            }
        }
    }
}

__device__ __forceinline__ bf16x8 act8(uint4 a, uint4 b, int mode) {
    unsigned av[4] = {a.x, a.y, a.z, a.w}, bv[4] = {b.x, b.y, b.z, b.w}; unsigned o[4];
#pragma unroll
    for (int q = 0; q < 4; ++q) {
        float lo = bflo(av[q]) + bflo(bv[q]), hi = bfhi(av[q]) + bfhi(bv[q]);
        if (mode == 1) { lo = 1.f - 2.f / (__expf(2.f * lo) + 1.f); hi = 1.f - 2.f / (__expf(2.f * hi) + 1.f); }
        else if (mode == 2) { lo = sigmoidf_(lo); hi = sigmoidf_(hi); }
        o[q] = pk_bf16(lo, hi);
    }
    return mk8(make_uint4(o[0], o[1], o[2], o[3]));
}
__device__ void prep_unit(const Params& p, int l, int u) {
    const int tt = u >> 3, hh = u & 7;
    const int lane = threadIdx.x & 63, w = threadIdx.x >> 6, tl = lane & 15, G = lane >> 4;
    const char* wne = p.ws + OFF_WNE + (size_t)l * WNE_SZ;
    const u16* lora1 = (const u16*)(p.ws + OFF_R + R_LORA1);
    const u16* projc = (const u16*)(p.ws + OFF_R + R_PROJC);
    const float* mu_rkv = (const float*)p.in[8] + (size_t)l * 3 * 512;
    const float* w0p = (const float*)p.in[10] + (size_t)l * 512;
    const float* a0p = (const float*)p.in[13] + (size_t)l * 512;
    const float* kkp = (const float*)p.in[18] + (size_t)l * 512;
    const float* kap = (const float*)p.in[19] + (size_t)l * 512;
    const float* rkp = (const float*)p.in[20] + (size_t)l * 512;
    const float* v0p = (const float*)p.in[24];
    const u16* vfirst = (const u16*)(p.ws + OFF_V);
    u16* vout = (u16*)(p.ws + OFF_V + (size_t)l * NTOK * 1024);
    u16* gout = (u16*)(p.ws + OFF_G);
    uint2* KR = (uint2*)(p.ws + OFF_KR); uint2* BK = (uint2*)(p.ws + OFF_BK); uint2* WW = (uint2*)(p.ws + OFF_W);
    float* bonus = (float*)(p.ws + OFF_BONUS);
#pragma unroll 1
    for (int t2 = 0; t2 < 2; ++t2) {
        const int tk = tt * 128 + w * 32 + t2 * 16 + tl; const bool hp = (tk & (SEQ - 1)) != 0;
        f32x4 acc[4][4];
#pragma unroll
        for (int a = 0; a < 4; ++a)
#pragma unroll
            for (int b = 0; b < 4; ++b) acc[a][b] = (f32x4){0.f, 0.f, 0.f, 0.f};
#pragma unroll
        for (int mat = 0; mat < 4; ++mat) {
            if (mat == 3 && l == 0) continue;
            const int K = (mat == 2) ? 128 : (mat == 3 ? 32 : 64);
            const int cola = (mat == 0) ? 0 : (mat == 1 ? 64 : (mat == 2 ? 128 : 256));
            const int mode = (mat == 0) ? 1 : (mat == 2 ? 2 : 0);
            const u16* wT = (const u16*)(wne + (mat == 0 ? WNE_W2T : (mat == 1 ? WNE_A2T : (mat == 2 ? WNE_G2T : WNE_V2T))));
#pragma unroll 1
            for (int s = 0; s < K / 32; ++s) {
                const int j0 = s * 32 + 8 * G;
                const uint4 xa = *(const uint4*)(lora1 + (size_t)tk * 576 + cola + j0);
                uint4 xb = make_uint4(0, 0, 0, 0);
                if (hp) xb = *(const uint4*)(lora1 + (size_t)(tk - 1) * 576 + 288 + cola + j0);
                const bf16x8 bfr = act8(xa, xb, mode);
#pragma unroll
                for (int ct = 0; ct < 4; ++ct) {
                    const bf16x8 af = mk8(*(const uint4*)(wT + (size_t)(hh * 64 + ct * 16 + tl) * K + j0));
                    acc[mat][ct] = MFMA16(af, bfr, acc[mat][ct]);
                }
            }
        }
        f32x4 kkraw[4], av[4];
        float ss = 0.f, bo = 0.f;
#pragma unroll
        for (int ct = 0; ct < 4; ++ct) {
            const int c0 = hh * 64 + ct * 16 + G * 4;
            const f32x4 r_t = unpk4(*(const uint2*)(projc + (size_t)tk * 1536 + c0));
            const f32x4 k_t = unpk4(*(const uint2*)(projc + (size_t)tk * 1536 + 512 + c0));
            const f32x4 v_t = unpk4(*(const uint2*)(projc + (size_t)tk * 1536 + 1024 + c0));
            f32x4 r_p = (f32x4){0.f, 0.f, 0.f, 0.f}, k_p = r_p, v_p = r_p;
            if (hp) {
                r_p = unpk4(*(const uint2*)(projc + (size_t)(tk - 1) * 1536 + c0));
                k_p = unpk4(*(const uint2*)(projc + (size_t)(tk - 1) * 1536 + 512 + c0));
                v_p = unpk4(*(const uint2*)(projc + (size_t)(tk - 1) * 1536 + 1024 + c0));
            }
            const f32x4 mur = *(const f32x4*)(mu_rkv + c0), muk = *(const f32x4*)(mu_rkv + 512 + c0), muv = *(const f32x4*)(mu_rkv + 1024 + c0);
            const f32x4 w0 = *(const f32x4*)(w0p + c0), a0 = *(const f32x4*)(a0p + c0), k_k = *(const f32x4*)(kkp + c0), k_a = *(const f32x4*)(kap + c0), r_k = *(const f32x4*)(rkp + c0);
            f32x4 rr = r_t + (r_p - r_t) * mur;
            f32x4 kx = k_t + (k_p - k_t) * muk;
            f32x4 vx = v_t + (v_p - v_t) * muv;
            f32x4 wd, aa, k2;
#pragma unroll
            for (int q = 0; q < 4; ++q) {
                const float wv = w0[q] + acc[0][ct][q];
                const float nx = -wv;
                const float sp = fmaxf(nx, 0.f) + log1pf(__expf(-fabsf(nx)));
                wd[q] = __expf(-__expf(-sp - 0.5f));
                aa[q] = sigmoidf_(a0[q] + acc[1][ct][q]);
            }
            if (l == 1) {
                const f32x4 vf = unpk4(*(const uint2*)(vfirst + (size_t)tk * 512 + c0));
                const f32x4 v0 = *(const f32x4*)(v0p + c0);
#pragma unroll
                for (int q = 0; q < 4; ++q) vx[q] = vx[q] + (vf[q] - vx[q]) * sigmoidf_(v0[q] + acc[3][ct][q]);
            }
#pragma unroll
            for (int q = 0; q < 4; ++q) {
                kkraw[ct][q] = kx[q] * k_k[q]; ss += kkraw[ct][q] * kkraw[ct][q];
                k2[q] = kx[q] * (1.f + (aa[q] - 1.f) * k_a[q]);
                bo += rr[q] * k2[q] * r_k[q];
            }
            av[ct] = aa;
            const size_t rec = ((size_t)tk * 8 + hh) * 16 + ct * 4 + G;
            KR[rec * 2 + 1] = pk4(rr);
            BK[rec * 2 + 1] = pk4(k2);
            { h2_t lo, hi; lo[0] = (_Float16)wd[0]; lo[1] = (_Float16)wd[1]; hi[0] = (_Float16)wd[2]; hi[1] = (_Float16)wd[3];
              WW[rec] = make_uint2(__builtin_bit_cast(unsigned, lo), __builtin_bit_cast(unsigned, hi)); }
            *(uint2*)(vout + (size_t)tk * 512 + c0) = pk4(vx);
            *(uint2*)(gout + (size_t)tk * 512 + c0) = pk4(acc[2][ct]);
        }
        ss += __shfl_xor(ss, 16); ss += __shfl_xor(ss, 32);
        bo += __shfl_xor(bo, 16); bo += __shfl_xor(bo, 32);
        const float inv = 1.f / fmaxf(sqrtf(ss), 1e-12f);
#pragma unroll
        for (int ct = 0; ct < 4; ++ct) {
            const size_t rec = ((size_t)tk * 8 + hh) * 16 + ct * 4 + G;
            const f32x4 kk = kkraw[ct] * inv;
            KR[rec * 2] = pk4(kk);
            BK[rec * 2] = pk4(kk * av[ct]);
        }
        if (G == 0) bonus[(size_t)tk * 8 + hh] = bo;
    }
}

__device__ void scan_unit(const Params& p, int l, int su) {
    const int bh = su >> 2, qv = su & 3, b = bh >> 3, hh = bh & 7;
    const int lane = threadIdx.x & 63, w = threadIdx.x >> 6, j = lane & 15;
    const int row = qv * 16 + w * 4 + (lane >> 4);
    const size_t tok0 = (size_t)b * SEQ;
    const uint4* KR = (const uint4*)(p.ws + OFF_KR) + (tok0 * 8 + hh) * 16 + j;
    const uint4* BK = (const uint4*)(p.ws + OFF_BK) + (tok0 * 8 + hh) * 16 + j;
    const uint2* WW = (const uint2*)(p.ws + OFF_W) + (tok0 * 8 + hh) * 16 + j;
    const u16* V = (const u16*)(p.ws + OFF_V + (size_t)l * NTOK * 1024) + tok0 * 512 + hh * 64 + row;
    u16* Y = (u16*)(p.ws + OFF_YRAW) + tok0 * 512 + hh * 64 + row;
    constexpr int PF = 8;
    uint4 kr[PF], bk[PF]; uint2 wv[PF]; u16 vv[PF];
#pragma unroll
    for (int i = 0; i < PF; ++i) { kr[i] = KR[(size_t)i * 128]; bk[i] = BK[(size_t)i * 128]; wv[i] = WW[(size_t)i * 128]; vv[i] = V[(size_t)i * 512]; }
    float s0 = 0.f, s1 = 0.f, s2 = 0.f, s3 = 0.f; unsigned sb0 = 0u, sb1 = 0u;
    for (int t0 = 0; t0 < SEQ; t0 += PF) {
#pragma unroll
        for (int i = 0; i < PF; ++i) {
            const uint4 ckr = kr[i], cbk = bk[i]; const uint2 cw = wv[i]; const float v = bf2f(vv[i]);
            int tn = t0 + i + PF; tn = tn < SEQ ? tn : SEQ - 1;
            kr[i] = KR[(size_t)tn * 128]; bk[i] = BK[(size_t)tn * 128]; wv[i] = WW[(size_t)tn * 128]; vv[i] = V[(size_t)tn * 512];
            float sa = dot2bf(sb0, ckr.x, 0.f); sa = dot2bf(sb1, ckr.y, sa);
            sa = -rowsum16(sa);
            const h2_t wlo = __builtin_bit_cast(h2_t, cw.x), whi = __builtin_bit_cast(h2_t, cw.y);
            s0 = s0 * (float)wlo[0] + (sa * bflo(cbk.x) + v * bflo(cbk.z));
            s1 = s1 * (float)wlo[1] + (sa * bfhi(cbk.x) + v * bfhi(cbk.z));
            s2 = s2 * (float)whi[0] + (sa * bflo(cbk.y) + v * bflo(cbk.w));
            s3 = s3 * (float)whi[1] + (sa * bfhi(cbk.y) + v * bfhi(cbk.w));
            sb0 = pk_bf16(s0, s1); sb1 = pk_bf16(s2, s3);
            float y = dot2bf(sb0, ckr.z, 0.f); y = dot2bf(sb1, ckr.w, y);
            y = rowsum16(y);
            if (j == 0) Y[(size_t)(t0 + i) * 512] = f2bf(y);
        }
    }
}

__device__ void mixa_unit(const Params& p, int l, int u, char* lds) {
    const int g = u & 3, bc = u >> 2;
    const int tok0 = bc * 128;
    const int tid = threadIdx.x, lane = tid & 63, w = tid >> 6, fr = lane & 15, G = lane >> 4;
    u16* proja = (u16*)(p.ws + OFF_R + R_PROJA);
    char* ldsV = lds; char* ldsW = lds + 32768; float2* stats = (float2*)(lds + 65536);
    for (int r = 0; r < 32; ++r) {
        const int row = w * 32 + r;
        const uint4 x = *(const uint4*)(proja + (size_t)(tok0 + row) * 1024 + 512 + lane * 8);
        const unsigned xv[4] = {x.x, x.y, x.z, x.w};
        float s = 0.f, q = 0.f;
#pragma unroll
        for (int i = 0; i < 4; ++i) { const float a = bflo(xv[i]), b2 = bfhi(xv[i]); s += a + b2; q += a * a + b2 * b2; }
        s = wavesum(s); q = wavesum(q);
        const float mu = s * (1.f / 512.f); const float var = fmaxf(q * (1.f / 512.f) - mu * mu, 0.f);
        if (lane == 0) stats[row] = make_float2(mu, rsqrtf(var + 1e-5f));
    }
    __syncthreads();
    const float* lng = (const float*)p.in[4] + (size_t)l * 512 + g * 128;
    const float* lnb = (const float*)p.in[5] + (size_t)l * 512 + g * 128;
    const float* wsrc = (const float*)p.in[6] + ((size_t)l * 4 + g) * 128 * 128;
#pragma unroll
    for (int i = 0; i < 8; ++i) {
        const int q = tid + 256 * i, row = q >> 4, ch = q & 15;
        const uint4 x = *(const uint4*)(proja + (size_t)(tok0 + row) * 1024 + 512 + g * 128 + ch * 8);
        const float2 st = stats[row];
        const f32x4 g0 = *(const f32x4*)(lng + ch * 8), g1 = *(const f32x4*)(lng + ch * 8 + 4), b0 = *(const f32x4*)(lnb + ch * 8), b1 = *(const f32x4*)(lnb + ch * 8 + 4);
        const unsigned xv[4] = {x.x, x.y, x.z, x.w}; unsigned o[4];
#pragma unroll
        for (int k = 0; k < 4; ++k) {
            const float ga = (k < 2) ? g0[2 * k] : g1[2 * k - 4], gb = (k < 2) ? g0[2 * k + 1] : g1[2 * k - 3];
            const float ba = (k < 2) ? b0[2 * k] : b1[2 * k - 4], bb = (k < 2) ? b0[2 * k + 1] : b1[2 * k - 3];
            o[k] = pk_bf16((bflo(xv[k]) - st.x) * st.y * ga + ba, (bfhi(xv[k]) - st.x) * st.y * gb + bb);
        }
        const int f = (row & 3) | (((row >> 3) & 1) << 2);
        *(uint4*)(ldsV + row * 256 + (((ch >> 1) ^ f) << 5) + ((ch & 1) << 4)) = make_uint4(o[0], o[1], o[2], o[3]);
        const f32x4 w0 = *(const f32x4*)(wsrc + (size_t)row * 128 + ch * 8), w1 = *(const f32x4*)(wsrc + (size_t)row * 128 + ch * 8 + 4);
        unsigned ow[4];
#pragma unroll
        for (int k = 0; k < 4; ++k) {
            const int s0i = ch * 8 + 2 * k;
            const float a = (k < 2) ? w0[2 * k] : w1[2 * k - 4], b2 = (k < 2) ? w0[2 * k + 1] : w1[2 * k - 3];
            ow[k] = pk_bf16(s0i <= row ? a : 0.f, (s0i + 1) <= row ? b2 : 0.f);
        }
        *(uint4*)(ldsW + row * 256 + ((ch ^ (row & 15)) << 4)) = make_uint4(ow[0], ow[1], ow[2], ow[3]);
    }
    __syncthreads();
    f32x4 acc[2][8];
#pragma unroll
    for (int a = 0; a < 2; ++a)
#pragma unroll
        for (int b = 0; b < 8; ++b) acc[a][b] = (f32x4){0.f, 0.f, 0.f, 0.f};
    const int qrow = (lane & 15) >> 2, pcol = lane & 3;
    for (int ss = 0; ss <= w; ++ss) {
        bf16x8 bw[2];
#pragma unroll
        for (int t2 = 0; t2 < 2; ++t2) { const int t = w * 32 + t2 * 16 + fr; bw[t2] = *(const bf16x8*)(ldsW + t * 256 + (((ss * 4 + G) ^ (t & 15)) << 4)); }
#pragma unroll
        for (int ct = 0; ct < 8; ++ct) {
            const int ra = ss * 32 + 8 * G + qrow, rb2 = ra + 4;
            const int fa = (ra & 3) | (((ra >> 3) & 1) << 2), fb = (rb2 & 3) | (((rb2 >> 3) & 1) << 2);
            const v4i16_t lo = __builtin_amdgcn_ds_read_tr16_b64_v4i16((LAS v4i16_t*)(ldsV + ra * 256 + ((ct ^ fa) << 5) + pcol * 8));
            const v4i16_t hi = __builtin_amdgcn_ds_read_tr16_b64_v4i16((LAS v4i16_t*)(ldsV + rb2 * 256 + ((ct ^ fb) << 5) + pcol * 8));
            bf16x8 af; af[0] = lo[0]; af[1] = lo[1]; af[2] = lo[2]; af[3] = lo[3]; af[4] = hi[0]; af[5] = hi[1]; af[6] = hi[2]; af[7] = hi[3];
            acc[0][ct] = MFMA16(af, bw[0], acc[0][ct]);
            acc[1][ct] = MFMA16(af, bw[1], acc[1][ct]);
        }
    }
    const float* bs = (const float*)p.in[7] + ((size_t)l * 4 + g) * 128;
#pragma unroll
    for (int t2 = 0; t2 < 2; ++t2) {
        const int t = w * 32 + t2 * 16 + fr; const float bias = bs[t];
#pragma unroll
        for (int ct = 0; ct < 8; ++ct) {
            u16* pu = proja + (size_t)(tok0 + t) * 1024 + g * 128 + ct * 16 + G * 4;
            const f32x4 uu = unpk4(*(const uint2*)pu);
            f32x4 y;
#pragma unroll
            for (int q = 0; q < 4; ++q) y[q] = uu[q] * (acc[t2][ct][q] + bias);
            *(uint2*)pu = pk4(y);
        }
    }
    __syncthreads();
}

__device__ void attn_unit(const Params& p, int u, char* lds) {
    const int hq = u & 3, combo = (u >> 2) % 48, b = (u >> 2) / 48;
    int g, r, n, dil;
    if (combo < 16) { g = 0; r = 0; n = combo; dil = 1; } else if (combo < 32) { g = 1; r = (combo - 16) >> 2; n = (combo - 16) & 3; dil = 4; } else { g = 2; r = combo - 32; n = 0; dil = 16; }
    const int head = g * 4 + hq;
    const int tid = threadIdx.x, lane = tid & 63, w = tid >> 6, fr = lane & 15, G = lane >> 4;
    u16* projb = (u16*)(p.ws + OFF_R + R_PROJB);
    char* ldsK = lds; char* ldsV = lds + 32768;
    const size_t tokb = (size_t)b * SEQ + r;
#pragma unroll
    for (int i = 0; i < 8; ++i) {
        const int q = tid + 256 * i, row = q >> 3, ch = q & 7;
        const int idx = (n - 1) * 128 + row;
        uint4 kx = make_uint4(0, 0, 0, 0), vx = kx;
        if (idx >= 0) {
            const u16* src = projb + (tokb + (size_t)idx * dil) * 2304 + head * 64 + ch * 8;
            kx = *(const uint4*)(src + 768); vx = *(const uint4*)(src + 1536);
        }
        *(uint4*)(ldsK + toff(row, ch)) = kx;
        *(uint4*)(ldsV + row * 128 + (((ch >> 1) ^ ((row >> 1) & 3)) << 5) + ((ch & 1) << 4)) = vx;
    }
    bf16x8 qf[2][2]; size_t qtok[2];
#pragma unroll
    for (int qt = 0; qt < 2; ++qt) {
        qtok[qt] = tokb + (size_t)(n * 128 + w * 32 + qt * 16 + fr) * dil;
#pragma unroll
        for (int s = 0; s < 2; ++s) qf[qt][s] = mk8(*(const uint4*)(projb + qtok[qt] * 2304 + head * 64 + s * 32 + 8 * G));
    }
    __syncthreads();
    f32x4 sc[2][10];
#pragma unroll
    for (int qt = 0; qt < 2; ++qt)
#pragma unroll
        for (int uu = 0; uu < 10; ++uu) sc[qt][uu] = (f32x4){0.f, 0.f, 0.f, 0.f};
#pragma unroll
    for (int uu = 0; uu < 10; ++uu)
#pragma unroll
        for (int s = 0; s < 2; ++s) {
            const bf16x8 kf = *(const bf16x8*)(ldsK + toff((2 * w + uu) * 16 + fr, s * 4 + G));
            sc[0][uu] = MFMA16(kf, qf[0][s], sc[0][uu]);
            sc[1][uu] = MFMA16(kf, qf[1][s], sc[1][uu]);
        }
    float mx[2], sm[2];
#pragma unroll
    for (int qt = 0; qt < 2; ++qt) {
        const int qi = w * 32 + qt * 16 + fr;
        float m = -1e30f;
#pragma unroll
        for (int uu = 0; uu < 10; ++uu)
#pragma unroll
            for (int q = 0; q < 4; ++q) {
                const int kj = (2 * w + uu) * 16 + G * 4 + q;
                const bool valid = (kj >= qi) && (kj <= qi + 128) && (n > 0 || kj >= 128);
                const float v = valid ? sc[qt][uu][q] : -1e30f;
                sc[qt][uu][q] = v; m = fmaxf(m, v);
            }
        m = fmaxf(m, __shfl_xor(m, 16)); m = fmaxf(m, __shfl_xor(m, 32));
        float s = 0.f;
#pragma unroll
        for (int uu = 0; uu < 10; ++uu)
#pragma unroll
            for (int q = 0; q < 4; ++q) { const float e = __expf(sc[qt][uu][q] - m); sc[qt][uu][q] = e; s += e; }
        s += __shfl_xor(s, 16); s += __shfl_xor(s, 32);
        mx[qt] = m; sm[qt] = s;
    }
    f32x4 oc[2][4];
#pragma unroll
    for (int qt = 0; qt < 2; ++qt)
#pragma unroll
        for (int dt = 0; dt < 4; ++dt) oc[qt][dt] = (f32x4){0.f, 0.f, 0.f, 0.f};
    const int qrow = (lane & 15) >> 2, pcol = lane & 3;
#pragma unroll
    for (int ks = 0; ks < 5; ++ks) {
        bf16x8 pf[2];
#pragma unroll
        for (int qt = 0; qt < 2; ++qt)
            pf[qt] = mk8(make_uint4(pk_bf16(sc[qt][2 * ks][0], sc[qt][2 * ks][1]), pk_bf16(sc[qt][2 * ks][2], sc[qt][2 * ks][3]),
                                    pk_bf16(sc[qt][2 * ks + 1][0], sc[qt][2 * ks + 1][1]), pk_bf16(sc[qt][2 * ks + 1][2], sc[qt][2 * ks + 1][3])));
        const int ra = (2 * w + 2 * ks) * 16 + 4 * G + qrow, rb2 = ra + 16;
#pragma unroll
        for (int dt = 0; dt < 4; ++dt) {
            const v4i16_t lo = __builtin_amdgcn_ds_read_tr16_b64_v4i16((LAS v4i16_t*)(ldsV + ra * 128 + ((dt ^ ((ra >> 1) & 3)) << 5) + pcol * 8));
            const v4i16_t hi = __builtin_amdgcn_ds_read_tr16_b64_v4i16((LAS v4i16_t*)(ldsV + rb2 * 128 + ((dt ^ ((rb2 >> 1) & 3)) << 5) + pcol * 8));
            bf16x8 vf; vf[0] = lo[0]; vf[1] = lo[1]; vf[2] = lo[2]; vf[3] = lo[3]; vf[4] = hi[0]; vf[5] = hi[1]; vf[6] = hi[2]; vf[7] = hi[3];
            oc[0][dt] = MFMA16(vf, pf[0], oc[0][dt]);
            oc[1][dt] = MFMA16(vf, pf[1], oc[1][dt]);
        }
    }
    float* lse = (float*)(p.ws + OFF_LSE);
#pragma unroll
    for (int qt = 0; qt < 2; ++qt) {
        const float inv = 1.f / sm[qt];
#pragma unroll
        for (int dt = 0; dt < 4; ++dt) *(uint2*)(projb + qtok[qt] * 2304 + head * 64 + dt * 16 + G * 4) = pk4(oc[qt][dt] * inv);
        if (G == 0) lse[((size_t)g * NTOK + qtok[qt]) * 4 + hq] = mx[qt] + __logf(sm[qt]);
    }
    __syncthreads();
}

__device__ void phase_post(const Params& p, int l) {
    const int lane = threadIdx.x & 63, j = lane & 15;
    const int gw = blockIdx.x * 4 + (threadIdx.x >> 6), nw = gridDim.x * 4;
    const u16* yraw = (const u16*)(p.ws + OFF_YRAW); u16* gy = (u16*)(p.ws + OFF_G);
    const u16* vv = (const u16*)(p.ws + OFF_V + (size_t)l * NTOK * 1024);
    const float* bonus = (const float*)(p.ws + OFF_BONUS);
    const float* lnw = (const float*)p.in[21] + (size_t)l * 512; const float* lnb = (const float*)p.in[22] + (size_t)l * 512;
    for (int it = gw; it < NTOK * 8 / 4; it += nw) {
        const int pr = it * 4 + (lane >> 4);
        const int tok = pr >> 3, hh = pr & 7;
        const size_t off = (size_t)tok * 512 + hh * 64 + j * 4;
        const f32x4 y = unpk4(*(const uint2*)(yraw + off));
        const float mu = rowsum16(y[0] + y[1] + y[2] + y[3]) * (1.f / 64.f);
        const f32x4 d = y - mu;
        const float var = rowsum16(d[0] * d[0] + d[1] * d[1] + d[2] * d[2] + d[3] * d[3]) * (1.f / 64.f);
        const float rstd = rsqrtf(var + 64e-5f);
        const f32x4 w4 = *(const f32x4*)(lnw + hh * 64 + j * 4), b4 = *(const f32x4*)(lnb + hh * 64 + j * 4);
        const f32x4 v4 = unpk4(*(const uint2*)(vv + off)), g4 = unpk4(*(const uint2*)(gy + off));
        const float bo = bonus[pr];
        f32x4 o;
#pragma unroll
        for (int q = 0; q < 4; ++q) o[q] = (d[q] * rstd * w4[q] + b4[q] + bo * v4[q]) * g4[q];
        *(uint2*)(gy + off) = pk4(o);
    }
    u16* projb = (u16*)(p.ws + OFF_R + R_PROJB); const float* lse = (const float*)(p.ws + OFF_LSE);
    for (int it = gw; it < NTOK * 4 / 4; it += nw) {
        const int pr = it * 4 + (lane >> 4);
        const int tok = pr >> 2, hq = pr & 3;
        const float l0 = lse[((size_t)0 * NTOK + tok) * 4 + hq], l1 = lse[((size_t)1 * NTOK + tok) * 4 + hq], l2 = lse[((size_t)2 * NTOK + tok) * 4 + hq];
        const float m = fmaxf(l0, fmaxf(l1, l2));
        const float e0 = __expf(l0 - m), e1 = __expf(l1 - m), e2 = __expf(l2 - m); const float inv = 1.f / (e0 + e1 + e2);
        const u16* base = projb + (size_t)tok * 2304 + hq * 64 + j * 4;
        const f32x4 o0 = unpk4(*(const uint2*)(base)), o1 = unpk4(*(const uint2*)(base + 256)), o2 = unpk4(*(const uint2*)(base + 512));
        const f32x4 o = (o0 * e0 + o1 * e1 + o2 * e2) * inv;
        *(uint2*)(projb + (size_t)tok * 2304 + 768 + hq * 64 + j * 4) = pk4(o);
    }
}

__device__ void merge_unit(const Params& p, int l, int u, char* lds) {
    const int mt = u >> 3, nt = u & 7;
    const int lane = threadIdx.x & 63, w = threadIdx.x >> 6, wm = w >> 1, wn = w & 1, fr = lane & 15, fg = lane >> 4;
    const char* wne = p.ws + OFF_WNE + (size_t)l * WNE_SZ;
    const float* bgate = (const float*)p.in[31] + (size_t)l * 3072;
    u16* merged = (u16*)(p.ws + OFF_MERGED);
#pragma unroll 1
    for (int br = 0; br < 3; ++br) {
        const u16* ya; int lda, K; const u16* wb;
        if (br == 0) { ya = (const u16*)(p.ws + OFF_R + R_PROJA); lda = 1024; K = 512; wb = (const u16*)(wne + WNE_WBRA); }
        else if (br == 1) { ya = (const u16*)(p.ws + OFF_R + R_PROJB) + 768; lda = 2304; K = 256; wb = (const u16*)(wne + WNE_WBRB); }
        else { ya = (const u16*)(p.ws + OFF_G); lda = 512; K = 512; wb = (const u16*)(wne + WNE_WBRC); }
        uint2 yb[4][4];
        {
            f32x4 acc[4][4]; acc_zero<4, 4>(acc);
            RowLoader al{ya + (size_t)mt * 128 * lda, lda};
            RowLoader bl{wb + (size_t)nt * 128 * K, K};
            gemm_kloop<4, 4>(acc, al, bl, K / 64, lds);
#pragma unroll
            for (int i = 0; i < 4; ++i)
#pragma unroll
                for (int j = 0; j < 4; ++j) yb[i][j] = pk4(acc[i][j]);
        }
        {
            f32x4 acc[4][4]; acc_zero<4, 4>(acc);
            RowLoader al{(const u16*)(p.ws + OFF_H) + (size_t)mt * 128 * 1024, 1024};
            RowLoader bl{(const u16*)(wne + WNE_WGATE) + (size_t)(br * 1024 + nt * 128) * 1024, 1024};
            gemm_kloop<4, 4>(acc, al, bl, 16, lds);
#pragma unroll
            for (int i = 0; i < 4; ++i)
#pragma unroll
                for (int j = 0; j < 4; ++j) {
                    const int m = mt * 128 + wm * 64 + i * 16 + fr, n = nt * 128 + wn * 64 + j * 16 + fg * 4;
                    const f32x4 bg = *(const f32x4*)(bgate + br * 1024 + n);
                    const f32x4 yv = unpk4(yb[i][j]);
                    f32x4 tv = (f32x4){0.f, 0.f, 0.f, 0.f};
                    if (br > 0) tv = unpk4(*(const uint2*)(merged + (size_t)m * 1024 + n));
#pragma unroll
                    for (int q = 0; q < 4; ++q) tv[q] += sigmoidf_(acc[i][j][q] + bg[q]) * yv[q];
                    *(uint2*)(merged + (size_t)m * 1024 + n) = pk4(tv);
                }
        }
    }
}

__device__ void outproj_unit(const Params& p, int l, int u, char* lds) {
    const int mt = u >> 3, nt = u & 7;
    const int lane = threadIdx.x & 63, w = threadIdx.x >> 6, wm = w >> 1, wn = w & 1, fr = lane & 15, fg = lane >> 4;
    RowLoader al{(const u16*)(p.ws + OFF_MERGED) + (size_t)mt * 128 * 1024, 1024};
    RowLoader bl{(const u16*)(p.ws + OFF_WNE + (size_t)l * WNE_SZ + WNE_WOUT) + (size_t)nt * 128 * 1024, 1024};
    f32x4 acc[4][4]; acc_zero<4, 4>(acc);
    gemm_kloop<4, 4>(acc, al, bl, 16, lds);
    const float* xin = (l == 0) ? (const float*)p.in[0] : p.out;
#pragma unroll
    for (int i = 0; i < 4; ++i)
#pragma unroll
        for (int j = 0; j < 4; ++j) {
            const int m = mt * 128 + wm * 64 + i * 16 + fr, n = nt * 128 + wn * 64 + j * 16 + fg * 4;
            const f32x4 xo = *(const f32x4*)(xin + (size_t)m * 1024 + n);
            *(f32x4*)(p.out + (size_t)m * 1024 + n) = xo + acc[i][j];
        }
}

__device__ void router_unit(const Params& p, int l, int u, char* lds) {
    const int tid = threadIdx.x, lane = tid & 63, w = tid >> 6, wm = w >> 1, wn = w & 1, fr = lane & 15, fg = lane >> 4;
    const int tok0 = u * 128;
    const float* g = (const float*)p.in[33] + (size_t)l * 1024;
    for (int r = 0; r < 32; ++r) {
        const int row = tok0 + w * 32 + r;
        const float4* xr = (const float4*)(p.out + (size_t)row * 1024);
        float4 v[4]; float ss = 0.f;
#pragma unroll
        for (int i = 0; i < 4; ++i) { v[i] = xr[lane + 64 * i]; ss += v[i].x * v[i].x + v[i].y * v[i].y + v[i].z * v[i].z + v[i].w * v[i].w; }
        ss = wavesum(ss);
        const float rinv = rsqrtf(ss * (1.f / 1024.f) + 1e-6f);
#pragma unroll
        for (int i = 0; i < 4; ++i) {
            const float4 gg = ((const float4*)g)[lane + 64 * i];
            ((uint2*)(p.ws + OFF_H + (size_t)row * 2048))[lane + 64 * i] = make_uint2(pk_bf16(v[i].x * rinv * gg.x, v[i].y * rinv * gg.y), pk_bf16(v[i].z * rinv * gg.z, v[i].w * rinv * gg.w));
        }
    }
    asm volatile("s_waitcnt vmcnt(0)" ::: "memory");
    __syncthreads();
    RowLoader al{(const u16*)(p.ws + OFF_H) + (size_t)tok0 * 1024, 1024};
    RowLoader bl{(const u16*)(p.ws + OFF_WNE + (size_t)l * WNE_SZ + WNE_WR), 1024};
    f32x4 acc[4][4]; acc_zero<4, 4>(acc);
    gemm_kloop<4, 4>(acc, al, bl, 16, lds);
    float* lg = (float*)lds;
    int* hist = (int*)(lds + 16384); int* base = hist + 32; int* cls = base + 32;
    if (wn == 0) {
#pragma unroll
        for (int i = 0; i < 4; ++i)
#pragma unroll
            for (int j = 0; j < 2; ++j) { const int m = wm * 64 + i * 16 + fr, n = j * 16 + fg * 4; *(f32x4*)(lg + m * 32 + n) = acc[i][j]; }
    }
    if (tid < 32) hist[tid] = 0;
    __syncthreads();
    float c_lo = 0.f, c_hi = 0.f; int c = 0, rank = 0;
    if (tid < 128) {
        const float* rgb = (const float*)p.in[35] + (size_t)l * 4; const float* reb = (const float*)p.in[37] + (size_t)l * 16;
        float gl[4]; int gi = 0;
#pragma unroll
        for (int q = 0; q < 4; ++q) { gl[q] = lg[tid * 32 + q] + rgb[q]; if (gl[q] > gl[gi]) gi = q; }
        float den = 0.f;
#pragma unroll
        for (int q = 0; q < 4; ++q) den += __expf(gl[q] - gl[gi]);
        const float gp = 1.f / den;
        float el[4];
#pragma unroll
        for (int q = 0; q < 4; ++q) {
            float v = 0.f;
#pragma unroll
            for (int gg = 0; gg < 4; ++gg) v = (gg == gi) ? (lg[tid * 32 + 4 + gg * 4 + q] + reb[gg * 4 + q]) : v;
            el[q] = v;
        }
        int i1 = 0;
#pragma unroll
        for (int q = 1; q < 4; ++q) if (el[q] > el[i1]) i1 = q;
        int i2 = (i1 == 0) ? 1 : 0;
#pragma unroll
        for (int q = 0; q < 4; ++q) if (q != i1 && el[q] > el[i2]) i2 = q;
        const float w1 = 1.f / (1.f + __expf(el[i2] - el[i1])), w2 = 1.f - w1;
        const int lo = i1 < i2 ? i1 : i2, hi = i1 < i2 ? i2 : i1;
        c_lo = gp * (i1 < i2 ? w1 : w2); c_hi = gp * (i1 < i2 ? w2 : w1);
        const int pidx = (lo == 0) ? (hi - 1) : (lo == 1 ? hi + 1 : 5);
        c = gi * 6 + pidx;
        rank = atomicAdd(&hist[c], 1);
    }
    __syncthreads();
    unsigned* cnt = (unsigned*)(p.ws + OFF_CTRL) + CT_CNT + l * 32;
    if (tid < 24) base[tid] = hist[tid] > 0 ? (int)atomicAdd(&cnt[tid], (unsigned)hist[tid]) : 0;
    __syncthreads();
    if (tid < 128) {
        const int slot = base[c] + rank;
        ((int*)(p.ws + OFF_PERM))[(size_t)c * 16384 + slot] = tok0 + tid;
        ((float2*)(p.ws + OFF_CW))[(size_t)c * 16384 + slot] = make_float2(c_lo, c_hi);
    }
    __syncthreads();
}

struct ClsInfo { int cls, rt, cnt, segrow, elo, ehi; };
__device__ __forceinline__ int moe_setup(const Params& p, int l, int* tab) {
    if (threadIdx.x == 0) {
        const unsigned* cnt = (const unsigned*)(p.ws + OFF_CTRL) + CT_CNT + l * 32;
        int tot = 0;
        for (int c = 0; c < 24; ++c) { const int n = (int)__hip_atomic_load(&cnt[c], __ATOMIC_RELAXED, __HIP_MEMORY_SCOPE_AGENT); tab[24 + c] = n; tab[c] = (n + 127) >> 7; tot += tab[c]; }
        tab[48] = tot;
    }
    __syncthreads();
    return tab[48];
}
__device__ __forceinline__ ClsInfo moe_find(const int* tab, int gt) {
    ClsInfo ci; int c = 0, seg = 0;
    while (c < 23 && gt >= tab[c]) { gt -= tab[c]; seg += tab[c]; ++c; }
    ci.cls = c; ci.rt = gt; ci.cnt = tab[24 + c]; ci.segrow = seg * 128;
    const int gi = c / 6, pi = c % 6;
    const int lo = pi < 3 ? 0 : (pi < 5 ? 1 : 2), hi = pi < 3 ? pi + 1 : (pi < 5 ? pi - 1 : 3);
    ci.elo = gi * 4 + lo; ci.ehi = gi * 4 + hi;
    return ci;
}
struct GatherLoader {
    const u16* base; int tok[4];
    __device__ __forceinline__ void operator()(int kt, uint4 (&r)[4]) const {
        const int ck = threadIdx.x & 7;
#pragma unroll
        for (int i = 0; i < 4; ++i) r[i] = *(const uint4*)(base + (size_t)tok[i] * 1024 + kt * 64 + ck * 8);
    }
};
struct GateUpLoader {
    const u16* gsrc; const u16* usrc;
    __device__ __forceinline__ void operator()(int kt, uint4 (&r)[4]) const {
        const int r0 = threadIdx.x >> 3, ck = threadIdx.x & 7;
#pragma unroll
        for (int i = 0; i < 4; ++i) { const int rr = r0 + 32 * i; const u16* s = (rr < 64) ? (gsrc + (size_t)rr * 1024) : (usrc + (size_t)(rr - 64) * 1024); r[i] = *(const uint4*)(s + kt * 64 + ck * 8); }
    }
};
struct DownLoader {
    const u16* lo; const u16* hi;
    __device__ __forceinline__ void operator()(int kt, uint4 (&r)[4]) const {
        const int r0 = threadIdx.x >> 3, ck = threadIdx.x & 7;
        const u16* s = (kt < 8) ? lo : hi;
#pragma unroll
        for (int i = 0; i < 4; ++i) r[i] = *(const uint4*)(s + (size_t)(r0 + 32 * i) * 512 + (kt & 7) * 64 + ck * 8);
    }
};
__device__ void moe_up_phase(const Params& p, int l, char* lds) {
    int* tab = (int*)(lds + LDS_BYTES - 512);
    const int ntiles = moe_setup(p, l, tab);
    const int tid = threadIdx.x, lane = tid & 63, w = tid >> 6, fr = lane & 15, fg = lane >> 4;
    const u16* wexp = (const u16*)(p.ws + OFF_R + R_WEXP);
    const int* perm = (const int*)(p.ws + OFF_PERM); const float2* cw = (const float2*)(p.ws + OFF_CW);
    u16* hid = (u16*)(p.ws + OFF_R + R_HID);
    for (int u = blockIdx.x; u < ntiles * 16; u += gridDim.x) {
        const int gt = u >> 4, nt = u & 15;
        const ClsInfo ci = moe_find(tab, gt);
        const int hc0 = nt * 64; const int e = hc0 < 512 ? ci.elo : ci.ehi; const int sel = hc0 < 512 ? 0 : 1;
        GatherLoader al; al.base = (const u16*)(p.ws + OFF_H);
#pragma unroll
        for (int i = 0; i < 4; ++i) { int s = ci.rt * 128 + (tid >> 3) + 32 * i; s = s < ci.cnt ? s : ci.cnt - 1; al.tok[i] = perm[(size_t)ci.cls * 16384 + s]; }
        GateUpLoader bl{wexp + ((size_t)e * 512 + (hc0 & 511)) * 1024, wexp + (size_t)16 * 512 * 1024 + ((size_t)e * 512 + (hc0 & 511)) * 1024};
        f32x4 acc[2][8]; acc_zero<2, 8>(acc);
        gemm_kloop<2, 8>(acc, al, bl, 16, lds);
#pragma unroll
        for (int i = 0; i < 2; ++i) {
            const int slot = ci.rt * 128 + w * 32 + i * 16 + fr;
            if (slot < ci.cnt) {
                const float2 cc = cw[(size_t)ci.cls * 16384 + slot]; const float cwv = sel ? cc.y : cc.x;
#pragma unroll
                for (int j = 0; j < 4; ++j) {
                    f32x4 hv;
#pragma unroll
                    for (int q = 0; q < 4; ++q) { const float gq = acc[i][j][q]; hv[q] = gq * sigmoidf_(gq) * acc[i][j + 4][q] * cwv; }
                    *(uint2*)(hid + (size_t)(ci.segrow + slot) * 1024 + hc0 + j * 16 + fg * 4) = pk4(hv);
                }
            }
        }
    }
}
__device__ void moe_down_phase(const Params& p, int l, char* lds) {
    int* tab = (int*)(lds + LDS_BYTES - 512);
    const int ntiles = moe_setup(p, l, tab);
    const int tid = threadIdx.x, lane = tid & 63, w = tid >> 6, wm = w >> 1, wn = w & 1, fr = lane & 15, fg = lane >> 4;
    const u16* wdown = (const u16*)(p.ws + OFF_R + R_WEXP) + (size_t)2 * 16 * 512 * 1024;
    const int* perm = (const int*)(p.ws + OFF_PERM);
    const u16* hid = (const u16*)(p.ws + OFF_R + R_HID);
    for (int u = blockIdx.x; u < ntiles * 8; u += gridDim.x) {
        const int gt = u >> 3, nt = u & 7;
        const ClsInfo ci = moe_find(tab, gt);
        RowLoader al{hid + (size_t)(ci.segrow + ci.rt * 128) * 1024, 1024};
        DownLoader bl{wdown + ((size_t)ci.elo * 1024 + nt * 128) * 512, wdown + ((size_t)ci.ehi * 1024 + nt * 128) * 512};
        f32x4 acc[4][4]; acc_zero<4, 4>(acc);
        gemm_kloop<4, 4>(acc, al, bl, 16, lds);
#pragma unroll
        for (int i = 0; i < 4; ++i) {
            const int slot = ci.rt * 128 + wm * 64 + i * 16 + fr;
            if (slot < ci.cnt) {
                const int tok = perm[(size_t)ci.cls * 16384 + slot];
#pragma unroll
                for (int j = 0; j < 4; ++j) {
                    float* px = p.out + (size_t)tok * 1024 + nt * 128 + wn * 64 + j * 16 + fg * 4;
                    *(f32x4*)px = *(const f32x4*)px + acc[i][j];
                }
            }
        }
    }
}

template <int S>
__device__ __forceinline__ void run_stage(const Params& p, int l, char* lds) {
    const int G = gridDim.x, bid = blockIdx.x;
    if (S == 100) { phase_conv_ne(p, lds); }
    else if (S == 101) { phase_norm<true>(p, p.out, (const float*)p.in[41]); }
    else if (S == 0) { phase_norm<false>(p, l == 0 ? (const float*)p.in[0] : p.out, (const float*)p.in[2] + (size_t)l * 1024); }
    else if (S == 1) { for (int u = bid; u < 128 * 17; u += G) gemm2a_unit(p, l, u, lds); }
    else if (S == 2) { for (int u = bid; u < 1024; u += G) prep_unit(p, l, u); }
    else if (S == 3) {
        const int nscan = G >= 512 ? 256 : G / 2;
        if (bid < nscan) { for (int u = bid; u < 256; u += nscan) scan_unit(p, l, u); }
        else { for (int u = bid - nscan; u < 128 * 26; u += G - nscan) gemm2b_unit(p, l, u, lds); }
    }
    else if (S == 4) { for (int u = bid; u < 512 + 1536; u += G) { if (u < 512) mixa_unit(p, l, u, lds); else attn_unit(p, u - 512, lds); } }
    else if (S == 5) { phase_post(p, l); }
    else if (S == 6) { for (int u = bid; u < 1024; u += G) merge_unit(p, l, u, lds); }
    else if (S == 7) { for (int u = bid; u < 1024 + 6144; u += G) { if (u < 1024) outproj_unit(p, l, u, lds); else conv_expert_unit(p, l, u - 1024, lds); } }
    else if (S == 8) { for (int u = bid; u < 128; u += G) router_unit(p, l, u, lds); }
    else if (S == 9) { moe_up_phase(p, l, lds); }
    else if (S == 10) { moe_down_phase(p, l, lds); }
}

template <int S>
__global__ void __launch_bounds__(256, 2) stage_kernel(Params p, int l) {
    __shared__ __attribute__((aligned(16))) char lds[LDS_BYTES + 16];
    run_stage<S>(p, l, lds);
}

#if MK_FUSED
__global__ void __launch_bounds__(256, 2) mega_kernel(Params p) {
    __shared__ __attribute__((aligned(16))) char lds[LDS_BYTES + 16];
    volatile LAS unsigned* st = (volatile LAS unsigned*)(lds + LDS_BYTES);
    if (threadIdx.x == 0) { st[0] = 0u; st[1] = 0u; st[2] = 0u; st[3] = 0u; }
    __syncthreads();
    XcdBarrier xb = xcd_barrier_post((unsigned*)(p.ws + OFF_CTRL), st);
    run_stage<100>(p, 0, lds); xcd_barrier(xb);
#pragma unroll 1
    for (int l = 0; l < 2; ++l) {
        run_stage<0>(p, l, lds); xcd_barrier(xb);
        run_stage<1>(p, l, lds); xcd_barrier(xb);
        run_stage<2>(p, l, lds); xcd_barrier(xb);
        run_stage<3>(p, l, lds); xcd_barrier(xb);
        run_stage<4>(p, l, lds); xcd_barrier(xb);
        run_stage<5>(p, l, lds); xcd_barrier(xb);
        run_stage<6>(p, l, lds); xcd_barrier(xb);
        run_stage<7>(p, l, lds); xcd_barrier(xb);
        run_stage<8>(p, l, lds); xcd_barrier(xb);
        run_stage<9>(p, l, lds); xcd_barrier(xb);
        run_stage<10>(p, l, lds); xcd_barrier(xb);
    }
    run_stage<101>(p, 0, lds);
}
#endif

#ifndef DBG
#define DBG 0
#endif
__global__ void dump_kernel(const u16* src, size_t stride, int width, float* out) {
    const size_t i = (size_t)blockIdx.x * 256 + threadIdx.x;
    const size_t tok = i >> 10; const int c = (int)(i & 1023);
    out[i] = bf2f(src[tok * stride + (c % width)]);
}
#define DUMP(off, stride, width) dump_kernel<<<dim3(NTOK * 1024 / 256), dim3(256), 0, stream>>>((const u16*)((char*)d_ws + (off)), stride, width, (float*)d_out)
#define LAUNCH_STAGE(S, l) stage_kernel<S><<<dim3(grid_blocks), dim3(256), 0, stream>>>(p, l)
extern "C" void kernel_launch(void* const* d_in, const int* in_sizes, int n_in, void* d_out, int out_size, void* d_ws, size_t ws_size, hipStream_t stream) {
    static int grid_blocks = 0;
    if (!grid_blocks) {
        int dev = 0, cus = 0, per_cu = 2;
        (void)hipGetDevice(&dev);
        (void)hipDeviceGetAttribute(&cus, hipDeviceAttributeMultiprocessorCount, dev);
#if MK_FUSED
        (void)hipOccupancyMaxActiveBlocksPerMultiprocessor(&per_cu, mega_kernel, 256, 0);
        if (per_cu > 2) per_cu = 2;
        if (per_cu < 1) per_cu = 1;
#endif
        if (cus <= 0) cus = 256;
        grid_blocks = cus * per_cu;
    }
    if (ws_size < OFF_END || n_in < 42) { fprintf(stderr, "workspace too small or bad inputs\n"); return; }
    Params p{};
    for (int i = 0; i < 42; ++i) p.in[i] = d_in[i];
    p.out = (float*)d_out; p.ws = (char*)d_ws;
    (void)hipMemsetAsync(d_ws, 0, 65536, stream);
#if MK_FUSED
    void* args[] = {&p};
    hipError_t e = hipLaunchCooperativeKernel((void*)mega_kernel, dim3(grid_blocks), dim3(256), args, 0, stream);
    if (e != hipSuccess) fprintf(stderr, "cooperative launch failed: %s (grid %d)\n", hipGetErrorString(e), grid_blocks);
#else
    LAUNCH_STAGE(100, 0);
    for (int l = 0; l < 2; ++l) {
        LAUNCH_STAGE(0, l); LAUNCH_STAGE(1, l);
        if (DBG == 1) { DUMP(OFF_R + R_PROJC, 1536, 1024); return; }
        LAUNCH_STAGE(2, l);
        if (DBG == 2) { DUMP(OFF_KR, 1024, 1024); return; }
        LAUNCH_STAGE(3, l);
        if (DBG == 3) { DUMP(OFF_YRAW, 512, 512); return; }
        if (DBG == 4) { DUMP(OFF_R + R_PROJB, 2304, 1024); return; }
        LAUNCH_STAGE(4, l);
        if (DBG == 5) { DUMP(OFF_R + R_PROJB, 2304, 1024); return; }
        if (DBG == 6) { DUMP(OFF_R + R_PROJA, 1024, 512); return; }
        LAUNCH_STAGE(5, l);
        if (DBG == 10) { DUMP(OFF_G, 512, 512); return; }
        if (DBG == 11) { DUMP(OFF_R + R_PROJB + 768 * 2, 2304, 256); return; }
        LAUNCH_STAGE(6, l);
        if (DBG == 7) { DUMP(OFF_MERGED, 1024, 1024); return; }
        LAUNCH_STAGE(7, l);
        if (DBG == 8) return;
        LAUNCH_STAGE(8, l); LAUNCH_STAGE(9, l); LAUNCH_STAGE(10, l);
        if (DBG == 9) return;
    }
    LAUNCH_STAGE(101, 0);
#endif
}
```

```cpp
#include <hip/hip_runtime.h>
#include <hip/hip_cooperative_groups.h>
#include <stdint.h>
#include <cstdio>

#ifndef MK_FUSED
#define MK_FUSED 1
#endif

typedef short bf16x8 __attribute__((ext_vector_type(8)));
typedef short bf16x4 __attribute__((ext_vector_type(4)));
typedef float f32x4 __attribute__((ext_vector_type(4)));
typedef __bf16 bf2_t __attribute__((ext_vector_type(2)));
typedef short v4i16_t __attribute__((ext_vector_type(4)));
typedef _Float16 h2_t __attribute__((ext_vector_type(2)));
typedef unsigned short u16;
#define LAS __attribute__((address_space(3)))

constexpr int NTOK = 16384, DM = 1024, SEQ = 2048;
constexpr int NPH = 24;
constexpr int LDS_BYTES = 66 * 1024;

constexpr size_t OFF_CTRL = 0;
constexpr size_t OFF_ROT  = 65536;
constexpr size_t OFF_WNE  = OFF_ROT + 2 * (size_t)NTOK * 8 * 4;
constexpr size_t WNE_WTC = 0, WNE_WTAB = 4456448, WNE_WGATE = 11272192, WNE_WBRA = 17563648, WNE_WBRB = 18612224,
                 WNE_WBRC = 19136512, WNE_WOUT = 20185088, WNE_W2T = 22282240, WNE_A2T = 22347776, WNE_G2T = 22413312,
                 WNE_V2T = 22544384, WNE_WR = 22577152, WNE_SZ = 22839296;
constexpr size_t OFF_H    = OFF_WNE + 2 * WNE_SZ;
constexpr size_t OFF_V    = OFF_H + (size_t)NTOK * 1024 * 2;
constexpr size_t OFF_KR   = OFF_V + 2 * (size_t)NTOK * 512 * 2;
constexpr size_t OFF_BK   = OFF_KR + (size_t)NTOK * 2048;
constexpr size_t OFF_W    = OFF_BK + (size_t)NTOK * 2048;
constexpr size_t OFF_G    = OFF_W + (size_t)NTOK * 1024;
constexpr size_t OFF_YRAW = OFF_G + (size_t)NTOK * 1024;
constexpr size_t OFF_BONUS= OFF_YRAW + (size_t)NTOK * 1024;
constexpr size_t OFF_LSE  = OFF_BONUS + (size_t)NTOK * 32;
constexpr size_t OFF_R    = OFF_LSE + (size_t)3 * NTOK * 16;
constexpr size_t R_PROJA = 0;
constexpr size_t R_PROJB = (size_t)NTOK * 2048;
constexpr size_t R_PROJC = 0;
constexpr size_t R_LORA1 = (size_t)NTOK * 3072;
constexpr size_t R_WEXP  = 0;
constexpr size_t R_HID   = 50331648;
constexpr size_t R_SZ    = (size_t)NTOK * (2048 + 4608);
constexpr size_t OFF_END  = OFF_R + R_SZ;
constexpr size_t OFF_MERGED = OFF_KR;
constexpr size_t OFF_PERM = OFF_BK;
constexpr size_t OFF_CW   = OFF_BK + (size_t)24 * 16384 * 4;
static_assert(OFF_END <= 356000000, "workspace too large");
static_assert(R_HID + (size_t)19456 * 2048 <= R_SZ, "R region");
constexpr int CT_CNT = 8192;

struct Params {
    const void* in[42];
    float* out;
    char* ws;
    int pad0, pad1;
};

typedef float f2_t __attribute__((ext_vector_type(2)));
__device__ __forceinline__ unsigned pk_bf16(float lo, float hi) { f2_t f; f[0] = lo; f[1] = hi; return __builtin_bit_cast(unsigned, __builtin_convertvector(f, bf2_t)); }
__device__ __forceinline__ float bflo(unsigned u) { return __uint_as_float(u << 16); }
__device__ __forceinline__ float bfhi(unsigned u) { return __uint_as_float(u & 0xffff0000u); }
__device__ __forceinline__ float bf2f(u16 h) { return __uint_as_float(((unsigned)h) << 16); }
__device__ __forceinline__ u16 f2bf(float f) { return (u16)(pk_bf16(f, 0.f) & 0xffffu); }
__device__ __forceinline__ uint2 pk4(f32x4 v) { return make_uint2(pk_bf16(v[0], v[1]), pk_bf16(v[2], v[3])); }
__device__ __forceinline__ f32x4 unpk4(uint2 u) { f32x4 r; r[0] = bflo(u.x); r[1] = bfhi(u.x); r[2] = bflo(u.y); r[3] = bfhi(u.y); return r; }
__device__ __forceinline__ float sigmoidf_(float x) { return 1.f / (1.f + __expf(-x)); }
__device__ __forceinline__ float gelu_tanh(float x) { const float z = 0.7978845608028654f * (x + 0.044715f * x * x * x); return x / (1.f + __expf(-2.f * z)); }
__device__ __forceinline__ float dot2bf(unsigned a, unsigned b, float c) { return __builtin_amdgcn_fdot2_f32_bf16(__builtin_bit_cast(bf2_t, a), __builtin_bit_cast(bf2_t, b), c, false); }
template <int CTRL> __device__ __forceinline__ float dpp_f(float x) { return __builtin_bit_cast(float, __builtin_amdgcn_update_dpp(0, __builtin_bit_cast(int, x), CTRL, 0xf, 0xf, false)); }
__device__ __forceinline__ float rowsum16(float x) { x += dpp_f<0x128>(x); x += dpp_f<0x124>(x); x += dpp_f<0x122>(x); x += dpp_f<0x121>(x); return x; }
__device__ __forceinline__ float wavesum(float x) { x += __shfl_xor(x, 32); x += __shfl_xor(x, 16); x += __shfl_xor(x, 8); x += __shfl_xor(x, 4); x += __shfl_xor(x, 2); x += __shfl_xor(x, 1); return x; }
__device__ __forceinline__ bf16x8 mk8(uint4 u) { return __builtin_bit_cast(bf16x8, u); }
#define MFMA16(a, b, c) __builtin_amdgcn_mfma_f32_16x16x32_bf16(a, b, c, 0, 0, 0)

#define XB_TMO      128
#define XB_XCNT(j)  (256  + 64 * (j))
#define XB_XSUB(j)  (1280 + 64 * (j))
#define XB_XGEN(j)  (2304 + 64 * (j))
#define XB_TOP      3328
#define XB_TOPGEN   3392
#define XCD_BAR_WORDS 3456
#define XB_SPIN_CAP (1u << 22)
__device__ __forceinline__ unsigned xb_ld(unsigned* p)              { return __hip_atomic_load(p, __ATOMIC_RELAXED, __HIP_MEMORY_SCOPE_AGENT); }
__device__ __forceinline__ unsigned xb_add(unsigned* p, unsigned v) { return __hip_atomic_fetch_add(p, v, __ATOMIC_RELAXED, __HIP_MEMORY_SCOPE_AGENT); }
__device__ __forceinline__ unsigned xb_xcc_id() { return (unsigned)__builtin_amdgcn_s_getreg((3 << 11) | 20) & 0xFu; }
#define XB_SPIN(cond, bar) do { unsigned _sp = 0; while (cond) { __builtin_amdgcn_s_sleep(1); \
    if ((++_sp & 255u) == 0u) { if (xb_ld(&(bar)[XB_TMO])) break; if (_sp > XB_SPIN_CAP) { atomicAdd(&(bar)[XB_TMO], 1u); break; } } } } while (0)
struct XcdBarrier { unsigned* bar; unsigned x; volatile LAS unsigned* st; };
__device__ __forceinline__ XcdBarrier xcd_barrier_post(unsigned* bar, volatile LAS unsigned* st) {
    XcdBarrier b; b.bar = bar; b.x = xb_xcc_id(); b.st = st;
    if (threadIdx.x == 0) (void)xb_add(&bar[XB_XCNT(b.x)], 1u);
    return b;
}
__device__ __forceinline__ void xcd_barrier_complete(unsigned* bar, unsigned x, unsigned& nloc, unsigned& nx) {
    const unsigned G = gridDim.x * gridDim.y * gridDim.z;
    unsigned sum, cnt, mine, sp = 0u;
    for (;;) {
        sum = 0u; cnt = 0u; mine = 0u;
#pragma unroll
        for (unsigned j = 0; j < 16; ++j) { const unsigned c = xb_ld(&bar[XB_XCNT(j)]); sum += c; cnt += (c > 0u) ? 1u : 0u; mine = (j == x) ? c : mine; }
        if (sum == G) break;
        __builtin_amdgcn_s_sleep(1);
        if ((++sp & 255u) == 0u) { if (xb_ld(&bar[XB_TMO])) break; if (sp > XB_SPIN_CAP) { atomicAdd(&bar[XB_TMO], 1u); break; } }
    }
    nloc = mine > 0u ? mine : 1u; nx = cnt > 0u ? cnt : 1u;
}
__device__ __forceinline__ void xcd_barrier(const XcdBarrier& b) {
    asm volatile("s_waitcnt vmcnt(0)" ::: "memory");
    __syncthreads();
    if (threadIdx.x == 0) {
        unsigned* bar = b.bar;
        __builtin_amdgcn_s_waitcnt(0);
        unsigned nloc = b.st[0], nx = b.st[1];
        if (nloc == 0u) { xcd_barrier_complete(bar, b.x, nloc, nx); b.st[0] = nloc; b.st[1] = nx; }
        const unsigned old = xb_add(&bar[XB_XSUB(b.x)], 1u);
        const unsigned gen = old / nloc;
        if (old + 1u == (gen + 1u) * nloc) {
            __builtin_amdgcn_fence(__ATOMIC_RELEASE, "agent");
            asm volatile("s_waitcnt vmcnt(0)" ::: "memory");
            const unsigned og = xb_add(&bar[XB_TOP], 1u);
            const unsigned tg = og / nx;
            if (og + 1u == (tg + 1u) * nx) xb_add(&bar[XB_TOPGEN], 1u);
            else XB_SPIN(xb_ld(&bar[XB_TOPGEN]) == tg, bar);
            __builtin_amdgcn_fence(__ATOMIC_ACQUIRE, "agent");
            xb_add(&bar[XB_XGEN(b.x)], 1u);
            asm volatile("s_waitcnt vmcnt(0)" ::: "memory");
        } else {
            XB_SPIN(xb_ld(&bar[XB_XGEN(b.x)]) == gen, bar);
            __builtin_amdgcn_fence(__ATOMIC_ACQUIRE, "agent");
            asm volatile("s_waitcnt vmcnt(0)" ::: "memory");
        }
    }
    __syncthreads();
}

__device__ __forceinline__ int toff(int row, int chunk) { return row * 128 + ((chunk ^ ((row >> 1) & 7)) << 4); }

template <int MT, int NT, class AL, class BL>
__device__ __forceinline__ void gemm_kloop(f32x4 (&acc)[MT][NT], const AL& al, const BL& bl, int nk, char* lds) {
    const int tid = threadIdx.x, lane = tid & 63, w = tid >> 6;
    const int wm = (MT == 4) ? (w >> 1) : w, wn = (MT == 4) ? (w & 1) : 0;
    const int r0 = tid >> 3, ck = tid & 7;
    const int fr = lane & 15, fg = lane >> 4;
    uint4 ra0 = al(0, 0), ra1 = al(0, 1), ra2 = al(0, 2), ra3 = al(0, 3);
    uint4 rb0 = bl(0, 0), rb1 = bl(0, 1), rb2 = bl(0, 2), rb3 = bl(0, 3);
    const int so0 = toff(r0, ck), so1 = toff(r0 + 32, ck), so2 = toff(r0 + 64, ck), so3 = toff(r0 + 96, ck);
    *(uint4*)(lds + so0) = ra0; *(uint4*)(lds + so1) = ra1; *(uint4*)(lds + so2) = ra2; *(uint4*)(lds + so3) = ra3;
    *(uint4*)(lds + 16384 + so0) = rb0; *(uint4*)(lds + 16384 + so1) = rb1; *(uint4*)(lds + 16384 + so2) = rb2; *(uint4*)(lds + 16384 + so3) = rb3;
    __syncthreads();
    for (int kt = 0; kt < nk; ++kt) {
        char* cA = lds + (kt & 1) * 32768; char* cB = cA + 16384;
        if (kt + 1 < nk) {
            ra0 = al(kt + 1, 0); ra1 = al(kt + 1, 1); ra2 = al(kt + 1, 2); ra3 = al(kt + 1, 3);
            rb0 = bl(kt + 1, 0); rb1 = bl(kt + 1, 1); rb2 = bl(kt + 1, 2); rb3 = bl(kt + 1, 3);
        }
#pragma unroll
        for (int s = 0; s < 2; ++s) {
            bf16x8 af[MT], bfr[NT];
#pragma unroll
            for (int i = 0; i < MT; ++i) af[i] = *(const bf16x8*)(cA + toff(wm * MT * 16 + i * 16 + fr, s * 4 + fg));
#pragma unroll
            for (int j = 0; j < NT; ++j) bfr[j] = *(const bf16x8*)(cB + toff(wn * NT * 16 + j * 16 + fr, s * 4 + fg));
#pragma unroll
            for (int i = 0; i < MT; ++i)
#pragma unroll
                for (int j = 0; j < NT; ++j) acc[i][j] = MFMA16(bfr[j], af[i], acc[i][j]);
        }
        if (kt + 1 < nk) {
            char* nA = lds + ((kt + 1) & 1) * 32768;
            *(uint4*)(nA + so0) = ra0; *(uint4*)(nA + so1) = ra1; *(uint4*)(nA + so2) = ra2; *(uint4*)(nA + so3) = ra3;
            *(uint4*)(nA + 16384 + so0) = rb0; *(uint4*)(nA + 16384 + so1) = rb1; *(uint4*)(nA + 16384 + so2) = rb2; *(uint4*)(nA + 16384 + so3) = rb3;
        }
        __syncthreads();
    }
}
template <int MT, int NT> __device__ __forceinline__ void acc_zero(f32x4 (&acc)[MT][NT]) {
#pragma unroll
    for (int i = 0; i < MT; ++i)
#pragma unroll
        for (int j = 0; j < NT; ++j) acc[i][j] = (f32x4){0.f, 0.f, 0.f, 0.f};
}
struct RowLoader {
    const u16* base; int ld;
    __device__ __forceinline__ uint4 operator()(int kt, int i) const {
        const int r0 = threadIdx.x >> 3, ck = threadIdx.x & 7;
        return *(const uint4*)(base + (size_t)(r0 + 32 * i) * ld + kt * 64 + ck * 8);
    }
};

struct ConvJob { const float* src; int ldsrc; int K; int nc; u16* dst; int ldd; const float* scale; int smode; };
__device__ __forceinline__ void conv_tile(const ConvJob& jb, int tk, int tn, char* lds) {
    float* T = (float*)lds;
    const int tid = threadIdx.x;
    const int k0 = tk * 64, n0 = tn * 64;
    {
        const int nl = tid & 63, kb = tid >> 6;
#pragma unroll
        for (int i = 0; i < 16; ++i) {
            const int kl = kb + 4 * i; const int k = k0 + kl, n = n0 + nl;
            float v = 0.f;
            if (jb.src != nullptr && k < jb.K && n < jb.nc) {
                v = jb.src[(size_t)k * jb.ldsrc + n];
                if (jb.smode == 1) v *= (1.f - jb.scale[k]); else if (jb.smode == 2) v *= jb.scale[k];
            }
            T[kl * 65 + nl] = v;
        }
    }
    __syncthreads();
    {
        const int kp = tid & 31, nb = tid >> 5;
#pragma unroll
        for (int i = 0; i < 8; ++i) {
            const int nl = nb + 8 * i; const int n = n0 + nl, k = k0 + 2 * kp;
            if (n < jb.nc && k < jb.K) {
                const unsigned pv = pk_bf16(T[(2 * kp) * 65 + nl], T[(2 * kp + 1) * 65 + nl]);
                *(unsigned*)(jb.dst + (size_t)n * jb.ldd + k) = pv;
            }
        }
    }
    __syncthreads();
}
constexpr int NE_JOBS = 23;
__device__ __forceinline__ void ne_job_dims(int j, int& K, int& nc) {
    K = 1024; nc = 64;
    switch (j) {
        case 0: nc = 1536; break; case 1: case 2: case 5: case 6: nc = 64; break; case 3: case 7: nc = 128; break; case 4: case 8: nc = 32; break;
        case 9: nc = 64; break; case 10: nc = 3328; break; case 11: nc = 3072; break; case 12: K = 512; nc = 1024; break; case 13: K = 256; nc = 1024; break;
        case 14: K = 512; nc = 1024; break; case 15: nc = 1024; break; case 16: case 17: K = 64; nc = 512; break; case 18: K = 128; nc = 512; break;
        case 19: K = 32; nc = 512; break; case 20: nc = 4; break; case 21: nc = 16; break; case 22: nc = 108; break;
    }
}
__device__ __forceinline__ void ne_job(const Params& p, int l, int j, ConvJob& jb) {
    char* wne = p.ws + OFF_WNE + (size_t)l * WNE_SZ;
    int K, nc; ne_job_dims(j, K, nc);
    jb.K = K; jb.nc = nc; jb.scale = nullptr; jb.smode = 0; jb.ldd = K; jb.src = nullptr; jb.ldsrc = nc; jb.dst = (u16*)wne;
    const float* w_in = (const float*)p.in[3] + (size_t)l * 1024 * 4864;
    const float* muwag = (const float*)p.in[9] + (size_t)l * 3 * 1024;
    const float* muv = (const float*)p.in[23];
    u16* wtc = (u16*)(wne + WNE_WTC);
    switch (j) {
        case 0: jb.src = w_in + 3328; jb.ldsrc = 4864; jb.dst = wtc; break;
        case 1: jb.src = (const float*)p.in[11] + (size_t)l * 1024 * 64; jb.dst = wtc + 1536 * 1024; jb.scale = muwag; jb.smode = 1; break;
        case 2: jb.src = (const float*)p.in[14] + (size_t)l * 1024 * 64; jb.dst = wtc + 1600 * 1024; jb.scale = muwag + 1024; jb.smode = 1; break;
        case 3: jb.src = (const float*)p.in[16] + (size_t)l * 1024 * 128; jb.dst = wtc + 1664 * 1024; jb.scale = muwag + 2048; jb.smode = 1; break;
        case 4: jb.src = (l == 1) ? (const float*)p.in[25] : nullptr; jb.dst = wtc + 1792 * 1024; jb.scale = muv; jb.smode = 1; break;
        case 5: jb.src = (const float*)p.in[11] + (size_t)l * 1024 * 64; jb.dst = wtc + 1824 * 1024; jb.scale = muwag; jb.smode = 2; break;
        case 6: jb.src = (const float*)p.in[14] + (size_t)l * 1024 * 64; jb.dst = wtc + 1888 * 1024; jb.scale = muwag + 1024; jb.smode = 2; break;
        case 7: jb.src = (const float*)p.in[16] + (size_t)l * 1024 * 128; jb.dst = wtc + 1952 * 1024; jb.scale = muwag + 2048; jb.smode = 2; break;
        case 8: jb.src = (l == 1) ? (const float*)p.in[25] : nullptr; jb.dst = wtc + 2080 * 1024; jb.scale = muv; jb.smode = 2; break;
        case 9: jb.src = nullptr; jb.dst = wtc + 2112 * 1024; break;
        case 10: jb.src = w_in; jb.ldsrc = 4864; jb.dst = (u16*)(wne + WNE_WTAB); break;
        case 11: jb.src = (const float*)p.in[30] + (size_t)l * 1024 * 3072; jb.dst = (u16*)(wne + WNE_WGATE); break;
        case 12: jb.src = (const float*)p.in[27] + (size_t)l * 512 * 1024; jb.dst = (u16*)(wne + WNE_WBRA); break;
        case 13: jb.src = (const float*)p.in[28] + (size_t)l * 256 * 1024; jb.dst = (u16*)(wne + WNE_WBRB); break;
        case 14: jb.src = (const float*)p.in[29] + (size_t)l * 512 * 1024; jb.dst = (u16*)(wne + WNE_WBRC); break;
        case 15: jb.src = (const float*)p.in[32] + (size_t)l * 1024 * 1024; jb.dst = (u16*)(wne + WNE_WOUT); break;
        case 16: jb.src = (const float*)p.in[12] + (size_t)l * 64 * 512; jb.dst = (u16*)(wne + WNE_W2T); break;
        case 17: jb.src = (const float*)p.in[15] + (size_t)l * 64 * 512; jb.dst = (u16*)(wne + WNE_A2T); break;
        case 18: jb.src = (const float*)p.in[17] + (size_t)l * 128 * 512; jb.dst = (u16*)(wne + WNE_G2T); break;
        case 19: jb.src = (l == 1) ? (const float*)p.in[26] : nullptr; jb.dst = (u16*)(wne + WNE_V2T); break;
        case 20: jb.src = (const float*)p.in[34] + (size_t)l * 1024 * 4; jb.dst = (u16*)(wne + WNE_WR); break;
        case 21: jb.src = (const float*)p.in[36] + (size_t)l * 1024 * 16; jb.dst = (u16*)(wne + WNE_WR) + 4 * 1024; break;
        case 22: jb.src = nullptr; jb.dst = (u16*)(wne + WNE_WR) + 20 * 1024; break;
    }
}
__device__ __forceinline__ int ne_total_tiles() {
    int tot = 0;
#pragma unroll
    for (int j = 0; j < NE_JOBS; ++j) { int K, nc; ne_job_dims(j, K, nc); tot += ((K + 63) / 64) * ((nc + 63) / 64); }
    return tot;
}
__device__ void phase_conv_ne(const Params& p, char* lds) {
    const int per_layer = ne_total_tiles();
    const int nconv = 2 * per_layer;
    const int nrot = NTOK * 8 / 256;
    for (int u = blockIdx.x; u < nconv + nrot; u += gridDim.x) {
        if (u < nconv) {
            const int l = u / per_layer; int t = u % per_layer; int j = 0;
            for (; j < NE_JOBS; ++j) { int K, nc; ne_job_dims(j, K, nc); const int c = ((K + 63) / 64) * ((nc + 63) / 64); if (t < c) break; t -= c; }
            ConvJob jb; ne_job(p, l, j, jb);
            const int ntn = (jb.nc + 63) / 64;
            conv_tile(jb, t / ntn, t % ntn, lds);
        } else {
            const int e = (u - nconv) * 256 + threadIdx.x;
            const int tok = e >> 3, i = e & 7;
            const float pos = (float)((const int*)p.in[1])[tok];
            const float inv = __expf(-(float)i * (13.122363377404328f / 8.f));
            float sn, cs; sincosf(pos * inv, &sn, &cs);
            ((float*)(p.ws + OFF_ROT))[e] = cs;
            ((float*)(p.ws + OFF_ROT))[(size_t)NTOK * 8 + e] = sn;
        }
    }
}
__device__ __forceinline__ void conv_expert_unit(const Params& p, int l, int u, char* lds) {
    const int mat = u >> 11, e = (u & 2047) >> 7, tile = u & 127;
    ConvJob jb; jb.scale = nullptr; jb.smode = 0;
    u16* wexp = (u16*)(p.ws + OFF_R + R_WEXP);
    if (mat < 2) {
        jb.src = (const float*)p.in[38 + mat] + ((size_t)l * 16 + e) * 1024 * 512; jb.ldsrc = 512; jb.K = 1024; jb.nc = 512;
        jb.dst = wexp + (size_t)mat * 16 * 512 * 1024 + (size_t)e * 512 * 1024; jb.ldd = 1024;
        conv_tile(jb, tile >> 3, tile & 7, lds);
    } else {
        jb.src = (const float*)p.in[40] + ((size_t)l * 16 + e) * 512 * 1024; jb.ldsrc = 1024; jb.K = 512; jb.nc = 1024;
        jb.dst = wexp + (size_t)2 * 16 * 512 * 1024 + (size_t)e * 1024 * 512; jb.ldd = 512;
        conv_tile(jb, tile >> 4, tile & 15, lds);
    }
}

__device__ __forceinline__ int tid_opaque() { int t = threadIdx.x; asm volatile("" : "+v"(t)); return t; }
template <bool FINAL>
__device__ void phase_norm(const Params& p, const float* x, const float* g) {
    const int tid_ = tid_opaque();
    const int lane = tid_ & 63;
    const int gw = blockIdx.x * 4 + (tid_ >> 6);
    for (int row = gw; row < NTOK; row += gridDim.x * 4) {
        const float4* xr = (const float4*)(x + (size_t)row * 1024);
        float4 v[4]; float ss = 0.f;
#pragma unroll
        for (int i = 0; i < 4; ++i) { v[i] = xr[lane + 64 * i]; ss += v[i].x * v[i].x + v[i].y * v[i].y + v[i].z * v[i].z + v[i].w * v[i].w; }
        ss = wavesum(ss);
        const float rinv = rsqrtf(ss * (1.f / 1024.f) + 1e-6f);
#pragma unroll
        for (int i = 0; i < 4; ++i) {
            const float4 gg = ((const float4*)g)[lane + 64 * i];
            const float a = v[i].x * rinv * gg.x, b = v[i].y * rinv * gg.y, c = v[i].z * rinv * gg.z, d = v[i].w * rinv * gg.w;
            if (FINAL) ((float4*)(p.out + (size_t)row * 1024))[lane + 64 * i] = make_float4(a, b, c, d);
            else ((uint2*)(p.ws + OFF_H + (size_t)row * 2048))[lane + 64 * i] = make_uint2(pk_bf16(a, b), pk_bf16(c, d));
        }
    }
}

__device__ void gemm2a_unit(const Params& p, int l, int u, char* lds) {
    const int mt = u / 17, nt = u % 17;
    const int lane = threadIdx.x & 63, w = threadIdx.x >> 6, wm = w >> 1, wn = w & 1, fr = lane & 15, fg = lane >> 4;
    RowLoader al{(const u16*)(p.ws + OFF_H) + (size_t)mt * 128 * 1024, 1024};
    RowLoader bl{(const u16*)(p.ws + OFF_WNE + (size_t)l * WNE_SZ + WNE_WTC) + (size_t)nt * 128 * 1024, 1024};
    f32x4 acc[4][4]; acc_zero<4, 4>(acc);
    gemm_kloop<4, 4>(acc, al, bl, 16, lds);
    u16* projc = (u16*)(p.ws + OFF_R + R_PROJC); u16* lora1 = (u16*)(p.ws + OFF_R + R_LORA1);
#pragma unroll
    for (int i = 0; i < 4; ++i)
#pragma unroll
        for (int j = 0; j < 4; ++j) {
            const int m = mt * 128 + wm * 64 + i * 16 + fr, n = nt * 128 + wn * 64 + j * 16 + fg * 4;
            const uint2 v = pk4(acc[i][j]);
            if (n < 1536) *(uint2*)(projc + (size_t)m * 1536 + n) = v;
            else if (n < 2112) *(uint2*)(lora1 + (size_t)m * 576 + (n - 1536)) = v;
        }
}
__device__ void gemm2b_unit(const Params& p, int l, int u, char* lds) {
    const int mt = u / 26, nt = u % 26;
    const int lane = threadIdx.x & 63, w = threadIdx.x >> 6, wm = w >> 1, wn = w & 1, fr = lane & 15, fg = lane >> 4;
    RowLoader al{(const u16*)(p.ws + OFF_H) + (size_t)mt * 128 * 1024, 1024};
    RowLoader bl{(const u16*)(p.ws + OFF_WNE + (size_t)l * WNE_SZ + WNE_WTAB) + (size_t)nt * 128 * 1024, 1024};
    f32x4 acc[4][4]; acc_zero<4, 4>(acc);
    gemm_kloop<4, 4>(acc, al, bl, 16, lds);
    u16* proja = (u16*)(p.ws + OFF_R + R_PROJA); u16* projb = (u16*)(p.ws + OFF_R + R_PROJB);
    const float* rc = (const float*)(p.ws + OFF_ROT); const float* rs = rc + (size_t)NTOK * 8;
    const int nbase = nt * 128 + wn * 64;
#pragma unroll
    for (int i = 0; i < 4; ++i) {
        const int m = mt * 128 + wm * 64 + i * 16 + fr;
#pragma unroll
        for (int j = 0; j < 4; ++j) {
            const int n = nbase + j * 16 + fg * 4;
            f32x4 v = acc[i][j];
            if (nbase < 1024) {
#pragma unroll
                for (int q = 0; q < 4; ++q) v[q] = gelu_tanh(v[q]);
                *(uint2*)(proja + (size_t)m * 1024 + n) = pk4(v);
            } else {
                const int nb = n - 1024;
                if (nbase < 1024 + 1536 && j == 0) {
                    f32x4 pv;
#pragma unroll
                    for (int q = 0; q < 4; ++q) pv[q] = __shfl_xor(v[q], 32);
                    const f32x4 cs = *(const f32x4*)(rc + (size_t)m * 8 + (fg & 1) * 4);
                    const f32x4 sn = *(const f32x4*)(rs + (size_t)m * 8 + (fg & 1) * 4);
#pragma unroll
                    for (int q = 0; q < 4; ++q) v[q] = (fg < 2) ? (v[q] * cs[q] - pv[q] * sn[q]) : (v[q] * cs[q] + pv[q] * sn[q]);
                }
                if (nbase < 1024 + 768) { v = v * 0.125f; }
                *(uint2*)(projb + (size_t)m * 2304 + nb) = pk4(v);
            }
        }
    }
}

__device__ __forceinline__ bf16x8 act8(uint4 a, uint4 b, int mode) {
    unsigned av[4] = {a.x, a.y, a.z, a.w}, bv[4] = {b.x, b.y, b.z, b.w}; unsigned o[4];
#pragma unroll
    for (int q = 0; q < 4; ++q) {
        float lo = bflo(av[q]) + bflo(bv[q]), hi = bfhi(av[q]) + bfhi(bv[q]);
        if (mode == 1) { lo = 1.f - 2.f / (__expf(2.f * lo) + 1.f); hi = 1.f - 2.f / (__expf(2.f * hi) + 1.f); }
        else if (mode == 2) { lo = sigmoidf_(lo); hi = sigmoidf_(hi); }
        o[q] = pk_bf16(lo, hi);
    }
    return mk8(make_uint4(o[0], o[1], o[2], o[3]));
}
__device__ void prep_unit(const Params& p, int l, int u) {
    const int tt = u >> 3, hh = u & 7;
    const int lane = threadIdx.x & 63, w = threadIdx.x >> 6, tl = lane & 15, G = lane >> 4;
    const char* wne = p.ws + OFF_WNE + (size_t)l * WNE_SZ;
    const u16* lora1 = (const u16*)(p.ws + OFF_R + R_LORA1);
    const u16* projc = (const u16*)(p.ws + OFF_R + R_PROJC);
    const float* mu_rkv = (const float*)p.in[8] + (size_t)l * 3 * 512;
    const float* w0p = (const float*)p.in[10] + (size_t)l * 512;
    const float* a0p = (const float*)p.in[13] + (size_t)l * 512;
    const float* kkp = (const float*)p.in[18] + (size_t)l * 512;
    const float* kap = (const float*)p.in[19] + (size_t)l * 512;
    const float* rkp = (const float*)p.in[20] + (size_t)l * 512;
    const float* v0p = (const float*)p.in[24];
    const u16* vfirst = (const u16*)(p.ws + OFF_V);
    u16* vout = (u16*)(p.ws + OFF_V + (size_t)l * NTOK * 1024);
    u16* gout = (u16*)(p.ws + OFF_G);
    uint2* KR = (uint2*)(p.ws + OFF_KR); uint2* BK = (uint2*)(p.ws + OFF_BK); uint2* WW = (uint2*)(p.ws + OFF_W);
    float* bonus = (float*)(p.ws + OFF_BONUS);
#pragma unroll 1
    for (int t2 = 0; t2 < 2; ++t2) {
        const int tk = tt * 128 + w * 32 + t2 * 16 + tl; const bool hp = (tk & (SEQ - 1)) != 0;
        f32x4 acc[4][4];
#pragma unroll
        for (int a = 0; a < 4; ++a)
#pragma unroll
            for (int b = 0; b < 4; ++b) acc[a][b] = (f32x4){0.f, 0.f, 0.f, 0.f};
#pragma unroll
        for (int mat = 0; mat < 4; ++mat) {
            if (mat == 3 && l == 0) continue;
            const int K = (mat == 2) ? 128 : (mat == 3 ? 32 : 64);
            const int cola = (mat == 0) ? 0 : (mat == 1 ? 64 : (mat == 2 ? 128 : 256));
            const int mode = (mat == 0) ? 1 : (mat == 2 ? 2 : 0);
            const u16* wT = (const u16*)(wne + (mat == 0 ? WNE_W2T : (mat == 1 ? WNE_A2T : (mat == 2 ? WNE_G2T : WNE_V2T))));
#pragma unroll 1
            for (int s = 0; s < K / 32; ++s) {
                const int j0 = s * 32 + 8 * G;
                const uint4 xa = *(const uint4*)(lora1 + (size_t)tk * 576 + cola + j0);
                uint4 xb = make_uint4(0, 0, 0, 0);
                if (hp) xb = *(const uint4*)(lora1 + (size_t)(tk - 1) * 576 + 288 + cola + j0);
                const bf16x8 bfr = act8(xa, xb, mode);
#pragma unroll
                for (int ct = 0; ct < 4; ++ct) {
                    const bf16x8 af = mk8(*(const uint4*)(wT + (size_t)(hh * 64 + ct * 16 + tl) * K + j0));
                    acc[mat][ct] = MFMA16(af, bfr, acc[mat][ct]);
                }
            }
        }
        f32x4 kkraw[4], av[4];
        float ss = 0.f, bo = 0.f;
#pragma unroll
        for (int ct = 0; ct < 4; ++ct) {
            const int c0 = hh * 64 + ct * 16 + G * 4;
            const f32x4 r_t = unpk4(*(const uint2*)(projc + (size_t)tk * 1536 + c0));
            const f32x4 k_t = unpk4(*(const uint2*)(projc + (size_t)tk * 1536 + 512 + c0));
            const f32x4 v_t = unpk4(*(const uint2*)(projc + (size_t)tk * 1536 + 1024 + c0));
            f32x4 r_p = (f32x4){0.f, 0.f, 0.f, 0.f}, k_p = r_p, v_p = r_p;
            if (hp) {
                r_p = unpk4(*(const uint2*)(projc + (size_t)(tk - 1) * 1536 + c0));
                k_p = unpk4(*(const uint2*)(projc + (size_t)(tk - 1) * 1536 + 512 + c0));
                v_p = unpk4(*(const uint2*)(projc + (size_t)(tk - 1) * 1536 + 1024 + c0));
            }
            const f32x4 mur = *(const f32x4*)(mu_rkv + c0), muk = *(const f32x4*)(mu_rkv + 512 + c0), muv = *(const f32x4*)(mu_rkv + 1024 + c0);
            const f32x4 w0 = *(const f32x4*)(w0p + c0), a0 = *(const f32x4*)(a0p + c0), k_k = *(const f32x4*)(kkp + c0), k_a = *(const f32x4*)(kap + c0), r_k = *(const f32x4*)(rkp + c0);
            f32x4 rr = r_t + (r_p - r_t) * mur;
            f32x4 kx = k_t + (k_p - k_t) * muk;
            f32x4 vx = v_t + (v_p - v_t) * muv;
            f32x4 wd, aa, k2;
#pragma unroll
            for (int q = 0; q < 4; ++q) {
                const float wv = w0[q] + acc[0][ct][q];
                const float nx = -wv;
                const float sp = fmaxf(nx, 0.f) + log1pf(__expf(-fabsf(nx)));
                wd[q] = __expf(-__expf(-sp - 0.5f));
                aa[q] = sigmoidf_(a0[q] + acc[1][ct][q]);
            }
            if (l == 1) {
                const f32x4 vf = unpk4(*(const uint2*)(vfirst + (size_t)tk * 512 + c0));
                const f32x4 v0 = *(const f32x4*)(v0p + c0);
#pragma unroll
                for (int q = 0; q < 4; ++q) vx[q] = vx[q] + (vf[q] - vx[q]) * sigmoidf_(v0[q] + acc[3][ct][q]);
            }
#pragma unroll
            for (int q = 0; q < 4; ++q) {
                kkraw[ct][q] = kx[q] * k_k[q]; ss += kkraw[ct][q] * kkraw[ct][q];
                k2[q] = kx[q] * (1.f + (aa[q] - 1.f) * k_a[q]);
                bo += rr[q] * k2[q] * r_k[q];
            }
            av[ct] = aa;
            const size_t rec = ((size_t)tk * 8 + hh) * 16 + ct * 4 + G;
            KR[rec * 2 + 1] = pk4(rr);
            BK[rec * 2 + 1] = pk4(k2);
            { h2_t lo, hi; lo[0] = (_Float16)wd[0]; lo[1] = (_Float16)wd[1]; hi[0] = (_Float16)wd[2]; hi[1] = (_Float16)wd[3];
              WW[rec] = make_uint2(__builtin_bit_cast(unsigned, lo), __builtin_bit_cast(unsigned, hi)); }
            *(uint2*)(vout + (size_t)tk * 512 + c0) = pk4(vx);
            *(uint2*)(gout + (size_t)tk * 512 + c0) = pk4(acc[2][ct]);
        }
        ss += __shfl_xor(ss, 16); ss += __shfl_xor(ss, 32);
        bo += __shfl_xor(bo, 16); bo += __shfl_xor(bo, 32);
        const float inv = 1.f / fmaxf(sqrtf(ss), 1e-12f);
#pragma unroll
        for (int ct = 0; ct < 4; ++ct) {
            const size_t rec = ((size_t)tk * 8 + hh) * 16 + ct * 4 + G;
            const f32x4 kk = kkraw[ct] * inv;
            KR[rec * 2] = pk4(kk);
            BK[rec * 2] = pk4(kk * av[ct]);
        }
        if (G == 0) bonus[(size_t)tk * 8 + hh] = bo;
    }
}

__device__ void scan_unit(const Params& p, int l, int su) {
    const int bh = su >> 2, qv = su & 3, b = bh >> 3, hh = bh & 7;
    const int lane = threadIdx.x & 63, w = threadIdx.x >> 6, j = lane & 15;
    const int row = qv * 16 + w * 4 + (lane >> 4);
    const size_t tok0 = (size_t)b * SEQ;
    const uint4* KR = (const uint4*)(p.ws + OFF_KR) + (tok0 * 8 + hh) * 16 + j;
    const uint4* BK = (const uint4*)(p.ws + OFF_BK) + (tok0 * 8 + hh) * 16 + j;
    const uint2* WW = (const uint2*)(p.ws + OFF_W) + (tok0 * 8 + hh) * 16 + j;
    const u16* V = (const u16*)(p.ws + OFF_V + (size_t)l * NTOK * 1024) + tok0 * 512 + hh * 64 + row;
    u16* Y = (u16*)(p.ws + OFF_YRAW) + tok0 * 512 + hh * 64 + row;
    constexpr int PF = 8;
    uint4 kr[PF], bk[PF]; uint2 wv[PF]; u16 vv[PF];
#pragma unroll
    for (int i = 0; i < PF; ++i) { kr[i] = KR[(size_t)i * 128]; bk[i] = BK[(size_t)i * 128]; wv[i] = WW[(size_t)i * 128]; vv[i] = V[(size_t)i * 512]; }
    float s0 = 0.f, s1 = 0.f, s2 = 0.f, s3 = 0.f; unsigned sb0 = 0u, sb1 = 0u;
    for (int t0 = 0; t0 < SEQ; t0 += PF) {
#pragma unroll
        for (int i = 0; i < PF; ++i) {
            const uint4 ckr = kr[i], cbk = bk[i]; const uint2 cw = wv[i]; const float v = bf2f(vv[i]);
            int tn = t0 + i + PF; tn = tn < SEQ ? tn : SEQ - 1;
            kr[i] = KR[(size_t)tn * 128]; bk[i] = BK[(size_t)tn * 128]; wv[i] = WW[(size_t)tn * 128]; vv[i] = V[(size_t)tn * 512];
            float sa = dot2bf(sb0, ckr.x, 0.f); sa = dot2bf(sb1, ckr.y, sa);
            sa = -rowsum16(sa);
            const h2_t wlo = __builtin_bit_cast(h2_t, cw.x), whi = __builtin_bit_cast(h2_t, cw.y);
            s0 = s0 * (float)wlo[0] + (sa * bflo(cbk.x) + v * bflo(cbk.z));
            s1 = s1 * (float)wlo[1] + (sa * bfhi(cbk.x) + v * bfhi(cbk.z));
            s2 = s2 * (float)whi[0] + (sa * bflo(cbk.y) + v * bflo(cbk.w));
            s3 = s3 * (float)whi[1] + (sa * bfhi(cbk.y) + v * bfhi(cbk.w));
            sb0 = pk_bf16(s0, s1); sb1 = pk_bf16(s2, s3);
            float y = dot2bf(sb0, ckr.z, 0.f); y = dot2bf(sb1, ckr.w, y);
            y = rowsum16(y);
            if (j == 0) Y[(size_t)(t0 + i) * 512] = f2bf(y);
        }
    }
}

__device__ void mixa_unit(const Params& p, int l, int u, char* lds) {
    const int g = u & 3, bc = u >> 2;
    const int tok0 = bc * 128;
    const int tid = threadIdx.x, lane = tid & 63, w = tid >> 6, fr = lane & 15, G = lane >> 4;
    u16* proja = (u16*)(p.ws + OFF_R + R_PROJA);
    char* ldsV = lds; char* ldsW = lds + 32768; float2* stats = (float2*)(lds + 65536);
    for (int r = 0; r < 32; ++r) {
        const int row = w * 32 + r;
        const uint4 x = *(const uint4*)(proja + (size_t)(tok0 + row) * 1024 + 512 + lane * 8);
        const unsigned xv[4] = {x.x, x.y, x.z, x.w};
        float s = 0.f, q = 0.f;
#pragma unroll
        for (int i = 0; i < 4; ++i) { const float a = bflo(xv[i]), b2 = bfhi(xv[i]); s += a + b2; q += a * a + b2 * b2; }
        s = wavesum(s); q = wavesum(q);
        const float mu = s * (1.f / 512.f); const float var = fmaxf(q * (1.f / 512.f) - mu * mu, 0.f);
        if (lane == 0) stats[row] = make_float2(mu, rsqrtf(var + 1e-5f));
    }
    __syncthreads();
    const float* lng = (const float*)p.in[4] + (size_t)l * 512 + g * 128;
    const float* lnb = (const float*)p.in[5] + (size_t)l * 512 + g * 128;
    const float* wsrc = (const float*)p.in[6] + ((size_t)l * 4 + g) * 128 * 128;
#pragma unroll
    for (int i = 0; i < 8; ++i) {
        const int q = tid + 256 * i, row = q >> 4, ch = q & 15;
        const uint4 x = *(const uint4*)(proja + (size_t)(tok0 + row) * 1024 + 512 + g * 128 + ch * 8);
        const float2 st = stats[row];
        const f32x4 g0 = *(const f32x4*)(lng + ch * 8), g1 = *(const f32x4*)(lng + ch * 8 + 4), b0 = *(const f32x4*)(lnb + ch * 8), b1 = *(const f32x4*)(lnb + ch * 8 + 4);
        const unsigned xv[4] = {x.x, x.y, x.z, x.w}; unsigned o[4];
#pragma unroll
        for (int k = 0; k < 4; ++k) {
            const float ga = (k < 2) ? g0[2 * k] : g1[2 * k - 4], gb = (k < 2) ? g0[2 * k + 1] : g1[2 * k - 3];
            const float ba = (k < 2) ? b0[2 * k] : b1[2 * k - 4], bb = (k < 2) ? b0[2 * k + 1] : b1[2 * k - 3];
            o[k] = pk_bf16((bflo(xv[k]) - st.x) * st.y * ga + ba, (bfhi(xv[k]) - st.x) * st.y * gb + bb);
        }
        const int f = (row & 3) | (((row >> 3) & 1) << 2);
        *(uint4*)(ldsV + row * 256 + (((ch >> 1) ^ f) << 5) + ((ch & 1) << 4)) = make_uint4(o[0], o[1], o[2], o[3]);
        const f32x4 w0 = *(const f32x4*)(wsrc + (size_t)row * 128 + ch * 8), w1 = *(const f32x4*)(wsrc + (size_t)row * 128 + ch * 8 + 4);
        unsigned ow[4];
#pragma unroll
        for (int k = 0; k < 4; ++k) {
            const int s0i = ch * 8 + 2 * k;
            const float a = (k < 2) ? w0[2 * k] : w1[2 * k - 4], b2 = (k < 2) ? w0[2 * k + 1] : w1[2 * k - 3];
            ow[k] = pk_bf16(s0i <= row ? a : 0.f, (s0i + 1) <= row ? b2 : 0.f);
        }
        *(uint4*)(ldsW + row * 256 + ((ch ^ (row & 15)) << 4)) = make_uint4(ow[0], ow[1], ow[2], ow[3]);
    }
    __syncthreads();
    f32x4 acc[2][8];
#pragma unroll
    for (int a = 0; a < 2; ++a)
#pragma unroll
        for (int b = 0; b < 8; ++b) acc[a][b] = (f32x4){0.f, 0.f, 0.f, 0.f};
    const int qrow = (lane & 15) >> 2, pcol = lane & 3;
    for (int ss = 0; ss <= w; ++ss) {
        bf16x8 bw[2];
#pragma unroll
        for (int t2 = 0; t2 < 2; ++t2) { const int t = w * 32 + t2 * 16 + fr; bw[t2] = *(const bf16x8*)(ldsW + t * 256 + (((ss * 4 + G) ^ (t & 15)) << 4)); }
#pragma unroll
        for (int ct = 0; ct < 8; ++ct) {
            const int ra = ss * 32 + 8 * G + qrow, rb2 = ra + 4;
            const int fa = (ra & 3) | (((ra >> 3) & 1) << 2), fb = (rb2 & 3) | (((rb2 >> 3) & 1) << 2);
            const v4i16_t lo = __builtin_amdgcn_ds_read_tr16_b64_v4i16((LAS v4i16_t*)(ldsV + ra * 256 + ((ct ^ fa) << 5) + pcol * 8));
            const v4i16_t hi = __builtin_amdgcn_ds_read_tr16_b64_v4i16((LAS v4i16_t*)(ldsV + rb2 * 256 + ((ct ^ fb) << 5) + pcol * 8));
            bf16x8 af; af[0] = lo[0]; af[1] = lo[1]; af[2] = lo[2]; af[3] = lo[3]; af[4] = hi[0]; af[5] = hi[1]; af[6] = hi[2]; af[7] = hi[3];
            acc[0][ct] = MFMA16(af, bw[0], acc[0][ct]);
            acc[1][ct] = MFMA16(af, bw[1], acc[1][ct]);
        }
    }
    const float* bs = (const float*)p.in[7] + ((size_t)l * 4 + g) * 128;
#pragma unroll
    for (int t2 = 0; t2 < 2; ++t2) {
        const int t = w * 32 + t2 * 16 + fr; const float bias = bs[t];
#pragma unroll
        for (int ct = 0; ct < 8; ++ct) {
            u16* pu = proja + (size_t)(tok0 + t) * 1024 + g * 128 + ct * 16 + G * 4;
            const f32x4 uu = unpk4(*(const uint2*)pu);
            f32x4 y;
#pragma unroll
            for (int q = 0; q < 4; ++q) y[q] = uu[q] * (acc[t2][ct][q] + bias);
            *(uint2*)pu = pk4(y);
        }
    }
    __syncthreads();
}

__device__ void attn_unit(const Params& p, int u, char* lds) {
    const int hq = u & 3, combo = (u >> 2) % 48, b = (u >> 2) / 48;
    int g, r, n, dil;
    if (combo < 16) { g = 0; r = 0; n = combo; dil = 1; } else if (combo < 32) { g = 1; r = (combo - 16) >> 2; n = (combo - 16) & 3; dil = 4; } else { g = 2; r = combo - 32; n = 0; dil = 16; }
    const int head = g * 4 + hq;
    const int tid = threadIdx.x, lane = tid & 63, w = tid >> 6, fr = lane & 15, G = lane >> 4;
    u16* projb = (u16*)(p.ws + OFF_R + R_PROJB);
    char* ldsK = lds; char* ldsV = lds + 32768;
    const size_t tokb = (size_t)b * SEQ + r;
#pragma unroll
    for (int i = 0; i < 8; ++i) {
        const int q = tid + 256 * i, row = q >> 3, ch = q & 7;
        const int idx = (n - 1) * 128 + row;
        uint4 kx = make_uint4(0, 0, 0, 0), vx = kx;
        if (idx >= 0) {
            const u16* src = projb + (tokb + (size_t)idx * dil) * 2304 + head * 64 + ch * 8;
            kx = *(const uint4*)(src + 768); vx = *(const uint4*)(src + 1536);
        }
        *(uint4*)(ldsK + toff(row, ch)) = kx;
        *(uint4*)(ldsV + row * 128 + (((ch >> 1) ^ ((row >> 1) & 3)) << 5) + ((ch & 1) << 4)) = vx;
    }
    bf16x8 qf[2][2]; size_t qtok[2];
#pragma unroll
    for (int qt = 0; qt < 2; ++qt) {
        qtok[qt] = tokb + (size_t)(n * 128 + w * 32 + qt * 16 + fr) * dil;
#pragma unroll
        for (int s = 0; s < 2; ++s) qf[qt][s] = mk8(*(const uint4*)(projb + qtok[qt] * 2304 + head * 64 + s * 32 + 8 * G));
    }
    __syncthreads();
    f32x4 sc[2][10];
#pragma unroll
    for (int qt = 0; qt < 2; ++qt)
#pragma unroll
        for (int uu = 0; uu < 10; ++uu) sc[qt][uu] = (f32x4){0.f, 0.f, 0.f, 0.f};
#pragma unroll
    for (int uu = 0; uu < 10; ++uu)
#pragma unroll
        for (int s = 0; s < 2; ++s) {
            const bf16x8 kf = *(const bf16x8*)(ldsK + toff((2 * w + uu) * 16 + fr, s * 4 + G));
            sc[0][uu] = MFMA16(kf, qf[0][s], sc[0][uu]);
            sc[1][uu] = MFMA16(kf, qf[1][s], sc[1][uu]);
        }
    float mx[2], sm[2];
#pragma unroll
    for (int qt = 0; qt < 2; ++qt) {
        const int qi = w * 32 + qt * 16 + fr;
        float m = -1e30f;
#pragma unroll
        for (int uu = 0; uu < 10; ++uu)
#pragma unroll
            for (int q = 0; q < 4; ++q) {
                const int kj = (2 * w + uu) * 16 + G * 4 + q;
                const bool valid = (kj >= qi) && (kj <= qi + 128) && (n > 0 || kj >= 128);
                const float v = valid ? sc[qt][uu][q] : -1e30f;
                sc[qt][uu][q] = v; m = fmaxf(m, v);
            }
        m = fmaxf(m, __shfl_xor(m, 16)); m = fmaxf(m, __shfl_xor(m, 32));
        float s = 0.f;
#pragma unroll
        for (int uu = 0; uu < 10; ++uu)
#pragma unroll
            for (int q = 0; q < 4; ++q) { const float e = __expf(sc[qt][uu][q] - m); sc[qt][uu][q] = e; s += e; }
        s += __shfl_xor(s, 16); s += __shfl_xor(s, 32);
        mx[qt] = m; sm[qt] = s;
    }
    f32x4 oc[2][4];
#pragma unroll
    for (int qt = 0; qt < 2; ++qt)
#pragma unroll
        for (int dt = 0; dt < 4; ++dt) oc[qt][dt] = (f32x4){0.f, 0.f, 0.f, 0.f};
    const int qrow = (lane & 15) >> 2, pcol = lane & 3;
#pragma unroll
    for (int ks = 0; ks < 5; ++ks) {
        bf16x8 pf[2];
#pragma unroll
        for (int qt = 0; qt < 2; ++qt)
            pf[qt] = mk8(make_uint4(pk_bf16(sc[qt][2 * ks][0], sc[qt][2 * ks][1]), pk_bf16(sc[qt][2 * ks][2], sc[qt][2 * ks][3]),
                                    pk_bf16(sc[qt][2 * ks + 1][0], sc[qt][2 * ks + 1][1]), pk_bf16(sc[qt][2 * ks + 1][2], sc[qt][2 * ks + 1][3])));
        const int ra = (2 * w + 2 * ks) * 16 + 4 * G + qrow, rb2 = ra + 16;
#pragma unroll
        for (int dt = 0; dt < 4; ++dt) {
            const v4i16_t lo = __builtin_amdgcn_ds_read_tr16_b64_v4i16((LAS v4i16_t*)(ldsV + ra * 128 + ((dt ^ ((ra >> 1) & 3)) << 5) + pcol * 8));
            const v4i16_t hi = __builtin_amdgcn_ds_read_tr16_b64_v4i16((LAS v4i16_t*)(ldsV + rb2 * 128 + ((dt ^ ((rb2 >> 1) & 3)) << 5) + pcol * 8));
            bf16x8 vf; vf[0] = lo[0]; vf[1] = lo[1]; vf[2] = lo[2]; vf[3] = lo[3]; vf[4] = hi[0]; vf[5] = hi[1]; vf[6] = hi[2]; vf[7] = hi[3];
            oc[0][dt] = MFMA16(vf, pf[0], oc[0][dt]);
            oc[1][dt] = MFMA16(vf, pf[1], oc[1][dt]);
        }
    }
    float* lse = (float*)(p.ws + OFF_LSE);
#pragma unroll
    for (int qt = 0; qt < 2; ++qt) {
        const float inv = 1.f / sm[qt];
#pragma unroll
        for (int dt = 0; dt < 4; ++dt) *(uint2*)(projb + qtok[qt] * 2304 + head * 64 + dt * 16 + G * 4) = pk4(oc[qt][dt] * inv);
        if (G == 0) lse[((size_t)g * NTOK + qtok[qt]) * 4 + hq] = mx[qt] + __logf(sm[qt]);
    }
    __syncthreads();
}

__device__ void phase_post(const Params& p, int l) {
    const int tid_ = tid_opaque();
    const int lane = tid_ & 63, j = lane & 15;
    const int gw = blockIdx.x * 4 + (tid_ >> 6), nw = gridDim.x * 4;
    const u16* yraw = (const u16*)(p.ws + OFF_YRAW); u16* gy = (u16*)(p.ws + OFF_G);
    const u16* vv = (const u16*)(p.ws + OFF_V + (size_t)l * NTOK * 1024);
    const float* bonus = (const float*)(p.ws + OFF_BONUS);
    const float* lnw = (const float*)p.in[21] + (size_t)l * 512; const float* lnb = (const float*)p.in[22] + (size_t)l * 512;
    for (int it = gw; it < NTOK * 8 / 4; it += nw) {
        const int pr = it * 4 + (lane >> 4);
        const int tok = pr >> 3, hh = pr & 7;
        const size_t off = (size_t)tok * 512 + hh * 64 + j * 4;
        const f32x4 y = unpk4(*(const uint2*)(yraw + off));
        const float mu = rowsum16(y[0] + y[1] + y[2] + y[3]) * (1.f / 64.f);
        const f32x4 d = y - mu;
        const float var = rowsum16(d[0] * d[0] + d[1] * d[1] + d[2] * d[2] + d[3] * d[3]) * (1.f / 64.f);
        const float rstd = rsqrtf(var + 64e-5f);
        const f32x4 w4 = *(const f32x4*)(lnw + hh * 64 + j * 4), b4 = *(const f32x4*)(lnb + hh * 64 + j * 4);
        const f32x4 v4 = unpk4(*(const uint2*)(vv + off)), g4 = unpk4(*(const uint2*)(gy + off));
        const float bo = bonus[pr];
        f32x4 o;
#pragma unroll
        for (int q = 0; q < 4; ++q) o[q] = (d[q] * rstd * w4[q] + b4[q] + bo * v4[q]) * g4[q];
        *(uint2*)(gy + off) = pk4(o);
    }
    u16* projb = (u16*)(p.ws + OFF_R + R_PROJB); const float* lse = (const float*)(p.ws + OFF_LSE);
    for (int it = gw; it < NTOK * 4 / 4; it += nw) {
        const int pr = it * 4 + (lane >> 4);
        const int tok = pr >> 2, hq = pr & 3;
        const float l0 = lse[((size_t)0 * NTOK + tok) * 4 + hq], l1 = lse[((size_t)1 * NTOK + tok) * 4 + hq], l2 = lse[((size_t)2 * NTOK + tok) * 4 + hq];
        const float m = fmaxf(l0, fmaxf(l1, l2));
        const float e0 = __expf(l0 - m), e1 = __expf(l1 - m), e2 = __expf(l2 - m); const float inv = 1.f / (e0 + e1 + e2);
        const u16* base = projb + (size_t)tok * 2304 + hq * 64 + j * 4;
        const f32x4 o0 = unpk4(*(const uint2*)(base)), o1 = unpk4(*(const uint2*)(base + 256)), o2 = unpk4(*(const uint2*)(base + 512));
        const f32x4 o = (o0 * e0 + o1 * e1 + o2 * e2) * inv;
        *(uint2*)(projb + (size_t)tok * 2304 + 768 + hq * 64 + j * 4) = pk4(o);
    }
}

__device__ void merge_unit(const Params& p, int l, int u, char* lds) {
    const int mt = u >> 3, nt = u & 7;
    const int lane = threadIdx.x & 63, w = threadIdx.x >> 6, wm = w >> 1, wn = w & 1, fr = lane & 15, fg = lane >> 4;
    const char* wne = p.ws + OFF_WNE + (size_t)l * WNE_SZ;
    const float* bgate = (const float*)p.in[31] + (size_t)l * 3072;
    u16* merged = (u16*)(p.ws + OFF_MERGED);
#pragma unroll 1
    for (int br = 0; br < 3; ++br) {
        const u16* ya; int lda, K; const u16* wb;
        if (br == 0) { ya = (const u16*)(p.ws + OFF_R + R_PROJA); lda = 1024; K = 512; wb = (const u16*)(wne + WNE_WBRA); }
        else if (br == 1) { ya = (const u16*)(p.ws + OFF_R + R_PROJB) + 768; lda = 2304; K = 256; wb = (const u16*)(wne + WNE_WBRB); }
        else { ya = (const u16*)(p.ws + OFF_G); lda = 512; K = 512; wb = (const u16*)(wne + WNE_WBRC); }
        uint2 yb[4][4];
        {
            f32x4 acc[4][4]; acc_zero<4, 4>(acc);
            RowLoader al{ya + (size_t)mt * 128 * lda, lda};
            RowLoader bl{wb + (size_t)nt * 128 * K, K};
            gemm_kloop<4, 4>(acc, al, bl, K / 64, lds);
#pragma unroll
            for (int i = 0; i < 4; ++i)
#pragma unroll
                for (int j = 0; j < 4; ++j) yb[i][j] = pk4(acc[i][j]);
        }
        {
            f32x4 acc[4][4]; acc_zero<4, 4>(acc);
            RowLoader al{(const u16*)(p.ws + OFF_H) + (size_t)mt * 128 * 1024, 1024};
            RowLoader bl{(const u16*)(wne + WNE_WGATE) + (size_t)(br * 1024 + nt * 128) * 1024, 1024};
            gemm_kloop<4, 4>(acc, al, bl, 16, lds);
#pragma unroll
            for (int i = 0; i < 4; ++i)
#pragma unroll
                for (int j = 0; j < 4; ++j) {
                    const int m = mt * 128 + wm * 64 + i * 16 + fr, n = nt * 128 + wn * 64 + j * 16 + fg * 4;
                    const f32x4 bg = *(const f32x4*)(bgate + br * 1024 + n);
                    const f32x4 yv = unpk4(yb[i][j]);
                    f32x4 tv = (f32x4){0.f, 0.f, 0.f, 0.f};
                    if (br > 0) tv = unpk4(*(const uint2*)(merged + (size_t)m * 1024 + n));
#pragma unroll
                    for (int q = 0; q < 4; ++q) tv[q] += sigmoidf_(acc[i][j][q] + bg[q]) * yv[q];
                    *(uint2*)(merged + (size_t)m * 1024 + n) = pk4(tv);
                }
        }
    }
}

__device__ void outproj_unit(const Params& p, int l, int u, char* lds) {
    const int mt = u >> 3, nt = u & 7;
    const int lane = threadIdx.x & 63, w = threadIdx.x >> 6, wm = w >> 1, wn = w & 1, fr = lane & 15, fg = lane >> 4;
    RowLoader al{(const u16*)(p.ws + OFF_MERGED) + (size_t)mt * 128 * 1024, 1024};
    RowLoader bl{(const u16*)(p.ws + OFF_WNE + (size_t)l * WNE_SZ + WNE_WOUT) + (size_t)nt * 128 * 1024, 1024};
    f32x4 acc[4][4]; acc_zero<4, 4>(acc);
    gemm_kloop<4, 4>(acc, al, bl, 16, lds);
    const float* xin = (l == 0) ? (const float*)p.in[0] : p.out;
#pragma unroll
    for (int i = 0; i < 4; ++i)
#pragma unroll
        for (int j = 0; j < 4; ++j) {
            const int m = mt * 128 + wm * 64 + i * 16 + fr, n = nt * 128 + wn * 64 + j * 16 + fg * 4;
            const f32x4 xo = *(const f32x4*)(xin + (size_t)m * 1024 + n);
            *(f32x4*)(p.out + (size_t)m * 1024 + n) = xo + acc[i][j];
        }
}

__device__ void router_unit(const Params& p, int l, int u, char* lds) {
    const int tid = threadIdx.x, lane = tid & 63, w = tid >> 6, wm = w >> 1, wn = w & 1, fr = lane & 15, fg = lane >> 4;
    const int tok0 = u * 128;
    const float* g = (const float*)p.in[33] + (size_t)l * 1024;
    for (int r = 0; r < 32; ++r) {
        const int row = tok0 + w * 32 + r;
        const float4* xr = (const float4*)(p.out + (size_t)row * 1024);
        float4 v[4]; float ss = 0.f;
#pragma unroll
        for (int i = 0; i < 4; ++i) { v[i] = xr[lane + 64 * i]; ss += v[i].x * v[i].x + v[i].y * v[i].y + v[i].z * v[i].z + v[i].w * v[i].w; }
        ss = wavesum(ss);
        const float rinv = rsqrtf(ss * (1.f / 1024.f) + 1e-6f);
#pragma unroll
        for (int i = 0; i < 4; ++i) {
            const float4 gg = ((const float4*)g)[lane + 64 * i];
            ((uint2*)(p.ws + OFF_H + (size_t)row * 2048))[lane + 64 * i] = make_uint2(pk_bf16(v[i].x * rinv * gg.x, v[i].y * rinv * gg.y), pk_bf16(v[i].z * rinv * gg.z, v[i].w * rinv * gg.w));
        }
    }
    asm volatile("s_waitcnt vmcnt(0)" ::: "memory");
    __syncthreads();
    RowLoader al{(const u16*)(p.ws + OFF_H) + (size_t)tok0 * 1024, 1024};
    RowLoader bl{(const u16*)(p.ws + OFF_WNE + (size_t)l * WNE_SZ + WNE_WR), 1024};
    f32x4 acc[4][4]; acc_zero<4, 4>(acc);
    gemm_kloop<4, 4>(acc, al, bl, 16, lds);
    float* lg = (float*)lds;
    int* hist = (int*)(lds + 16384); int* base = hist + 32; int* cls = base + 32;
    if (wn == 0) {
#pragma unroll
        for (int i = 0; i < 4; ++i)
#pragma unroll
            for (int j = 0; j < 2; ++j) { const int m = wm * 64 + i * 16 + fr, n = j * 16 + fg * 4; *(f32x4*)(lg + m * 32 + n) = acc[i][j]; }
    }
    if (tid < 32) hist[tid] = 0;
    __syncthreads();
    float c_lo = 0.f, c_hi = 0.f; int c = 0, rank = 0;
    if (tid < 128) {
        const float* rgb = (const float*)p.in[35] + (size_t)l * 4; const float* reb = (const float*)p.in[37] + (size_t)l * 16;
        float gl[4]; int gi = 0;
#pragma unroll
        for (int q = 0; q < 4; ++q) { gl[q] = lg[tid * 32 + q] + rgb[q]; if (gl[q] > gl[gi]) gi = q; }
        float den = 0.f;
#pragma unroll
        for (int q = 0; q < 4; ++q) den += __expf(gl[q] - gl[gi]);
        const float gp = 1.f / den;
        float el[4];
#pragma unroll
        for (int q = 0; q < 4; ++q) {
            float v = 0.f;
#pragma unroll
            for (int gg = 0; gg < 4; ++gg) v = (gg == gi) ? (lg[tid * 32 + 4 + gg * 4 + q] + reb[gg * 4 + q]) : v;
            el[q] = v;
        }
        int i1 = 0;
#pragma unroll
        for (int q = 1; q < 4; ++q) if (el[q] > el[i1]) i1 = q;
        int i2 = (i1 == 0) ? 1 : 0;
#pragma unroll
        for (int q = 0; q < 4; ++q) if (q != i1 && el[q] > el[i2]) i2 = q;
        const float w1 = 1.f / (1.f + __expf(el[i2] - el[i1])), w2 = 1.f - w1;
        const int lo = i1 < i2 ? i1 : i2, hi = i1 < i2 ? i2 : i1;
        c_lo = gp * (i1 < i2 ? w1 : w2); c_hi = gp * (i1 < i2 ? w2 : w1);
        const int pidx = (lo == 0) ? (hi - 1) : (lo == 1 ? hi + 1 : 5);
        c = gi * 6 + pidx;
        rank = atomicAdd(&hist[c], 1);
    }
    __syncthreads();
    unsigned* cnt = (unsigned*)(p.ws + OFF_CTRL) + CT_CNT + l * 32;
    if (tid < 24) base[tid] = hist[tid] > 0 ? (int)atomicAdd(&cnt[tid], (unsigned)hist[tid]) : 0;
    __syncthreads();
    if (tid < 128) {
        const int slot = base[c] + rank;
        ((int*)(p.ws + OFF_PERM))[(size_t)c * 16384 + slot] = tok0 + tid;
        ((float2*)(p.ws + OFF_CW))[(size_t)c * 16384 + slot] = make_float2(c_lo, c_hi);
    }
    __syncthreads();
}

struct ClsInfo { int cls, rt, cnt, segrow, elo, ehi; };
__device__ __forceinline__ int moe_setup(const Params& p, int l, int* tab) {
    if (threadIdx.x == 0) {
        const unsigned* cnt = (const unsigned*)(p.ws + OFF_CTRL) + CT_CNT + l * 32;
        int tot = 0;
        for (int c = 0; c < 24; ++c) { const int n = (int)__hip_atomic_load(&cnt[c], __ATOMIC_RELAXED, __HIP_MEMORY_SCOPE_AGENT); tab[24 + c] = n; tab[c] = (n + 127) >> 7; tot += tab[c]; }
        tab[48] = tot;
    }
    __syncthreads();
    return tab[48];
}
__device__ __forceinline__ ClsInfo moe_find(const int* tab, int gt) {
    ClsInfo ci; int c = 0, seg = 0;
    while (c < 23 && gt >= tab[c]) { gt -= tab[c]; seg += tab[c]; ++c; }
    ci.cls = c; ci.rt = gt; ci.cnt = tab[24 + c]; ci.segrow = seg * 128;
    const int gi = c / 6, pi = c % 6;
    const int lo = pi < 3 ? 0 : (pi < 5 ? 1 : 2), hi = pi < 3 ? pi + 1 : (pi < 5 ? pi - 1 : 3);
    ci.elo = gi * 4 + lo; ci.ehi = gi * 4 + hi;
    return ci;
}
struct GatherLoader {
    const u16* base; int tok0, tok1, tok2, tok3;
    __device__ __forceinline__ uint4 operator()(int kt, int i) const {
        const int ck = threadIdx.x & 7;
        const int tk = (i == 0) ? tok0 : (i == 1 ? tok1 : (i == 2 ? tok2 : tok3));
        return *(const uint4*)(base + (size_t)tk * 1024 + kt * 64 + ck * 8);
    }
};
struct GateUpLoader {
    const u16* gsrc; const u16* usrc;
    __device__ __forceinline__ uint4 operator()(int kt, int i) const {
        const int r0 = threadIdx.x >> 3, ck = threadIdx.x & 7;
        const int rr = r0 + 32 * i; const u16* s = (i < 2) ? (gsrc + (size_t)rr * 1024) : (usrc + (size_t)(rr - 64) * 1024);
        return *(const uint4*)(s + kt * 64 + ck * 8);
    }
};
struct DownLoader {
    const u16* lo; const u16* hi;
    __device__ __forceinline__ uint4 operator()(int kt, int i) const {
        const int r0 = threadIdx.x >> 3, ck = threadIdx.x & 7;
        const u16* s = (kt < 8) ? lo : hi;
        return *(const uint4*)(s + (size_t)(r0 + 32 * i) * 512 + (kt & 7) * 64 + ck * 8);
    }
};
__device__ void moe_up_phase(const Params& p, int l, char* lds) {
    int* tab = (int*)(lds + LDS_BYTES - 512);
    const int ntiles = moe_setup(p, l, tab);
    const int tid = threadIdx.x, lane = tid & 63, w = tid >> 6, fr = lane & 15, fg = lane >> 4;
    const u16* wexp = (const u16*)(p.ws + OFF_R + R_WEXP);
    const int* perm = (const int*)(p.ws + OFF_PERM); const float2* cw = (const float2*)(p.ws + OFF_CW);
    u16* hid = (u16*)(p.ws + OFF_R + R_HID);
    for (int u = blockIdx.x; u < ntiles * 16; u += gridDim.x) {
        const int gt = u >> 4, nt = u & 15;
        const ClsInfo ci = moe_find(tab, gt);
        const int hc0 = nt * 64; const int e = hc0 < 512 ? ci.elo : ci.ehi; const int sel = hc0 < 512 ? 0 : 1;
        GatherLoader al; al.base = (const u16*)(p.ws + OFF_H);
        { const int sb = ci.rt * 128 + (tid >> 3), cm = ci.cnt - 1; const int* pp = perm + (size_t)ci.cls * 16384;
          al.tok0 = pp[min(sb, cm)]; al.tok1 = pp[min(sb + 32, cm)]; al.tok2 = pp[min(sb + 64, cm)]; al.tok3 = pp[min(sb + 96, cm)]; }
        GateUpLoader bl{wexp + ((size_t)e * 512 + (hc0 & 511)) * 1024, wexp + (size_t)16 * 512 * 1024 + ((size_t)e * 512 + (hc0 & 511)) * 1024};
        f32x4 acc[2][8]; acc_zero<2, 8>(acc);
        gemm_kloop<2, 8>(acc, al, bl, 16, lds);
#pragma unroll
        for (int i = 0; i < 2; ++i) {
            const int slot = ci.rt * 128 + w * 32 + i * 16 + fr;
            if (slot < ci.cnt) {
                const float2 cc = cw[(size_t)ci.cls * 16384 + slot]; const float cwv = sel ? cc.y : cc.x;
#pragma unroll
                for (int j = 0; j < 4; ++j) {
                    f32x4 hv;
#pragma unroll
                    for (int q = 0; q < 4; ++q) { const float gq = acc[i][j][q]; hv[q] = gq * sigmoidf_(gq) * acc[i][j + 4][q] * cwv; }
                    *(uint2*)(hid + (size_t)(ci.segrow + slot) * 1024 + hc0 + j * 16 + fg * 4) = pk4(hv);
                }
            }
        }
    }
}
__device__ void moe_down_phase(const Params& p, int l, char* lds) {
    int* tab = (int*)(lds + LDS_BYTES - 512);
    const int ntiles = moe_setup(p, l, tab);
    const int tid = threadIdx.x, lane = tid & 63, w = tid >> 6, wm = w >> 1, wn = w & 1, fr = lane & 15, fg = lane >> 4;
    const u16* wdown = (const u16*)(p.ws + OFF_R + R_WEXP) + (size_t)2 * 16 * 512 * 1024;
    const int* perm = (const int*)(p.ws + OFF_PERM);
    const u16* hid = (const u16*)(p.ws + OFF_R + R_HID);
    for (int u = blockIdx.x; u < ntiles * 8; u += gridDim.x) {
        const int gt = u >> 3, nt = u & 7;
        const ClsInfo ci = moe_find(tab, gt);
        RowLoader al{hid + (size_t)(ci.segrow + ci.rt * 128) * 1024, 1024};
        DownLoader bl{wdown + ((size_t)ci.elo * 1024 + nt * 128) * 512, wdown + ((size_t)ci.ehi * 1024 + nt * 128) * 512};
        f32x4 acc[4][4]; acc_zero<4, 4>(acc);
        gemm_kloop<4, 4>(acc, al, bl, 16, lds);
#pragma unroll
        for (int i = 0; i < 4; ++i) {
            const int slot = ci.rt * 128 + wm * 64 + i * 16 + fr;
            if (slot < ci.cnt) {
                const int tok = perm[(size_t)ci.cls * 16384 + slot];
#pragma unroll
                for (int j = 0; j < 4; ++j) {
                    float* px = p.out + (size_t)tok * 1024 + nt * 128 + wn * 64 + j * 16 + fg * 4;
                    *(f32x4*)px = *(const f32x4*)px + acc[i][j];
                }
            }
        }
    }
}

template <int S>
__device__ __forceinline__ void run_stage(const Params& p, int l, char* lds) {
    const int G = gridDim.x, bid = blockIdx.x;
    if (S == 100) { phase_conv_ne(p, lds); }
    else if (S == 101) { phase_norm<true>(p, p.out, (const float*)p.in[41]); }
    else if (S == 0) { phase_norm<false>(p, l == 0 ? (const float*)p.in[0] : p.out, (const float*)p.in[2] + (size_t)l * 1024); }
    else if (S == 1) { for (int u = bid; u < 128 * 17; u += G) gemm2a_unit(p, l, u, lds); }
    else if (S == 2) { for (int u = bid; u < 1024; u += G) prep_unit(p, l, u); }
    else if (S == 3) {
        const int nscan = G >= 512 ? 256 : G / 2;
        if (bid < nscan) { for (int u = bid; u < 256; u += nscan) scan_unit(p, l, u); }
        else { for (int u = bid - nscan; u < 128 * 26; u += G - nscan) gemm2b_unit(p, l, u, lds); }
    }
    else if (S == 4) { for (int u = bid; u < 512 + 1536; u += G) { if (u < 512) mixa_unit(p, l, u, lds); else attn_unit(p, u - 512, lds); } }
    else if (S == 5) { phase_post(p, l); }
    else if (S == 6) { for (int u = bid; u < 1024; u += G) merge_unit(p, l, u, lds); }
    else if (S == 7) { for (int u = bid; u < 1024 + 6144; u += G) { if (u < 1024) outproj_unit(p, l, u, lds); else conv_expert_unit(p, l, u - 1024, lds); } }
    else if (S == 8) { for (int u = bid; u < 128; u += G) router_unit(p, l, u, lds); }
    else if (S == 9) { moe_up_phase(p, l, lds); }
    else if (S == 10) { moe_down_phase(p, l, lds); }
}

template <int S>
__global__ void __launch_bounds__(256, 2) stage_kernel(Params p, int l) {
    __shared__ __attribute__((aligned(16))) char lds[LDS_BYTES + 16];
    run_stage<S>(p, l, lds);
}

#if MK_FUSED
__global__ void __launch_bounds__(256, 2) mega_kernel(Params p) {
    __shared__ __attribute__((aligned(16))) char lds[LDS_BYTES + 16];
    volatile LAS unsigned* st = (volatile LAS unsigned*)(lds + LDS_BYTES);
    if (threadIdx.x == 0) { st[0] = 0u; st[1] = 0u; st[2] = 0u; st[3] = 0u; }
    __syncthreads();
    XcdBarrier xb = xcd_barrier_post((unsigned*)(p.ws + OFF_CTRL), st);
    run_stage<100>(p, 0, lds); xcd_barrier(xb);
#define MK_LAYER(l) \
    run_stage<0>(p, l, lds); xcd_barrier(xb); run_stage<1>(p, l, lds); xcd_barrier(xb); run_stage<2>(p, l, lds); xcd_barrier(xb); \
    run_stage<3>(p, l, lds); xcd_barrier(xb); run_stage<4>(p, l, lds); xcd_barrier(xb); run_stage<5>(p, l, lds); xcd_barrier(xb); \
    run_stage<6>(p, l, lds); xcd_barrier(xb); run_stage<7>(p, l, lds); xcd_barrier(xb); run_stage<8>(p, l, lds); xcd_barrier(xb); \
    run_stage<9>(p, l, lds); xcd_barrier(xb); run_stage<10>(p, l, lds); xcd_barrier(xb);
    MK_LAYER(0)
    MK_LAYER(1)
    run_stage<101>(p, 0, lds);
}
#endif

#ifndef DBG
#define DBG 0
#endif
__global__ void dump_kernel(const u16* src, size_t stride, int width, float* out) {
    const size_t i = (size_t)blockIdx.x * 256 + threadIdx.x;
    const size_t tok = i >> 10; const int c = (int)(i & 1023);
    out[i] = bf2f(src[tok * stride + (c % width)]);
}
#define DUMP(off, stride, width) dump_kernel<<<dim3(NTOK * 1024 / 256), dim3(256), 0, stream>>>((const u16*)((char*)d_ws + (off)), stride, width, (float*)d_out)
#define LAUNCH_STAGE(S, l) stage_kernel<S><<<dim3(grid_blocks), dim3(256), 0, stream>>>(p, l)
extern "C" void kernel_launch(void* const* d_in, const int* in_sizes, int n_in, void* d_out, int out_size, void* d_ws, size_t ws_size, hipStream_t stream) {
    static int grid_blocks = 0;
    if (!grid_blocks) {
        int dev = 0, cus = 0, per_cu = 2;
        (void)hipGetDevice(&dev);
        (void)hipDeviceGetAttribute(&cus, hipDeviceAttributeMultiprocessorCount, dev);
#if MK_FUSED
        (void)hipOccupancyMaxActiveBlocksPerMultiprocessor(&per_cu, mega_kernel, 256, 0);
        if (per_cu > 2) per_cu = 2;
        if (per_cu < 1) per_cu = 1;
#endif
        if (cus <= 0) cus = 256;
        grid_blocks = cus * per_cu;
    }
    if (ws_size < OFF_END || n_in < 42) { fprintf(stderr, "workspace too small or bad inputs\n"); return; }
    Params p{};
    for (int i = 0; i < 42; ++i) p.in[i] = d_in[i];
    p.out = (float*)d_out; p.ws = (char*)d_ws;
    (void)hipMemsetAsync(d_ws, 0, 65536, stream);
#if MK_FUSED
    void* args[] = {&p};
    hipError_t e = hipLaunchCooperativeKernel((void*)mega_kernel, dim3(grid_blocks), dim3(256), args, 0, stream);
    if (e != hipSuccess) fprintf(stderr, "cooperative launch failed: %s (grid %d)\n", hipGetErrorString(e), grid_blocks);
#else
    LAUNCH_STAGE(100, 0);
    for (int l = 0; l < 2; ++l) {
        LAUNCH_STAGE(0, l); LAUNCH_STAGE(1, l);
        if (DBG == 1) { DUMP(OFF_R + R_PROJC, 1536, 1024); return; }
        LAUNCH_STAGE(2, l);
        if (DBG == 2) { DUMP(OFF_KR, 1024, 1024); return; }
        LAUNCH_STAGE(3, l);
        if (DBG == 3) { DUMP(OFF_YRAW, 512, 512); return; }
        if (DBG == 4) { DUMP(OFF_R + R_PROJB, 2304, 1024); return; }
        LAUNCH_STAGE(4, l);
        if (DBG == 5) { DUMP(OFF_R + R_PROJB, 2304, 1024); return; }
        if (DBG == 6) { DUMP(OFF_R + R_PROJA, 1024, 512); return; }
        LAUNCH_STAGE(5, l);
        if (DBG == 10) { DUMP(OFF_G, 512, 512); return; }
        if (DBG == 11) { DUMP(OFF_R + R_PROJB + 768 * 2, 2304, 256); return; }
        LAUNCH_STAGE(6, l);
        if (DBG == 7) { DUMP(OFF_MERGED, 1024, 1024); return; }
        LAUNCH_STAGE(7, l);
        if (DBG == 8) return;
        LAUNCH_STAGE(8, l); LAUNCH_STAGE(9, l); LAUNCH_STAGE(10, l);
        if (DBG == 9) return;
    }
    LAUNCH_STAGE(101, 0);
#endif
}
```

```cpp
#include <hip/hip_runtime.h>
#include <hip/hip_cooperative_groups.h>
#include <stdint.h>
#include <cstdio>

#ifndef MK_FUSED
#define MK_FUSED 1
#endif
#ifndef TIMING_PHASE
#define TIMING_PHASE -1
#endif
#ifndef DUP_STAGE
#define DUP_STAGE -1
#endif

typedef short bf16x8 __attribute__((ext_vector_type(8)));
typedef short bf16x4 __attribute__((ext_vector_type(4)));
typedef float f32x4 __attribute__((ext_vector_type(4)));
typedef __bf16 bf2_t __attribute__((ext_vector_type(2)));
typedef short v4i16_t __attribute__((ext_vector_type(4)));
typedef _Float16 h2_t __attribute__((ext_vector_type(2)));
typedef unsigned short u16;
#define LAS __attribute__((address_space(3)))

constexpr int NTOK = 16384, DM = 1024, SEQ = 2048;
constexpr int NPH = 24;
constexpr int LDS_BYTES = 66 * 1024;

constexpr size_t OFF_CTRL = 0;
constexpr size_t OFF_ROT  = 65536;
constexpr size_t OFF_WNE  = OFF_ROT + 2 * (size_t)NTOK * 8 * 4;
constexpr size_t WNE_WTC = 0, WNE_WTAB = 4456448, WNE_WGATE = 11272192, WNE_WBRA = 17563648, WNE_WBRB = 18612224,
                 WNE_WBRC = 19136512, WNE_WOUT = 20185088, WNE_W2T = 22282240, WNE_A2T = 22347776, WNE_G2T = 22413312,
                 WNE_V2T = 22544384, WNE_WR = 22577152, WNE_SZ = 22839296;
constexpr size_t OFF_H    = OFF_WNE + 2 * WNE_SZ;
constexpr size_t OFF_V    = OFF_H + (size_t)NTOK * 1024 * 2;
constexpr size_t OFF_KR   = OFF_V + 2 * (size_t)NTOK * 512 * 2;
constexpr size_t OFF_BK   = OFF_KR + (size_t)NTOK * 2048;
constexpr size_t OFF_W    = OFF_BK + (size_t)NTOK * 2048;
constexpr size_t OFF_G    = OFF_W + (size_t)NTOK * 1024;
constexpr size_t OFF_YRAW = OFF_G + (size_t)NTOK * 1024;
constexpr size_t OFF_BONUS= OFF_YRAW + (size_t)NTOK * 1024;
constexpr size_t OFF_LSE  = OFF_BONUS + (size_t)NTOK * 32;
constexpr size_t OFF_R    = OFF_LSE + (size_t)3 * NTOK * 16;
constexpr size_t R_PROJA = 0;
constexpr size_t R_PROJB = (size_t)NTOK * 2048;
constexpr size_t R_PROJC = 0;
constexpr size_t R_LORA1 = (size_t)NTOK * 3072;
constexpr size_t R_WEXP  = 0;
constexpr size_t R_HID   = 50331648;
constexpr size_t R_SZ    = (size_t)NTOK * (2048 + 4608);
constexpr size_t OFF_UP8  = OFF_R + R_SZ;
constexpr size_t OFF_WSA  = OFF_UP8 + (size_t)16 * 512 * 1024;
constexpr size_t OFF_END  = OFF_WSA + (size_t)2 * 4 * 128 * 128 * 2;
constexpr size_t OFF_KK = OFF_KR;
constexpr size_t OFF_RR = OFF_KR + (size_t)NTOK * 1024;
constexpr size_t OFF_PC = OFF_W;
constexpr size_t OFF_COEF = OFF_W + (size_t)4 * 1024 * 1024;
constexpr size_t OFF_MERGED = OFF_KR;
constexpr size_t OFF_DOWN8 = OFF_W + (size_t)8 * 1024 * 1024;
constexpr size_t OFF_WEXP = OFF_BK;
constexpr size_t OFF_PERM = OFF_YRAW;
constexpr size_t OFF_CW   = OFF_YRAW + (size_t)24 * 16384 * 4;
static_assert((size_t)NTOK * 2048 + (size_t)NTOK * 1024 >= 50331648, "WEXP overlay");
static_assert((size_t)24 * 16384 * 12 <= (size_t)NTOK * 1024, "perm/cw overlay");
static_assert(OFF_END <= 356000000, "workspace too large");
static_assert(R_HID + (size_t)19456 * 2048 <= R_SZ, "R region");
constexpr int CT_CNT = 8192;

struct Params {
    const void* in[42];
    float* out;
    char* ws;
    int pad0, pad1;
};

typedef float f2_t __attribute__((ext_vector_type(2)));
__device__ __forceinline__ unsigned pk_bf16(float lo, float hi) { f2_t f; f[0] = lo; f[1] = hi; return __builtin_bit_cast(unsigned, __builtin_convertvector(f, bf2_t)); }
__device__ __forceinline__ float bflo(unsigned u) { return __uint_as_float(u << 16); }
__device__ __forceinline__ float bfhi(unsigned u) { return __uint_as_float(u & 0xffff0000u); }
__device__ __forceinline__ float bf2f(u16 h) { return __uint_as_float(((unsigned)h) << 16); }
__device__ __forceinline__ u16 f2bf(float f) { return (u16)(pk_bf16(f, 0.f) & 0xffffu); }
__device__ __forceinline__ uint2 pk4(f32x4 v) { return make_uint2(pk_bf16(v[0], v[1]), pk_bf16(v[2], v[3])); }
__device__ __forceinline__ f32x4 unpk4(uint2 u) { f32x4 r; r[0] = bflo(u.x); r[1] = bfhi(u.x); r[2] = bflo(u.y); r[3] = bfhi(u.y); return r; }
__device__ __forceinline__ float fast_rcp(float x) { return __builtin_amdgcn_rcpf(x); }
__device__ __forceinline__ float fast_exp(float x) { return __builtin_amdgcn_exp2f(x * 1.4426950408889634f); }
__device__ __forceinline__ float sigmoidf_(float x) { return fast_rcp(1.f + fast_exp(-x)); }
__device__ __forceinline__ float gelu_tanh(float x) { const float z = 0.7978845608028654f * (x + 0.044715f * x * x * x); return x * fast_rcp(1.f + fast_exp(-2.f * z)); }
__device__ __forceinline__ float dot2bf(unsigned a, unsigned b, float c) { return __builtin_amdgcn_fdot2_f32_bf16(__builtin_bit_cast(bf2_t, a), __builtin_bit_cast(bf2_t, b), c, false); }
template <int CTRL> __device__ __forceinline__ float dpp_f(float x) { return __builtin_bit_cast(float, __builtin_amdgcn_update_dpp(0, __builtin_bit_cast(int, x), CTRL, 0xf, 0xf, false)); }
__device__ __forceinline__ float rowsum16(float x) { x += dpp_f<0x128>(x); x += dpp_f<0x124>(x); x += dpp_f<0x122>(x); x += dpp_f<0x121>(x); return x; }
__device__ __forceinline__ float wavesum(float x) { x += __shfl_xor(x, 32); x += __shfl_xor(x, 16); x += __shfl_xor(x, 8); x += __shfl_xor(x, 4); x += __shfl_xor(x, 2); x += __shfl_xor(x, 1); return x; }
__device__ __forceinline__ bf16x8 mk8(uint4 u) { return __builtin_bit_cast(bf16x8, u); }
__device__ __forceinline__ int tid_opaque() { int t = threadIdx.x; asm volatile("" : "+v"(t)); return t; }
#define MFMA16(a, b, c) __builtin_amdgcn_mfma_f32_16x16x32_bf16(a, b, c, 0, 0, 0)
typedef int i32x8 __attribute__((ext_vector_type(8)));
#define MFMA8X(a, b, c) __builtin_amdgcn_mfma_scale_f32_16x16x128_f8f6f4(a, b, c, 0, 0, 0, 0x7f7f7f7f, 0, 0x7f7f7f7f)
__device__ __forceinline__ unsigned pk_fp8x4(float a, float b, float c, float d) {
    int r = __builtin_amdgcn_cvt_pk_fp8_f32(a, b, 0, false);
    r = __builtin_amdgcn_cvt_pk_fp8_f32(c, d, r, true);
    return (unsigned)r;
}
constexpr float HID_SCALE = 8.f;
constexpr float GATE_WSCALE = 32.f;

#define XB_TMO      128
#define XB_XCNT(j)  (256  + 64 * (j))
#define XB_XSUB(j)  (1280 + 64 * (j))
#define XB_XGEN(j)  (2304 + 64 * (j))
#define XB_TOP      3328
#define XB_TOPGEN   3392
#define XCD_BAR_WORDS 3456
#define XB_SPIN_CAP (1u << 22)
__device__ __forceinline__ unsigned xb_ld(unsigned* p)              { return __hip_atomic_load(p, __ATOMIC_RELAXED, __HIP_MEMORY_SCOPE_AGENT); }
__device__ __forceinline__ unsigned xb_add(unsigned* p, unsigned v) { return __hip_atomic_fetch_add(p, v, __ATOMIC_RELAXED, __HIP_MEMORY_SCOPE_AGENT); }
__device__ __forceinline__ unsigned xb_xcc_id() { return (unsigned)__builtin_amdgcn_s_getreg((3 << 11) | 20) & 0xFu; }
#define XB_SPIN(cond, bar) do { unsigned _sp = 0; while (cond) { __builtin_amdgcn_s_sleep(1); \
    if ((++_sp & 255u) == 0u) { if (xb_ld(&(bar)[XB_TMO])) break; if (_sp > XB_SPIN_CAP) { atomicAdd(&(bar)[XB_TMO], 1u); break; } } } } while (0)
struct XcdBarrier { unsigned* bar; unsigned x; volatile LAS unsigned* st; };
__device__ __forceinline__ XcdBarrier xcd_barrier_post(unsigned* bar, volatile LAS unsigned* st) {
    XcdBarrier b; b.bar = bar; b.x = xb_xcc_id(); b.st = st;
    if (threadIdx.x == 0) (void)xb_add(&bar[XB_XCNT(b.x)], 1u);
    return b;
}
__device__ __forceinline__ void xcd_barrier_complete(unsigned* bar, unsigned x, unsigned& nloc, unsigned& nx) {
    const unsigned G = gridDim.x * gridDim.y * gridDim.z;
    unsigned sum, cnt, mine, sp = 0u;
    for (;;) {
        sum = 0u; cnt = 0u; mine = 0u;
#pragma unroll
        for (unsigned j = 0; j < 16; ++j) { const unsigned c = xb_ld(&bar[XB_XCNT(j)]); sum += c; cnt += (c > 0u) ? 1u : 0u; mine = (j == x) ? c : mine; }
        if (sum == G) break;
        __builtin_amdgcn_s_sleep(1);
        if ((++sp & 255u) == 0u) { if (xb_ld(&bar[XB_TMO])) break; if (sp > XB_SPIN_CAP) { atomicAdd(&bar[XB_TMO], 1u); break; } }
    }
    nloc = mine > 0u ? mine : 1u; nx = cnt > 0u ? cnt : 1u;
}
__device__ __forceinline__ void xcd_barrier(const XcdBarrier& b) {
    asm volatile("s_waitcnt vmcnt(0)" ::: "memory");
    __syncthreads();
    if (threadIdx.x == 0) {
        unsigned* bar = b.bar;
        __builtin_amdgcn_s_waitcnt(0);
        unsigned nloc = b.st[0], nx = b.st[1];
        if (nloc == 0u) { xcd_barrier_complete(bar, b.x, nloc, nx); b.st[0] = nloc; b.st[1] = nx; }
        const unsigned old = xb_add(&bar[XB_XSUB(b.x)], 1u);
        const unsigned gen = old / nloc;
        if (old + 1u == (gen + 1u) * nloc) {
            __builtin_amdgcn_fence(__ATOMIC_RELEASE, "agent");
            asm volatile("s_waitcnt vmcnt(0)" ::: "memory");
            const unsigned og = xb_add(&bar[XB_TOP], 1u);
            const unsigned tg = og / nx;
            if (og + 1u == (tg + 1u) * nx) xb_add(&bar[XB_TOPGEN], 1u);
            else XB_SPIN(xb_ld(&bar[XB_TOPGEN]) == tg, bar);
            __builtin_amdgcn_fence(__ATOMIC_ACQUIRE, "agent");
            xb_add(&bar[XB_XGEN(b.x)], 1u);
            asm volatile("s_waitcnt vmcnt(0)" ::: "memory");
        } else {
            XB_SPIN(xb_ld(&bar[XB_XGEN(b.x)]) == gen, bar);
            __builtin_amdgcn_fence(__ATOMIC_ACQUIRE, "agent");
            asm volatile("s_waitcnt vmcnt(0)" ::: "memory");
        }
    }
    __syncthreads();
}

__device__ __forceinline__ int toff(int row, int chunk) { return row * 128 + ((chunk ^ ((row >> 1) & 7)) << 4); }

template <int MT, int NT, bool F8 = false, class AL, class BL>
__device__ __forceinline__ void gemm_kloop(f32x4 (&acc)[MT][NT], const AL& al, const BL& bl, int nk, char* lds, int tid) {
    const int lane = tid & 63, w = tid >> 6;
    const int wm = (MT == 4) ? (w >> 1) : w, wn = (MT == 4) ? (w & 1) : 0;
    const int fr = lane & 15, fg = lane >> 4;
    const int lrow = lane >> 3, pc = lane & 7;
    unsigned va[4], vb[4];
#pragma unroll
    for (int q = 0; q < 4; ++q) { const int row = w * 32 + q * 8 + lrow; const int c = pc ^ ((row >> 1) & 7); va[q] = al.off(q, row, c); vb[q] = bl.off(q, row, c); }
    char* ldw = lds + __builtin_amdgcn_readfirstlane(w) * 4096;
#define GK_STAGE(kt_, buf_) do { const char* ua_ = al.ub(kt_); const char* ub_ = bl.ub(kt_); char* dA_ = ldw + (buf_) * 32768; \
        _Pragma("unroll") for (int q_ = 0; q_ < 4; ++q_) { \
            __builtin_amdgcn_global_load_lds((const unsigned*)(ua_ + va[q_]), (unsigned*)(dA_ + q_ * 1024), 16, 0, 0); \
            __builtin_amdgcn_global_load_lds((const unsigned*)(ub_ + vb[q_]), (unsigned*)(dA_ + 16384 + q_ * 1024), 16, 0, 0); } } while (0)
    GK_STAGE(0, 0);
    asm volatile("s_waitcnt vmcnt(0)" ::: "memory");
    __syncthreads();
    for (int kt = 0; kt < nk; ++kt) {
        const char* cA = lds + (kt & 1) * 32768; const char* cB = cA + 16384;
        if (kt + 1 < nk) GK_STAGE(kt + 1, (kt + 1) & 1);
        if (F8) {
            i32x8 af[MT], bfr[NT];
#pragma unroll
            for (int i = 0; i < MT; ++i) { const uint4 lo = *(const uint4*)(cA + toff(wm * MT * 16 + i * 16 + fr, fg)), hi = *(const uint4*)(cA + toff(wm * MT * 16 + i * 16 + fr, 4 + fg));
                                           af[i] = (i32x8){(int)lo.x, (int)lo.y, (int)lo.z, (int)lo.w, (int)hi.x, (int)hi.y, (int)hi.z, (int)hi.w}; }
#pragma unroll
            for (int j = 0; j < NT; ++j) { const uint4 lo = *(const uint4*)(cB + toff(wn * NT * 16 + j * 16 + fr, fg)), hi = *(const uint4*)(cB + toff(wn * NT * 16 + j * 16 + fr, 4 + fg));
                                           bfr[j] = (i32x8){(int)lo.x, (int)lo.y, (int)lo.z, (int)lo.w, (int)hi.x, (int)hi.y, (int)hi.z, (int)hi.w}; }
#pragma unroll
            for (int i = 0; i < MT; ++i)
#pragma unroll
                for (int j = 0; j < NT; ++j) acc[i][j] = MFMA8X(bfr[j], af[i], acc[i][j]);
        } else {
#pragma unroll
        for (int s = 0; s < 2; ++s) {
            bf16x8 af[MT], bfr[NT];
#pragma unroll
            for (int i = 0; i < MT; ++i) af[i] = *(const bf16x8*)(cA + toff(wm * MT * 16 + i * 16 + fr, s * 4 + fg));
#pragma unroll
            for (int j = 0; j < NT; ++j) bfr[j] = *(const bf16x8*)(cB + toff(wn * NT * 16 + j * 16 + fr, s * 4 + fg));
#pragma unroll
            for (int i = 0; i < MT; ++i)
#pragma unroll
                for (int j = 0; j < NT; ++j) acc[i][j] = MFMA16(bfr[j], af[i], acc[i][j]);
        }
        }
        asm volatile("s_waitcnt vmcnt(0)" ::: "memory");
        __syncthreads();
    }
#undef GK_STAGE
}
__device__ __forceinline__ void gemm_kloop2(f32x4 (&acc)[4][4], uint2 (&yb)[4][4], const u16* a1, int lda1, const u16* b1, int ldb1, int nk1,
                                            const u16* a2, int lda2, const u16* b2, int ldb2, int nk2, char* lds, int tid) {
    const int lane = tid & 63, w = tid >> 6;
    const int wm = w >> 1, wn = w & 1;
    const int fr = lane & 15, fg = lane >> 4;
    const int lrow = lane >> 3, pc = lane & 7;
    const int nk = nk1 + nk2;
#define GK_STAGE2(kt_, buf_) do { char* dA_ = lds + (buf_) * 32768 + w * 4096 + lane * 16; \
        const bool f_ = (kt_) < nk1; const u16* ab_ = f_ ? a1 : a2; const u16* bb_ = f_ ? b1 : b2; const int la_ = f_ ? lda1 : lda2, lb_ = f_ ? ldb1 : ldb2; \
        const int kk_ = (f_ ? (kt_) : (kt_) - nk1) * 64; \
        _Pragma("unroll") for (int q_ = 0; q_ < 4; ++q_) { const int row_ = w * 32 + q_ * 8 + lrow; const int c_ = (pc ^ ((row_ >> 1) & 7)) * 8 + kk_; \
            __builtin_amdgcn_global_load_lds((const unsigned*)(ab_ + (size_t)row_ * la_ + c_), (unsigned*)(dA_ + q_ * 1024), 16, 0, 0); \
            __builtin_amdgcn_global_load_lds((const unsigned*)(bb_ + (size_t)row_ * lb_ + c_), (unsigned*)(dA_ + 16384 + q_ * 1024), 16, 0, 0); } } while (0)
    GK_STAGE2(0, 0);
    asm volatile("s_waitcnt vmcnt(0)" ::: "memory");
    __syncthreads();
#pragma unroll 1
    for (int kt = 0; kt < nk1; ++kt) {
        const char* cA = lds + (kt & 1) * 32768; const char* cB = cA + 16384;
        if (kt + 1 < nk) GK_STAGE2(kt + 1, (kt + 1) & 1);
#pragma unroll
        for (int s = 0; s < 2; ++s) {
            bf16x8 af[4], bfr[4];
#pragma unroll
            for (int i = 0; i < 4; ++i) af[i] = *(const bf16x8*)(cA + toff(wm * 64 + i * 16 + fr, s * 4 + fg));
#pragma unroll
            for (int j = 0; j < 4; ++j) bfr[j] = *(const bf16x8*)(cB + toff(wn * 64 + j * 16 + fr, s * 4 + fg));
#pragma unroll
            for (int i = 0; i < 4; ++i)
#pragma unroll
                for (int j = 0; j < 4; ++j) acc[i][j] = MFMA16(bfr[j], af[i], acc[i][j]);
        }
        asm volatile("s_waitcnt vmcnt(0)" ::: "memory");
        __syncthreads();
    }
#pragma unroll
    for (int i = 0; i < 4; ++i)
#pragma unroll
        for (int j = 0; j < 4; ++j) { yb[i][j] = pk4(acc[i][j]); acc[i][j] = (f32x4){0.f, 0.f, 0.f, 0.f}; }
#pragma unroll 1
    for (int kt = nk1; kt < nk; ++kt) {
        const char* cA = lds + (kt & 1) * 32768; const char* cB = cA + 16384;
        if (kt + 1 < nk) GK_STAGE2(kt + 1, (kt + 1) & 1);
        {
            i32x8 af[4], bfr[4];
#pragma unroll
            for (int i = 0; i < 4; ++i) { const uint4 lo = *(const uint4*)(cA + toff(wm * 64 + i * 16 + fr, fg)), hi = *(const uint4*)(cA + toff(wm * 64 + i * 16 + fr, 4 + fg));
                                          af[i] = (i32x8){(int)lo.x, (int)lo.y, (int)lo.z, (int)lo.w, (int)hi.x, (int)hi.y, (int)hi.z, (int)hi.w}; }
#pragma unroll
            for (int j = 0; j < 4; ++j) { const uint4 lo = *(const uint4*)(cB + toff(wn * 64 + j * 16 + fr, fg)), hi = *(const uint4*)(cB + toff(wn * 64 + j * 16 + fr, 4 + fg));
                                          bfr[j] = (i32x8){(int)lo.x, (int)lo.y, (int)lo.z, (int)lo.w, (int)hi.x, (int)hi.y, (int)hi.z, (int)hi.w}; }
#pragma unroll
            for (int i = 0; i < 4; ++i)
#pragma unroll
                for (int j = 0; j < 4; ++j) acc[i][j] = MFMA8X(bfr[j], af[i], acc[i][j]);
        }
        asm volatile("s_waitcnt vmcnt(0)" ::: "memory");
        __syncthreads();
    }
#undef GK_STAGE2
}
template <int MT, int NT> __device__ __forceinline__ void acc_zero(f32x4 (&acc)[MT][NT]) {
#pragma unroll
    for (int i = 0; i < MT; ++i)
#pragma unroll
        for (int j = 0; j < NT; ++j) acc[i][j] = (f32x4){0.f, 0.f, 0.f, 0.f};
}
struct RowLoader {
    const u16* base; int ld;
    __device__ __forceinline__ RowLoader(const u16* b, int l, int) : base(b), ld(l) {}
    __device__ __forceinline__ unsigned off(int q, int row, int c) const { return (unsigned)(row * ld + c * 8) * 2u; }
    __device__ __forceinline__ const char* ub(int kt) const { return (const char*)base + kt * 128; }
};

struct ConvJob { const float* src; int ldsrc; int K; int nc; u16* dst; int ldd; const float* scale; int smode; };
__device__ __forceinline__ void conv_tile(const ConvJob& jb, int tk, int tn, char* lds) {
    float* T = (float*)lds;
    const int tid = tid_opaque();
    const int k0 = tk * 64, n0 = tn * 64;
    const bool full = (jb.src != nullptr) && (k0 + 64 <= jb.K) && (n0 + 64 <= jb.nc) && ((jb.ldsrc & 3) == 0);
    if (full) {
        const int n4 = (tid & 15) * 4, kb = tid >> 4;
#pragma unroll
        for (int i = 0; i < 4; ++i) {
            const int kl = kb + 16 * i; const int k = k0 + kl;
            f32x4 v = *(const f32x4*)(jb.src + (size_t)k * jb.ldsrc + n0 + n4);
            if (jb.smode == 1) v = v * (1.f - jb.scale[k]); else if (jb.smode == 2) v = v * jb.scale[k];
            T[kl * 65 + n4] = v[0]; T[kl * 65 + n4 + 1] = v[1]; T[kl * 65 + n4 + 2] = v[2]; T[kl * 65 + n4 + 3] = v[3];
        }
    } else {
        const int nl = tid & 63, kb = tid >> 6;
#pragma unroll
        for (int i = 0; i < 16; ++i) {
            const int kl = kb + 4 * i; const int k = k0 + kl, n = n0 + nl;
            float v = 0.f;
            if (jb.src != nullptr && k < jb.K && n < jb.nc) {
                v = jb.src[(size_t)k * jb.ldsrc + n];
                if (jb.smode == 1) v *= (1.f - jb.scale[k]); else if (jb.smode == 2) v *= jb.scale[k];
            }
            T[kl * 65 + nl] = v;
        }
    }
    __syncthreads();
    if (full || ((k0 + 64 <= jb.K) && (n0 + 64 <= jb.nc))) {
        const int k8 = (tid & 7) * 8, nb = tid >> 3;
#pragma unroll
        for (int i = 0; i < 2; ++i) {
            const int nl = nb + 32 * i;
            const uint4 o = make_uint4(pk_bf16(T[(k8 + 0) * 65 + nl], T[(k8 + 1) * 65 + nl]), pk_bf16(T[(k8 + 2) * 65 + nl], T[(k8 + 3) * 65 + nl]),
                                       pk_bf16(T[(k8 + 4) * 65 + nl], T[(k8 + 5) * 65 + nl]), pk_bf16(T[(k8 + 6) * 65 + nl], T[(k8 + 7) * 65 + nl]));
            *(uint4*)(jb.dst + (size_t)(n0 + nl) * jb.ldd + k0 + k8) = o;
        }
    } else {
        const int kp = tid & 31, nb = tid >> 5;
#pragma unroll
        for (int i = 0; i < 8; ++i) {
            const int nl = nb + 8 * i; const int n = n0 + nl, k = k0 + 2 * kp;
            if (n < jb.nc && k < jb.K) {
                const unsigned pv = pk_bf16(T[(2 * kp) * 65 + nl], T[(2 * kp + 1) * 65 + nl]);
                *(unsigned*)(jb.dst + (size_t)n * jb.ldd + k) = pv;
            }
        }
    }
    __syncthreads();
}
constexpr int NE_JOBS = 23;
__device__ __forceinline__ void ne_job_dims(int j, int& K, int& nc) {
    K = 1024; nc = 64;
    switch (j) {
        case 0: nc = 1536; break; case 1: case 2: case 5: case 6: nc = 64; break; case 3: case 7: nc = 128; break; case 4: case 8: nc = 32; break;
        case 9: nc = 64; break; case 10: nc = 3328; break; case 11: nc = 3072; break; case 12: K = 512; nc = 1024; break; case 13: K = 256; nc = 1024; break;
        case 14: K = 512; nc = 1024; break; case 15: nc = 1024; break; case 16: case 17: K = 64; nc = 512; break; case 18: K = 128; nc = 512; break;
        case 19: K = 32; nc = 512; break; case 20: nc = 4; break; case 21: nc = 16; break; case 22: nc = 108; break;
    }
}
__device__ __forceinline__ void ne_job(const Params& p, int l, int j, ConvJob& jb) {
    char* wne = p.ws + OFF_WNE + (size_t)l * WNE_SZ;
    int K, nc; ne_job_dims(j, K, nc);
    jb.K = K; jb.nc = nc; jb.scale = nullptr; jb.smode = 0; jb.ldd = K; jb.src = nullptr; jb.ldsrc = nc; jb.dst = (u16*)wne;
    const float* w_in = (const float*)p.in[3] + (size_t)l * 1024 * 4864;
    const float* muwag = (const float*)p.in[9] + (size_t)l * 3 * 1024;
    const float* muv = (const float*)p.in[23];
    u16* wtc = (u16*)(wne + WNE_WTC);
    switch (j) {
        case 0: jb.src = w_in + 3328; jb.ldsrc = 4864; jb.dst = wtc; break;
        case 1: jb.src = (const float*)p.in[11] + (size_t)l * 1024 * 64; jb.dst = wtc + 1536 * 1024; jb.scale = muwag; jb.smode = 1; break;
        case 2: jb.src = (const float*)p.in[14] + (size_t)l * 1024 * 64; jb.dst = wtc + 1600 * 1024; jb.scale = muwag + 1024; jb.smode = 1; break;
        case 3: jb.src = (const float*)p.in[16] + (size_t)l * 1024 * 128; jb.dst = wtc + 1664 * 1024; jb.scale = muwag + 2048; jb.smode = 1; break;
        case 4: jb.src = (l == 1) ? (const float*)p.in[25] : nullptr; jb.dst = wtc + 2048 * 1024; jb.scale = muv; jb.smode = 1; break;
        case 5: jb.src = (const float*)p.in[11] + (size_t)l * 1024 * 64; jb.dst = wtc + 1792 * 1024; jb.scale = muwag; jb.smode = 2; break;
        case 6: jb.src = (const float*)p.in[14] + (size_t)l * 1024 * 64; jb.dst = wtc + 1856 * 1024; jb.scale = muwag + 1024; jb.smode = 2; break;
        case 7: jb.src = (const float*)p.in[16] + (size_t)l * 1024 * 128; jb.dst = wtc + 1920 * 1024; jb.scale = muwag + 2048; jb.smode = 2; break;
        case 8: jb.src = (l == 1) ? (const float*)p.in[25] : nullptr; jb.dst = wtc + 2080 * 1024; jb.scale = muv; jb.smode = 2; break;
        case 9: jb.src = nullptr; jb.dst = wtc + 2112 * 1024; break;
        case 10: jb.src = w_in; jb.ldsrc = 4864; jb.dst = (u16*)(wne + WNE_WTAB); break;
        case 11: jb.src = (const float*)p.in[30] + (size_t)l * 1024 * 3072; jb.dst = (u16*)(wne + WNE_WGATE); jb.smode = 3; break;
        case 12: jb.src = (const float*)p.in[27] + (size_t)l * 512 * 1024; jb.dst = (u16*)(wne + WNE_WBRA); break;
        case 13: jb.src = (const float*)p.in[28] + (size_t)l * 256 * 1024; jb.dst = (u16*)(wne + WNE_WBRB); break;
        case 14: jb.src = (const float*)p.in[29] + (size_t)l * 512 * 1024; jb.dst = (u16*)(wne + WNE_WBRC); break;
        case 15: jb.src = (const float*)p.in[32] + (size_t)l * 1024 * 1024; jb.dst = (u16*)(wne + WNE_WOUT); break;
        case 16: jb.src = (const float*)p.in[12] + (size_t)l * 64 * 512; jb.dst = (u16*)(wne + WNE_W2T); break;
        case 17: jb.src = (const float*)p.in[15] + (size_t)l * 64 * 512; jb.dst = (u16*)(wne + WNE_A2T); break;
        case 18: jb.src = (const float*)p.in[17] + (size_t)l * 128 * 512; jb.dst = (u16*)(wne + WNE_G2T); break;
        case 19: jb.src = (l == 1) ? (const float*)p.in[26] : nullptr; jb.dst = (u16*)(wne + WNE_V2T); break;
        case 20: jb.src = (const float*)p.in[34] + (size_t)l * 1024 * 4; jb.dst = (u16*)(wne + WNE_WR); break;
        case 21: jb.src = (const float*)p.in[36] + (size_t)l * 1024 * 16; jb.dst = (u16*)(wne + WNE_WR) + 4 * 1024; break;
        case 22: jb.src = nullptr; jb.dst = (u16*)(wne + WNE_WR) + 20 * 1024; break;
    }
}
__device__ __forceinline__ int ne_total_tiles() {
    int tot = 0;
#pragma unroll
    for (int j = 0; j < NE_JOBS; ++j) { int K, nc; ne_job_dims(j, K, nc); tot += ((K + 63) / 64) * ((nc + 63) / 64); }
    return tot;
}
__device__ __forceinline__ bool conv_full(const ConvJob& jb, int tk, int tn) { return (jb.src != nullptr) && (tk * 64 + 64 <= jb.K) && (tn * 64 + 64 <= jb.nc) && ((jb.ldsrc & 3) == 0); }
__device__ __forceinline__ void conv_load(const ConvJob& jb, int tk, int tn, f32x4 (&v)[4], float (&sc)[4], int tid) {
    const int n4 = (tid & 15) * 4, kb = tid >> 4;
#pragma unroll
    for (int i = 0; i < 4; ++i) {
        const int k = tk * 64 + kb + 16 * i;
        v[i] = *(const f32x4*)(jb.src + (size_t)k * jb.ldsrc + tn * 64 + n4);
        sc[i] = (jb.smode == 1 || jb.smode == 2) ? jb.scale[k] : 1.f;
    }
}
__device__ __forceinline__ void conv_finish(const ConvJob& jb, int tk, int tn, const f32x4 (&v)[4], const float (&sc)[4], char* lds, int tid) {
    float* T = (float*)lds;
    const int k0 = tk * 64, n0 = tn * 64;
    {
        const int n4 = (tid & 15) * 4, kb = tid >> 4;
#pragma unroll
        for (int i = 0; i < 4; ++i) {
            const int kl = kb + 16 * i;
            const float m = (jb.smode == 1) ? (1.f - sc[i]) : (jb.smode == 3 ? GATE_WSCALE : sc[i]);
            const f32x4 w = v[i] * m;
            T[kl * 65 + n4] = w[0]; T[kl * 65 + n4 + 1] = w[1]; T[kl * 65 + n4 + 2] = w[2]; T[kl * 65 + n4 + 3] = w[3];
        }
    }
    __syncthreads();
    {
        const int k8 = (tid & 7) * 8, nb = tid >> 3;
#pragma unroll
        for (int i = 0; i < 2; ++i) {
            const int nl = nb + 32 * i;
            if (jb.smode == 3) {
                const uint2 o8 = make_uint2(pk_fp8x4(T[(k8 + 0) * 65 + nl], T[(k8 + 1) * 65 + nl], T[(k8 + 2) * 65 + nl], T[(k8 + 3) * 65 + nl]),
                                            pk_fp8x4(T[(k8 + 4) * 65 + nl], T[(k8 + 5) * 65 + nl], T[(k8 + 6) * 65 + nl], T[(k8 + 7) * 65 + nl]));
                *(uint2*)((char*)jb.dst + (size_t)(n0 + nl) * jb.ldd + k0 + k8) = o8;
            } else {
            const uint4 o = make_uint4(pk_bf16(T[(k8 + 0) * 65 + nl], T[(k8 + 1) * 65 + nl]), pk_bf16(T[(k8 + 2) * 65 + nl], T[(k8 + 3) * 65 + nl]),
                                       pk_bf16(T[(k8 + 4) * 65 + nl], T[(k8 + 5) * 65 + nl]), pk_bf16(T[(k8 + 6) * 65 + nl], T[(k8 + 7) * 65 + nl]));
            *(uint4*)(jb.dst + (size_t)(n0 + nl) * jb.ldd + k0 + k8) = o;
            }
        }
    }
    __syncthreads();
}
__device__ __forceinline__ void ne_decode(const Params& p, int per_layer, int u, ConvJob& jb, int& tk, int& tn) {
    const int l = u / per_layer; int t = u % per_layer; int j = 0;
    for (; j < NE_JOBS; ++j) { int K, nc; ne_job_dims(j, K, nc); const int c = ((K + 63) / 64) * ((nc + 63) / 64); if (t < c) break; t -= c; }
    ne_job(p, l, j, jb);
    const int ntn = (jb.nc + 63) / 64;
    tk = t / ntn; tn = t % ntn;
}
__device__ void phase_conv_ne(const Params& p, char* lds) {
    const int per_layer = ne_total_tiles();
    const int nconv = 2 * per_layer;
    const int nrot = NTOK * 8 / 256;
    const int tid = tid_opaque();
    const int G = gridDim.x;
    f32x4 v[4]; float sc[4]; bool fc = false;
#pragma unroll
    for (int i = 0; i < 4; ++i) { v[i] = (f32x4){0.f, 0.f, 0.f, 0.f}; sc[i] = 1.f; }
    { const int u = blockIdx.x; if (u < nconv) { ConvJob jb; int tk, tn; ne_decode(p, per_layer, u, jb, tk, tn); fc = conv_full(jb, tk, tn); if (fc) conv_load(jb, tk, tn, v, sc, tid); } }
#pragma unroll 1
    for (int u = blockIdx.x; u < nconv; u += G) {
        f32x4 vn[4]; float scn[4]; bool fn = false;
#pragma unroll
        for (int i = 0; i < 4; ++i) { vn[i] = (f32x4){0.f, 0.f, 0.f, 0.f}; scn[i] = 1.f; }
        const int un = u + G;
        if (un < nconv) { ConvJob jn; int tk, tn; ne_decode(p, per_layer, un, jn, tk, tn); fn = conv_full(jn, tk, tn); if (fn) conv_load(jn, tk, tn, vn, scn, tid); }
        { ConvJob jb; int tk, tn; ne_decode(p, per_layer, u, jb, tk, tn);
          if (fc) conv_finish(jb, tk, tn, v, sc, lds, tid); else conv_tile(jb, tk, tn, lds); }
#pragma unroll
        for (int i = 0; i < 4; ++i) { v[i] = vn[i]; sc[i] = scn[i]; }
        fc = fn;
    }
    for (int r = blockIdx.x; r < 64; r += G) {
        const int e8 = (r * 256 + threadIdx.x) * 8;
        const int t_ = (e8 >> 7) & 127, s0_ = e8 & 127;
        const f32x4 w0 = *(const f32x4*)((const float*)p.in[6] + e8), w1 = *(const f32x4*)((const float*)p.in[6] + e8 + 4);
        unsigned ow[4];
#pragma unroll
        for (int k = 0; k < 4; ++k) { const int si = s0_ + 2 * k; const float a = (k < 2) ? w0[2 * k] : w1[2 * k - 4], b2 = (k < 2) ? w0[2 * k + 1] : w1[2 * k - 3];
                                      ow[k] = pk_bf16(si <= t_ ? a : 0.f, (si + 1) <= t_ ? b2 : 0.f); }
        *(uint4*)(p.ws + OFF_WSA + (size_t)e8 * 2) = make_uint4(ow[0], ow[1], ow[2], ow[3]);
    }
    for (int r = blockIdx.x; r < nrot; r += G) {
        const int e = r * 256 + threadIdx.x;
        const int tok = e >> 3, i = e & 7;
        const float pos = (float)((const int*)p.in[1])[tok];
        const float inv = __expf(-(float)i * (13.122363377404328f / 8.f));
        float sn, cs; sincosf(pos * inv, &sn, &cs);
        ((float*)(p.ws + OFF_ROT))[e] = cs;
        ((float*)(p.ws + OFF_ROT))[(size_t)NTOK * 8 + e] = sn;
    }
}
__device__ __forceinline__ char* wexp_base(const Params& p, int l, int mat) {
    return p.ws + (mat == 0 ? (OFF_V + (l == 0 ? (size_t)NTOK * 1024 : 0)) : (mat == 1 ? OFF_UP8 : OFF_DOWN8));
}
__device__ __forceinline__ void expert_decode(const Params& p, int l, int u, ConvJob& jb, int& tk, int& tn) {
    const int mat = u >> 11, e = (u & 2047) >> 7, tile = u & 127;
    jb.scale = nullptr; jb.smode = 0;
    if (mat < 2) {
        jb.src = (const float*)p.in[38 + mat] + ((size_t)l * 16 + e) * 1024 * 512; jb.ldsrc = 512; jb.K = 1024; jb.nc = 512;
        jb.dst = (u16*)(wexp_base(p, l, mat) + (size_t)e * 512 * 1024); jb.ldd = 1024; jb.smode = 3;
        tk = tile >> 3; tn = tile & 7;
    } else {
        jb.src = (const float*)p.in[40] + ((size_t)l * 16 + e) * 512 * 1024; jb.ldsrc = 1024; jb.K = 512; jb.nc = 1024;
        jb.dst = (u16*)(wexp_base(p, l, 2) + (size_t)e * 512 * 1024); jb.ldd = 512; jb.smode = 3;
        tk = tile >> 4; tn = tile & 15;
    }
}
__device__ __forceinline__ void conv_expert_unit(const Params& p, int l, int u, char* lds) {
    ConvJob jb; int tk, tn; expert_decode(p, l, u, jb, tk, tn);
    conv_tile(jb, tk, tn, lds);
}
__device__ __forceinline__ void conv_expert_run(const Params& p, int l, int t0, int n, int G, int tend, char* lds) {
    const int tid = tid_opaque();
    f32x4 v[4]; float sc[4]; bool have = false;
#pragma unroll
    for (int i = 0; i < 4; ++i) { v[i] = (f32x4){0.f, 0.f, 0.f, 0.f}; sc[i] = 1.f; }
    if (n > 0 && t0 < tend) { ConvJob jb; int tk, tn; expert_decode(p, l, t0, jb, tk, tn); conv_load(jb, tk, tn, v, sc, tid); have = true; }
#pragma unroll 1
    for (int i = 0; i < n; ++i) {
        const int tc = t0 + i * G, tx = tc + G;
        f32x4 vn[4]; float scn[4]; bool hn = false;
#pragma unroll
        for (int q = 0; q < 4; ++q) { vn[q] = (f32x4){0.f, 0.f, 0.f, 0.f}; scn[q] = 1.f; }
        if (i + 1 < n && tx < tend) { ConvJob jn; int tk, tn; expert_decode(p, l, tx, jn, tk, tn); conv_load(jn, tk, tn, vn, scn, tid); hn = true; }
        if (have) { ConvJob jb; int tk, tn; expert_decode(p, l, tc, jb, tk, tn); conv_finish(jb, tk, tn, v, sc, lds, tid); }
#pragma unroll
        for (int q = 0; q < 4; ++q) { v[q] = vn[q]; sc[q] = scn[q]; }
        have = hn;
    }
}

template <bool FINAL>
__device__ void phase_norm(const Params& p, const float* x, const float* g) {
    const int tid_ = tid_opaque();
    const int lane = tid_ & 63;
    const int gw = blockIdx.x * 4 + (tid_ >> 6);
    const int nwv = gridDim.x * 4;
    float4 gg[4];
#pragma unroll
    for (int i = 0; i < 4; ++i) gg[i] = ((const float4*)g)[lane + 64 * i];
#pragma unroll 1
    for (int row0 = gw; row0 < NTOK; row0 += 4 * nwv) {
        float4 v[4][4];
#pragma unroll
        for (int rr = 0; rr < 4; ++rr) {
            const float4* xr = (const float4*)(x + (size_t)min(row0 + rr * nwv, NTOK - 1) * 1024);
#pragma unroll
            for (int i = 0; i < 4; ++i) v[rr][i] = xr[lane + 64 * i];
        }
#pragma unroll
        for (int rr = 0; rr < 4; ++rr) {
            const int row = row0 + rr * nwv;
            float ss = 0.f;
#pragma unroll
            for (int i = 0; i < 4; ++i) ss += v[rr][i].x * v[rr][i].x + v[rr][i].y * v[rr][i].y + v[rr][i].z * v[rr][i].z + v[rr][i].w * v[rr][i].w;
            ss = wavesum(ss);
            const float rinv = rsqrtf(ss * (1.f / 1024.f) + 1e-6f);
            if (row < NTOK) {
#pragma unroll
                for (int i = 0; i < 4; ++i) {
                    const float a = v[rr][i].x * rinv * gg[i].x, b = v[rr][i].y * rinv * gg[i].y, c = v[rr][i].z * rinv * gg[i].z, d = v[rr][i].w * rinv * gg[i].w;
                    if (FINAL) ((float4*)(p.out + (size_t)row * 1024))[lane + 64 * i] = make_float4(a, b, c, d);
                    else ((uint2*)(p.ws + OFF_H + (size_t)row * 2048))[lane + 64 * i] = make_uint2(pk_bf16(a, b), pk_bf16(c, d));
                }
            }
        }
    }
}

__device__ void gemm2a_unit(const Params& p, int l, int u, int ntn, char* lds) {
    const int mt = u / ntn, nt = u % ntn;
    const int tid = tid_opaque();
    const int lane = tid & 63, w = tid >> 6, wm = w >> 1, wn = w & 1, fr = lane & 15, fg = lane >> 4;
    RowLoader al((const u16*)(p.ws + OFF_H) + (size_t)mt * 128 * 1024, 1024, tid);
    RowLoader bl((const u16*)(p.ws + OFF_WNE + (size_t)l * WNE_SZ + WNE_WTC) + (size_t)nt * 128 * 1024, 1024, tid);
    f32x4 acc[4][4]; acc_zero<4, 4>(acc);
    gemm_kloop<4, 4>(acc, al, bl, 16, lds, tid);
    u16* projc = (u16*)(p.ws + OFF_R + R_PROJC); u16* lora1 = (u16*)(p.ws + OFF_R + R_LORA1);
#pragma unroll
    for (int i = 0; i < 4; ++i)
#pragma unroll
        for (int j = 0; j < 4; ++j) {
            const int m = mt * 128 + wm * 64 + i * 16 + fr, n = nt * 128 + wn * 64 + j * 16 + fg * 4;
            const uint2 v = pk4(acc[i][j]);
            if (n < 1536) *(uint2*)(projc + (size_t)m * 1536 + n) = v;
            else if (n < 2112) *(uint2*)(lora1 + (size_t)m * 576 + (n - 1536)) = v;
        }
}
__device__ void gemm2b_unit(const Params& p, int l, int u, char* lds) {
    const int mt = u / 26, nt = u % 26;
    const int tid = tid_opaque();
    const int lane = tid & 63, w = tid >> 6, wm = w >> 1, wn = w & 1, fr = lane & 15, fg = lane >> 4;
    RowLoader al((const u16*)(p.ws + OFF_H) + (size_t)mt * 128 * 1024, 1024, tid);
    RowLoader bl((const u16*)(p.ws + OFF_WNE + (size_t)l * WNE_SZ + WNE_WTAB) + (size_t)nt * 128 * 1024, 1024, tid);
    f32x4 acc[4][4]; acc_zero<4, 4>(acc);
    gemm_kloop<4, 4>(acc, al, bl, 16, lds, tid);
    u16* proja = (u16*)(p.ws + OFF_R + R_PROJA); u16* projb = (u16*)(p.ws + OFF_R + R_PROJB);
    const float* rc = (const float*)(p.ws + OFF_ROT); const float* rs = rc + (size_t)NTOK * 8;
    const int nbase = nt * 128 + wn * 64;
#pragma unroll
    for (int i = 0; i < 4; ++i) {
        const int m = mt * 128 + wm * 64 + i * 16 + fr;
#pragma unroll
        for (int j = 0; j < 4; ++j) {
            const int n = nbase + j * 16 + fg * 4;
            f32x4 v = acc[i][j];
            if (nbase < 1024) {
#pragma unroll
                for (int q = 0; q < 4; ++q) v[q] = gelu_tanh(v[q]);
                *(uint2*)(proja + (size_t)m * 1024 + n) = pk4(v);
            } else {
                const int nb = n - 1024;
                if (nbase < 1024 + 1536 && j == 0) {
                    f32x4 pv;
#pragma unroll
                    for (int q = 0; q < 4; ++q) pv[q] = __shfl_xor(v[q], 32);
                    const f32x4 cs = *(const f32x4*)(rc + (size_t)m * 8 + (fg & 1) * 4);
                    const f32x4 sn = *(const f32x4*)(rs + (size_t)m * 8 + (fg & 1) * 4);
#pragma unroll
                    for (int q = 0; q < 4; ++q) v[q] = (fg < 2) ? (v[q] * cs[q] - pv[q] * sn[q]) : (v[q] * cs[q] + pv[q] * sn[q]);
                }
                if (nbase < 1024 + 768) { v = v * 0.125f; }
                *(uint2*)(projb + (size_t)m * 2304 + nb) = pk4(v);
            }
        }
    }
}

__device__ __forceinline__ bf16x8 act8(uint4 a, uint4 b, int mode) {
    unsigned av[4] = {a.x, a.y, a.z, a.w}, bv[4] = {b.x, b.y, b.z, b.w}; unsigned o[4];
#pragma unroll
    for (int q = 0; q < 4; ++q) {
        float lo = bflo(av[q]) + bflo(bv[q]), hi = bfhi(av[q]) + bfhi(bv[q]);
        if (mode == 1) { lo = 1.f - 2.f * fast_rcp(fast_exp(2.f * lo) + 1.f); hi = 1.f - 2.f * fast_rcp(fast_exp(2.f * hi) + 1.f); }
        else if (mode == 2) { lo = sigmoidf_(lo); hi = sigmoidf_(hi); }
        o[q] = pk_bf16(lo, hi);
    }
    return mk8(make_uint4(o[0], o[1], o[2], o[3]));
}
__device__ void prep_unit(const Params& p, int l, int u, char* lds) {
    const int tt = u >> 3, hh = u & 7;
    const int tid = tid_opaque();
    const int lane = tid & 63, w = tid >> 6, tl = lane & 15, G = lane >> 4;
    const char* wne = p.ws + OFF_WNE + (size_t)l * WNE_SZ;
    const u16* lora1 = (const u16*)(p.ws + OFF_R + R_LORA1);
    const u16* projc = (const u16*)(p.ws + OFF_R + R_PROJC);
    const u16* vfirst = (const u16*)(p.ws + OFF_V);
    u16* vout = (u16*)(p.ws + OFF_V + (size_t)l * NTOK * 1024);
    u16* gout = (u16*)(p.ws + OFF_G);
    uint2* KKo = (uint2*)(p.ws + OFF_KK); uint2* RRo = (uint2*)(p.ws + OFF_RR); uint4* BKo = (uint4*)(p.ws + OFF_BK); float* PCo = (float*)(p.ws + OFF_PC);
    float* bonus = (float*)(p.ws + OFF_BONUS);
    char* ldsW = lds; char* ldsA = lds + 8192; char* ldsG = lds + 16384; char* ldsV = lds + 32768; float* prm = (float*)(lds + 36864);
    __syncthreads();
    {
        const u16* w2 = (const u16*)(wne + WNE_W2T) + (size_t)hh * 64 * 64; const u16* a2 = (const u16*)(wne + WNE_A2T) + (size_t)hh * 64 * 64;
        const u16* g2 = (const u16*)(wne + WNE_G2T) + (size_t)hh * 64 * 128; const u16* v2 = (const u16*)(wne + WNE_V2T) + (size_t)hh * 64 * 32;
#pragma unroll
        for (int k = 0; k < 2; ++k) { const int q = tid + 256 * k, row = q >> 3, ch = q & 7;
            *(uint4*)(ldsW + toff(row, ch)) = *(const uint4*)(w2 + row * 64 + ch * 8); *(uint4*)(ldsA + toff(row, ch)) = *(const uint4*)(a2 + row * 64 + ch * 8); }
#pragma unroll
        for (int k = 0; k < 4; ++k) { const int q = tid + 256 * k, row = q >> 4, ch = q & 15; *(uint4*)(ldsG + row * 256 + ((ch ^ (row & 15)) << 4)) = *(const uint4*)(g2 + row * 128 + ch * 8); }
        if (l == 1) { const int row = tid >> 2, ch = tid & 3; *(uint4*)(ldsV + row * 64 + ch * 16) = *(const uint4*)(v2 + row * 32 + ch * 8); }
        const float* mu_rkv = (const float*)p.in[8] + (size_t)l * 3 * 512 + hh * 64;
        for (int q = tid; q < 9 * 64; q += 256) {
            const int a_ = q >> 6, c_ = q & 63; float v_;
            if (a_ < 3) v_ = mu_rkv[a_ * 512 + c_];
            else if (a_ == 3) v_ = ((const float*)p.in[10])[(size_t)l * 512 + hh * 64 + c_];
            else if (a_ == 4) v_ = ((const float*)p.in[13])[(size_t)l * 512 + hh * 64 + c_];
            else if (a_ == 5) v_ = ((const float*)p.in[18])[(size_t)l * 512 + hh * 64 + c_];
            else if (a_ == 6) v_ = ((const float*)p.in[19])[(size_t)l * 512 + hh * 64 + c_];
            else if (a_ == 7) v_ = ((const float*)p.in[20])[(size_t)l * 512 + hh * 64 + c_];
            else v_ = (l == 1) ? ((const float*)p.in[24])[hh * 64 + c_] : 0.f;
            prm[q] = v_;
        }
    }
    __syncthreads();
#pragma unroll 1
    for (int t2 = 0; t2 < 2; ++t2) {
        const int tk = tt * 128 + w * 32 + t2 * 16 + tl; const bool hp = (tk & (SEQ - 1)) != 0;
        uint4 xa[9], xb[9];
#pragma unroll
        for (int i = 0; i < 9; ++i) {
            const int cola = (i < 2) ? (i * 32) : (i < 4 ? 64 + (i - 2) * 32 : (i < 8 ? 128 + (i - 4) * 32 : 512));
            xa[i] = make_uint4(0, 0, 0, 0); xb[i] = xa[i];
            if (i < 8 || l == 1) {
                xa[i] = *(const uint4*)(lora1 + (size_t)tk * 576 + cola + 8 * G);
                if (hp) xb[i] = *(const uint4*)(lora1 + (size_t)(tk - 1) * 576 + ((i < 8) ? 256 : 32) + cola + 8 * G);
            }
        }
        uint2 rc[4], kc[4], vc[4], rp[4], kp_[4], vp[4], vf[4];
        f32x4 acc[4][4];
#pragma unroll
        for (int a_ = 0; a_ < 4; ++a_)
#pragma unroll
            for (int b_ = 0; b_ < 4; ++b_) acc[a_][b_] = (f32x4){0.f, 0.f, 0.f, 0.f};
#pragma unroll
        for (int i = 0; i < 9; ++i) {
            if (i == 4) {
#pragma unroll
            for (int ct = 0; ct < 4; ++ct) {
                const int c0 = hh * 64 + ct * 16 + G * 4;
                rc[ct] = *(const uint2*)(projc + (size_t)tk * 1536 + c0); kc[ct] = *(const uint2*)(projc + (size_t)tk * 1536 + 512 + c0); vc[ct] = *(const uint2*)(projc + (size_t)tk * 1536 + 1024 + c0);
                rp[ct] = make_uint2(0, 0); kp_[ct] = rp[ct]; vp[ct] = rp[ct]; vf[ct] = rp[ct];
                if (hp && tl == 0) { rp[ct] = *(const uint2*)(projc + (size_t)(tk - 1) * 1536 + c0); kp_[ct] = *(const uint2*)(projc + (size_t)(tk - 1) * 1536 + 512 + c0); vp[ct] = *(const uint2*)(projc + (size_t)(tk - 1) * 1536 + 1024 + c0); }
                if (l == 1) vf[ct] = *(const uint2*)(vfirst + (size_t)tk * 512 + c0);
            }
            }
            if (i == 8 && l == 0) continue;
            const int mat = (i < 2) ? 0 : (i < 4 ? 1 : (i < 8 ? 2 : 3));
            const int sidx = (i < 2) ? i : (i < 4 ? i - 2 : (i < 8 ? i - 4 : 0));
            const int mode = (mat == 0) ? 1 : (mat == 2 ? 2 : 0);
            const bf16x8 bfr = act8(xa[i], xb[i], mode);
#pragma unroll
            for (int ct = 0; ct < 4; ++ct) {
                const int row = ct * 16 + tl;
                bf16x8 af;
                if (mat == 0) af = *(const bf16x8*)(ldsW + toff(row, sidx * 4 + G));
                else if (mat == 1) af = *(const bf16x8*)(ldsA + toff(row, sidx * 4 + G));
                else if (mat == 2) af = *(const bf16x8*)(ldsG + row * 256 + (((sidx * 4 + G) ^ (row & 15)) << 4));
                else af = *(const bf16x8*)(ldsV + row * 64 + G * 16);
                acc[mat][ct] = MFMA16(af, bfr, acc[mat][ct]);
            }
        }
#define SHR1(x) ((unsigned)__builtin_amdgcn_update_dpp(0, (int)(x), 0x111, 0xf, 0xf, true))
#pragma unroll
        for (int ct = 0; ct < 4; ++ct) {
            const int cl = ct * 16 + G * 4;
            const uint2 a_ = make_uint2(SHR1(rc[ct].x), SHR1(rc[ct].y)), b_ = make_uint2(SHR1(kc[ct].x), SHR1(kc[ct].y)), c_ = make_uint2(SHR1(vc[ct].x), SHR1(vc[ct].y));
            const f32x4 r_p = unpk4((tl != 0) ? a_ : rp[ct]), k_p = unpk4((tl != 0) ? b_ : kp_[ct]), v_p = unpk4((tl != 0) ? c_ : vp[ct]);
            const f32x4 r_t = unpk4(rc[ct]), k_t = unpk4(kc[ct]), v_t = unpk4(vc[ct]);
            const f32x4 mur = *(const f32x4*)(prm + cl), muk = *(const f32x4*)(prm + 64 + cl), muv = *(const f32x4*)(prm + 2 * 64 + cl);
            rc[ct] = pk4(r_t + (r_p - r_t) * mur); kc[ct] = pk4(k_t + (k_p - k_t) * muk); vc[ct] = pk4(v_t + (v_p - v_t) * muv);
        }
#undef SHR1
        float ss = 0.f, bo = 0.f;
#pragma unroll
        for (int ct = 0; ct < 4; ++ct) {
            const int cl = ct * 16 + G * 4;
            const f32x4 k_k = *(const f32x4*)(prm + 5 * 64 + cl);
            const f32x4 kr = unpk4(kc[ct]) * k_k;
            ss += kr[0] * kr[0] + kr[1] * kr[1] + kr[2] * kr[2] + kr[3] * kr[3];
        }
        ss += __shfl_xor(ss, 16); ss += __shfl_xor(ss, 32);
        const float inv = __builtin_amdgcn_rsqf(fmaxf(ss, 1e-24f));
        uint2 kkprev = make_uint2(0, 0), rrprev = kkprev;
        uint2 kkpk[4], rrpk[4]; uint4 bkpk[4];
#pragma unroll
        for (int ct = 0; ct < 4; ++ct) {
            const int cl = ct * 16 + G * 4, c0 = hh * 64 + cl;
            const f32x4 acc_w = acc[0][ct], acc_a = acc[1][ct], acc_g = acc[2][ct], acc_v = acc[3][ct];
            const uint2 rcs = rc[ct], kcs = kc[ct], vcs = vc[ct], vfs = vf[ct];
            const f32x4 w0 = *(const f32x4*)(prm + 3 * 64 + cl), a0 = *(const f32x4*)(prm + 4 * 64 + cl), k_k = *(const f32x4*)(prm + 5 * 64 + cl), k_a = *(const f32x4*)(prm + 6 * 64 + cl), r_k = *(const f32x4*)(prm + 7 * 64 + cl);
            const f32x4 rr = unpk4(rcs);
            const f32x4 kx = unpk4(kcs);
            f32x4 vx = unpk4(vcs);
            f32x4 aa, k2, ee;
#pragma unroll
            for (int q = 0; q < 4; ++q) {
                const float wv = w0[q] + acc_w[q];
                ee[q] = -0.6065306597126334f * sigmoidf_(wv);
                aa[q] = sigmoidf_(a0[q] + acc_a[q]);
            }
            if (l == 1) {
                const f32x4 vfv = unpk4(vfs); const f32x4 v0 = *(const f32x4*)(prm + 8 * 64 + cl);
#pragma unroll
                for (int q = 0; q < 4; ++q) vx[q] = vx[q] + (vfv[q] - vx[q]) * sigmoidf_(v0[q] + acc_v[q]);
            }
#pragma unroll
            for (int q = 0; q < 4; ++q) {
                k2[q] = kx[q] * (1.f + (aa[q] - 1.f) * k_a[q]);
                bo += rr[q] * k2[q] * r_k[q];
            }
            f32x4 cs;
#pragma unroll
            for (int q = 0; q < 4; ++q) {
                float x = ee[q];
                x += __builtin_bit_cast(float, __builtin_amdgcn_update_dpp(0, __builtin_bit_cast(int, x), 0x111, 0xf, 0xf, true));
                x += __builtin_bit_cast(float, __builtin_amdgcn_update_dpp(0, __builtin_bit_cast(int, x), 0x112, 0xf, 0xf, true));
                x += __builtin_bit_cast(float, __builtin_amdgcn_update_dpp(0, __builtin_bit_cast(int, x), 0x114, 0xf, 0xf, true));
                x += __builtin_bit_cast(float, __builtin_amdgcn_update_dpp(0, __builtin_bit_cast(int, x), 0x118, 0xf, 0xf, true));
                cs[q] = x;
            }
            *(uint2*)(vout + (size_t)tk * 512 + c0) = pk4(vx);
            *(uint2*)(gout + (size_t)tk * 512 + c0) = pk4(acc_g);
            const size_t ci = ((size_t)tk * 8 + hh) * 64 + cl;
            f32x4 pt, ipt, ptm1;
#pragma unroll
            for (int q = 0; q < 4; ++q) { pt[q] = fast_exp(cs[q]); ipt[q] = fast_rcp(pt[q]); ptm1[q] = fast_exp(cs[q] - ee[q]); }
            const f32x4 kk = kx * k_k * inv;
            const f32x4 nk = -kk * ptm1, rt = rr * pt;
            const uint2 kkq = pk4(nk), rrq = pk4(rt);
            if ((ct & 1) == 0) { kkprev = kkq; rrprev = rrq; }
            else {
                const size_t vi = ((size_t)tk * 8 + hh) * 64 + ((ct >> 1) * 4 + G) * 8;
                ((uint4*)KKo)[vi >> 3] = make_uint4(kkprev.x, kkprev.y, kkq.x, kkq.y);
                ((uint4*)RRo)[vi >> 3] = make_uint4(rrprev.x, rrprev.y, rrq.x, rrq.y);
            }
            const f32x4 bb = kk * aa * ipt, kq = k2 * ipt;
            kkpk[ct] = kkq; rrpk[ct] = rrq;
            {
                unsigned m0 = pk_bf16(bb[0], kq[0]), m1 = pk_bf16(bb[1], kq[1]), m2 = pk_bf16(bb[2], kq[2]), m3 = pk_bf16(bb[3], kq[3]);
                bkpk[ct] = make_uint4(m0, m1, m2, m3);
                const bool ev = (tl & 1) == 0, lo = (tl & 2) == 0;
                const unsigned r0 = (unsigned)__builtin_amdgcn_update_dpp(0, (int)(ev ? m1 : m0), 0xB1, 0xf, 0xf, false), r1 = (unsigned)__builtin_amdgcn_update_dpp(0, (int)(ev ? m3 : m2), 0xB1, 0xf, 0xf, false);
                const unsigned n0 = ev ? m0 : r0, n1 = ev ? r0 : m1, n2 = ev ? m2 : r1, n3 = ev ? r1 : m3;
                const unsigned s0 = (unsigned)__builtin_amdgcn_update_dpp(0, (int)(lo ? n2 : n0), 0x4E, 0xf, 0xf, false), s1 = (unsigned)__builtin_amdgcn_update_dpp(0, (int)(lo ? n3 : n1), 0x4E, 0xf, 0xf, false);
                const uint4 o = lo ? make_uint4(n0, n1, s0, s1) : make_uint4(s0, s1, n2, n3);
                *(uint4*)((char*)BKo + (((size_t)(tk >> 2) * 8 + hh) * 64 + cl + (tl & 3)) * 16) = o;
            }
            if (tl == 15) *(f32x4*)(PCo + (((size_t)(tk >> 4) * 8 + hh) * 64 + cl)) = pt;
        }
        bo += __shfl_xor(bo, 16); bo += __shfl_xor(bo, 32);
        if (G == 0) bonus[(size_t)tk * 8 + hh] = bo;
        float qA[4], qB[4], qC[4], qD[4];
#pragma unroll
        for (int i = 0; i < 4; ++i) { qA[i] = 0.f; qB[i] = 0.f; qC[i] = 0.f; qD[i] = 0.f; }
#pragma unroll
        for (int ct = 0; ct < 4; ++ct) {
            const f32x4 nk = unpk4(kkpk[ct]), rt = unpk4(rrpk[ct]);
            const unsigned pw[4] = {bkpk[ct].x, bkpk[ct].y, bkpk[ct].z, bkpk[ct].w};
#define QUAD_ACC(i, CTRL) _Pragma("unroll") for (int q = 0; q < 4; ++q) { const unsigned pi_ = (unsigned)__builtin_amdgcn_update_dpp(0, (int)pw[q], CTRL, 0xf, 0xf, false); \
                const float bi = bflo(pi_), ki = bfhi(pi_); qA[i] += nk[q] * bi; qB[i] += nk[q] * ki; qC[i] += rt[q] * bi; qD[i] += rt[q] * ki; }
            QUAD_ACC(0, 0x00) QUAD_ACC(1, 0x55) QUAD_ACC(2, 0xAA) QUAD_ACC(3, 0xFF)
#undef QUAD_ACC
        }
#pragma unroll
        for (int i = 0; i < 4; ++i) {
            qA[i] += __shfl_xor(qA[i], 16); qA[i] += __shfl_xor(qA[i], 32); qB[i] += __shfl_xor(qB[i], 16); qB[i] += __shfl_xor(qB[i], 32);
            qC[i] += __shfl_xor(qC[i], 16); qC[i] += __shfl_xor(qC[i], 32); qD[i] += __shfl_xor(qD[i], 16); qD[i] += __shfl_xor(qD[i], 32);
        }
        if (G == 0) {
            float* cf = (float*)(p.ws + OFF_COEF) + ((size_t)(tk >> 2) * 8 + hh) * 32;
            const int j = tl & 3;
#pragma unroll
            for (int i = 0; i < 4; ++i) {
                if (i < j) { cf[j * (j - 1) / 2 + i] = qA[i]; cf[6 + j * (j - 1) / 2 + i] = qB[i]; }
                if (i <= j) { cf[12 + j * (j + 1) / 2 + i] = qC[i]; cf[22 + j * (j + 1) / 2 + i] = qD[i]; }
            }
        }
    }
}

typedef int i32x4 __attribute__((ext_vector_type(4)));
constexpr int SC_QRB = 2720, SC_CHB = 4 * SC_QRB, SC_BKO = 1024, SC_VO = 2048, SC_CFO = 2560, SC_ZOFF = 2688;
__device__ __forceinline__ void scan_unit(const Params& p, int l, int bh, char* lds) {
    const int b = bh >> 3, hh = bh & 7;
    const int tid = tid_opaque();
    const int lane = tid & 63, wq = tid >> 6, g = lane >> 4, c = lane & 15;
    const unsigned tok0 = (unsigned)b * SEQ;
    const __amdgpu_buffer_rsrc_t rs = __builtin_amdgcn_make_buffer_rsrc((void*)p.ws, 0, 0x7fffffff, 0x00020000);
    const unsigned vo_y  = (unsigned)OFF_YRAW + (tok0 * 512 + hh * 64 + wq * 16 + c) * 2;
    const unsigned vo_pc = (unsigned)OFF_PC + ((tok0 >> 4) * 8 + hh) * 256 + g * 16;
    unsigned gvo[3], lvo[3], gst[3];
#pragma unroll
    for (int k = 0; k < 3; ++k) {
        const int q = tid + 256 * k; const int qd = q / 168, r = q - qd * 168;
        const unsigned tq = tok0 + 4 * qd;
        unsigned go, st;
        if (r < 32)       { go = (unsigned)OFF_KK + ((tq + (r >> 3)) * 8 + hh) * 128 + (r & 7) * 16; st = 16384u; }
        else if (r < 64)  { go = (unsigned)OFF_RR + ((tq + ((r - 32) >> 3)) * 8 + hh) * 128 + (r & 7) * 16; st = 16384u; }
        else if (r < 128) { go = (unsigned)OFF_BK + ((tq >> 2) * 8 + hh) * 1024 + (r - 64) * 16; st = 32768u; }
        else if (r < 160) { go = (unsigned)(OFF_V + (size_t)l * NTOK * 1024) + ((tq + ((r - 128) >> 3)) * 512 + hh * 64) * 2 + (r & 7) * 16; st = 16384u; }
        else              { go = (unsigned)OFF_COEF + ((tq >> 2) * 8 + hh) * 128 + (r - 160) * 16; st = 4096u; }
        gvo[k] = go; lvo[k] = qd * SC_QRB + r * 16; gst[k] = st;
    }
    const bool has3 = tid < 160;
#define SC_SOFF(k, ch) ((unsigned)(ch) * gst[k])
    i32x4 st0, st1, st2;
#define SC_GLOAD(ch) do { st0 = __builtin_amdgcn_raw_buffer_load_b128(rs, gvo[0] + SC_SOFF(0, ch), 0, 0); st1 = __builtin_amdgcn_raw_buffer_load_b128(rs, gvo[1] + SC_SOFF(1, ch), 0, 0); \
        if (has3) st2 = __builtin_amdgcn_raw_buffer_load_b128(rs, gvo[2] + SC_SOFF(2, ch), 0, 0); } while (0)
#define SC_LSTORE(ch) do { char* d_ = lds + ((ch) & 3) * SC_CHB; *(i32x4*)(d_ + lvo[0]) = st0; *(i32x4*)(d_ + lvo[1]) = st1; if (has3) *(i32x4*)(d_ + lvo[2]) = st2; } while (0)
    st2 = (i32x4){0, 0, 0, 0};
    if (tid < 32) { *(i32x4*)(lds + (tid >> 1) * SC_QRB + SC_ZOFF + (tid & 1) * 16) = (i32x4){0, 0, 0, 0}; }
    SC_GLOAD(0); SC_LSTORE(0); SC_GLOAD(1); SC_LSTORE(1); SC_GLOAD(2); SC_LSTORE(2);
    __syncthreads();
    f32x4 Z0 = (f32x4){0.f, 0.f, 0.f, 0.f}, Z1 = Z0, Z2 = Z0, Z3 = Z0;
    const f32x4 z4 = (f32x4){0.f, 0.f, 0.f, 0.f};
    const int ad0 = (c < 4) ? (c * 128 + g * 16) : SC_ZOFF;
    const int ad1 = (c < 4) ? ad0 + 64 : SC_ZOFF;
    const int adr = (c < 4) ? 512 : 0;
    const int au = (g == 0) ? (SC_BKO + c * 16) : SC_ZOFF;
    const int austep = (g == 0) ? 256 : 0;
    const int vofs = (g == 0) ? (SC_VO + (wq * 16 + c) * 2) : SC_ZOFF;
    const int vstep = (g == 0) ? 128 : 0;
    uint4 ua0, ua1, ua2, ua3, ub0, ub1, ub2, ub3, bu = make_uint4(0u, 0u, 0u, 0u);
    bf16x8 a0c, a1c, a0n, a1n, r0c, r1c, r0n, r1n; unsigned v0c, v1c, v2c, v3c, v0n, v1n, v2n, v3n;
#define SC_LDSOPS(tb_, A0, A1, R0, R1, U0, U1, U2, U3, V0, V1, V2, V3) do { A0 = *(const bf16x8*)((tb_) + ad0); A1 = *(const bf16x8*)((tb_) + ad1); \
        R0 = *(const bf16x8*)((tb_) + ad0 + adr); R1 = *(const bf16x8*)((tb_) + ad1 + adr); \
        U0 = *(const uint4*)((tb_) + au); U1 = *(const uint4*)((tb_) + au + austep); U2 = *(const uint4*)((tb_) + au + 2 * austep); U3 = *(const uint4*)((tb_) + au + 3 * austep); \
        V0 = *(const u16*)((tb_) + vofs); V1 = *(const u16*)((tb_) + vofs + vstep); V2 = *(const u16*)((tb_) + vofs + 2 * vstep); V3 = *(const u16*)((tb_) + vofs + 3 * vstep); } while (0)
#define SC_STEP(tb_cur_, tb_next_, A0, A1, R0, R1, U0, U1, U2, U3, V0, V1, V2, V3, NA0, NA1, NR0, NR1, NU0, NU1, NU2, NU3, NV0, NV1, NV2, NV3, last_) do { \
        const f32x4 cf0_ = *(const f32x4*)((tb_cur_) + SC_CFO), cf1_ = *(const f32x4*)((tb_cur_) + SC_CFO + 16), cf2_ = *(const f32x4*)((tb_cur_) + SC_CFO + 32), cf3_ = *(const f32x4*)((tb_cur_) + SC_CFO + 48); \
        const f32x4 cf4_ = *(const f32x4*)((tb_cur_) + SC_CFO + 64), cf5_ = *(const f32x4*)((tb_cur_) + SC_CFO + 80), cf6_ = *(const f32x4*)((tb_cur_) + SC_CFO + 96), cf7_ = *(const f32x4*)((tb_cur_) + SC_CFO + 112); \
        SC_LDSOPS(tb_next_, NA0, NA1, NR0, NR1, NU0, NU1, NU2, NU3, NV0, NV1, NV2, NV3); \
        const bf16x8 sb0_ = mk8(make_uint4(pk_bf16(Z0[0], Z0[1]), pk_bf16(Z0[2], Z0[3]), pk_bf16(Z1[0], Z1[1]), pk_bf16(Z1[2], Z1[3]))); \
        const bf16x8 sb1_ = mk8(make_uint4(pk_bf16(Z2[0], Z2[1]), pk_bf16(Z2[2], Z2[3]), pk_bf16(Z3[0], Z3[1]), pk_bf16(Z3[2], Z3[3]))); \
        f32x4 d_ = MFMA16(A0, sb0_, z4); d_ = MFMA16(A1, sb1_, d_);            \
        f32x4 dy_ = MFMA16(R0, sb0_, z4); dy_ = MFMA16(R1, sb1_, dy_);        \
        const float w0_ = __uint_as_float(V0 << 16), w1_ = __uint_as_float(V1 << 16), w2_ = __uint_as_float(V2 << 16), w3_ = __uint_as_float(V3 << 16); \
          \
        const float b1_ = cf1_[2] * w0_, b2_ = cf1_[3] * w0_ + cf2_[0] * w1_, b3_ = cf2_[1] * w0_ + cf2_[2] * w1_ + cf2_[3] * w2_; \
        const float sa0_ = d_[0]; \
        const float sa1_ = (d_[1] + b1_) + cf0_[0] * sa0_; \
        const float sa2_ = (d_[2] + b2_) + cf0_[1] * sa0_ + cf0_[2] * sa1_; \
        const float sa3_ = (d_[3] + b3_) + cf0_[3] * sa0_ + cf1_[0] * sa1_ + cf1_[1] * sa2_; \
        bu.x = (g == 0) ? pk_bf16(sa0_, w0_) : 0u; bu.y = (g == 0) ? pk_bf16(sa1_, w1_) : 0u; bu.z = (g == 0) ? pk_bf16(sa2_, w2_) : 0u; bu.w = (g == 0) ? pk_bf16(sa3_, w3_) : 0u; \
        Z0 = MFMA16(mk8(U0), mk8(bu), Z0); Z1 = MFMA16(mk8(U1), mk8(bu), Z1); Z2 = MFMA16(mk8(U2), mk8(bu), Z2); Z3 = MFMA16(mk8(U3), mk8(bu), Z3); \
        { float y0_ = __builtin_fmaf(cf3_[0], sa0_, __builtin_fmaf(cf5_[2], w0_, dy_[0])); \
          float y1_ = __builtin_fmaf(cf3_[2], sa1_, __builtin_fmaf(cf3_[1], sa0_, __builtin_fmaf(cf6_[0], w1_, __builtin_fmaf(cf5_[3], w0_, dy_[1])))); \
          float y2_ = __builtin_fmaf(cf4_[1], sa2_, __builtin_fmaf(cf4_[0], sa1_, __builtin_fmaf(cf3_[3], sa0_, __builtin_fmaf(cf6_[3], w2_, __builtin_fmaf(cf6_[2], w1_, __builtin_fmaf(cf6_[1], w0_, dy_[2])))))); \
          float y3_ = __builtin_fmaf(cf5_[1], sa3_, __builtin_fmaf(cf5_[0], sa2_, __builtin_fmaf(cf4_[3], sa1_, __builtin_fmaf(cf4_[2], sa0_, __builtin_fmaf(cf7_[3], w3_, __builtin_fmaf(cf7_[2], w2_, __builtin_fmaf(cf7_[1], w1_, __builtin_fmaf(cf7_[0], w0_, dy_[3])))))))); \
          asm volatile("" : "+v"(y0_), "+v"(y1_), "+v"(y2_), "+v"(y3_));        \
          if (g == 0) { __builtin_amdgcn_raw_buffer_store_b16((u16)(pk_bf16(y0_, 0.f) & 0xffffu), rs, vo_y, (unsigned)(tcur) * 1024u, 0); \
                        __builtin_amdgcn_raw_buffer_store_b16((u16)(pk_bf16(y1_, 0.f) & 0xffffu), rs, vo_y, (unsigned)(tcur + 1) * 1024u, 0); \
                        __builtin_amdgcn_raw_buffer_store_b16((u16)(pk_bf16(y2_, 0.f) & 0xffffu), rs, vo_y, (unsigned)(tcur + 2) * 1024u, 0); \
                        __builtin_amdgcn_raw_buffer_store_b16((u16)(pk_bf16(y3_, 0.f) & 0xffffu), rs, vo_y, (unsigned)(tcur + 3) * 1024u, 0); } } \
        if (last_) { Z0 = Z0 * pc0; Z1 = Z1 * pc1; Z2 = Z2 * pc2; Z3 = Z3 * pc3; } \
        tcur += 4; } while (0)
    int tcur = 0;
    SC_LDSOPS(lds, a0c, a1c, r0c, r1c, ua0, ua1, ua2, ua3, v0c, v1c, v2c, v3c);
#pragma unroll 1
    for (int ch = 0; ch < SEQ / 16; ++ch) {
        if (ch + 3 < SEQ / 16) SC_GLOAD(ch + 3);
        const f32x4 pc0 = __builtin_bit_cast(f32x4, __builtin_amdgcn_raw_buffer_load_b128(rs, vo_pc, (unsigned)ch * 2048u, 0));
        const f32x4 pc1 = __builtin_bit_cast(f32x4, __builtin_amdgcn_raw_buffer_load_b128(rs, vo_pc + 64, (unsigned)ch * 2048u, 0));
        const f32x4 pc2 = __builtin_bit_cast(f32x4, __builtin_amdgcn_raw_buffer_load_b128(rs, vo_pc + 128, (unsigned)ch * 2048u, 0));
        const f32x4 pc3 = __builtin_bit_cast(f32x4, __builtin_amdgcn_raw_buffer_load_b128(rs, vo_pc + 192, (unsigned)ch * 2048u, 0));
        const char* cb = lds + (ch & 3) * SC_CHB;
        const char* nb = lds + ((ch + 1) & 3) * SC_CHB;
        SC_STEP(cb, cb + SC_QRB, a0c, a1c, r0c, r1c, ua0, ua1, ua2, ua3, v0c, v1c, v2c, v3c, a0n, a1n, r0n, r1n, ub0, ub1, ub2, ub3, v0n, v1n, v2n, v3n, false);
        SC_STEP(cb + SC_QRB, cb + 2 * SC_QRB, a0n, a1n, r0n, r1n, ub0, ub1, ub2, ub3, v0n, v1n, v2n, v3n, a0c, a1c, r0c, r1c, ua0, ua1, ua2, ua3, v0c, v1c, v2c, v3c, false);
        SC_STEP(cb + 2 * SC_QRB, cb + 3 * SC_QRB, a0c, a1c, r0c, r1c, ua0, ua1, ua2, ua3, v0c, v1c, v2c, v3c, a0n, a1n, r0n, r1n, ub0, ub1, ub2, ub3, v0n, v1n, v2n, v3n, false);
        SC_STEP(cb + 3 * SC_QRB, nb, a0n, a1n, r0n, r1n, ub0, ub1, ub2, ub3, v0n, v1n, v2n, v3n, a0c, a1c, r0c, r1c, ua0, ua1, ua2, ua3, v0c, v1c, v2c, v3c, true);
        if (ch + 3 < SEQ / 16) SC_LSTORE(ch + 3);
        __syncthreads();
    }
#undef SC_STEP
#undef SC_LDSOPS
#undef SC_GLOAD
#undef SC_LSTORE
#undef SC_SOFF
}

template <bool DRY>
__device__ void mixa_unit(const Params& p, int l, int u, char* lds) {
    const int g = u & 3, bc = u >> 2;
    const int tok0 = bc * 128;
    const int tid = tid_opaque();
    const int lane = tid & 63, w = tid >> 6, fr = lane & 15, G = lane >> 4;
    u16* proja = (u16*)(p.ws + OFF_R + R_PROJA);
    char* ldsV = lds; char* ldsW = lds + 32768; float2* stats = (float2*)(lds + 65536);
    uint4 wq[8];
    { const u16* wsa = (const u16*)(p.ws + OFF_WSA) + ((size_t)l * 4 + g) * 128 * 128;
#pragma unroll
      for (int i = 0; i < 8; ++i) { const int q = tid + 256 * i; wq[i] = *(const uint4*)(wsa + (size_t)q * 8); } }
#pragma unroll 1
    for (int r = 0; r < 32; r += 16) {
        uint4 xq[16];
#pragma unroll
        for (int rr = 0; rr < 16; ++rr) xq[rr] = *(const uint4*)(proja + (size_t)(tok0 + w * 32 + r + rr) * 1024 + 512 + lane * 8);
#pragma unroll
        for (int rr = 0; rr < 16; ++rr) {
            const unsigned xv[4] = {xq[rr].x, xq[rr].y, xq[rr].z, xq[rr].w};
            float s_ = 0.f, q_ = 0.f;
#pragma unroll
            for (int i = 0; i < 4; ++i) { const float a = bflo(xv[i]), b2 = bfhi(xv[i]); s_ += a + b2; q_ += a * a + b2 * b2; }
            s_ = rowsum16(s_); q_ = rowsum16(q_);
            s_ += __shfl_xor(s_, 16); q_ += __shfl_xor(q_, 16); s_ += __shfl_xor(s_, 32); q_ += __shfl_xor(q_, 32);
            const float mu = s_ * (1.f / 512.f); const float var = fmaxf(q_ * (1.f / 512.f) - mu * mu, 0.f);
            if (lane == 0) stats[w * 32 + r + rr] = make_float2(mu, rsqrtf(var + 1e-5f));
        }
    }
#pragma unroll
    for (int i = 0; i < 8; ++i) { const int q = tid + 256 * i, row = q >> 4, ch = q & 15; *(uint4*)(ldsW + row * 256 + ((ch ^ (row & 15)) << 4)) = wq[i]; }
    __syncthreads();
    const float* lng = (const float*)p.in[4] + (size_t)l * 512 + g * 128;
    const float* lnb = (const float*)p.in[5] + (size_t)l * 512 + g * 128;
#pragma unroll
    for (int i = 0; i < 8; ++i) {
        const int q = tid + 256 * i, row = q >> 4, ch = q & 15;
        const uint4 x = *(const uint4*)(proja + (size_t)(tok0 + row) * 1024 + 512 + g * 128 + ch * 8);
        const float2 st = stats[row];
        const f32x4 g0 = *(const f32x4*)(lng + ch * 8), g1 = *(const f32x4*)(lng + ch * 8 + 4), b0 = *(const f32x4*)(lnb + ch * 8), b1 = *(const f32x4*)(lnb + ch * 8 + 4);
        const unsigned xv[4] = {x.x, x.y, x.z, x.w}; unsigned o[4];
#pragma unroll
        for (int k = 0; k < 4; ++k) {
            const float ga = (k < 2) ? g0[2 * k] : g1[2 * k - 4], gb = (k < 2) ? g0[2 * k + 1] : g1[2 * k - 3];
            const float ba = (k < 2) ? b0[2 * k] : b1[2 * k - 4], bb = (k < 2) ? b0[2 * k + 1] : b1[2 * k - 3];
            o[k] = pk_bf16((bflo(xv[k]) - st.x) * st.y * ga + ba, (bfhi(xv[k]) - st.x) * st.y * gb + bb);
        }
        const int f = (row & 3) | (((row >> 3) & 1) << 2);
        *(uint4*)(ldsV + row * 256 + (((ch >> 1) ^ f) << 5) + ((ch & 1) << 4)) = make_uint4(o[0], o[1], o[2], o[3]);
    }
    __syncthreads();
    uint2 uq[2][8];
#pragma unroll
    for (int t2 = 0; t2 < 2; ++t2)
#pragma unroll
        for (int ct = 0; ct < 8; ++ct) uq[t2][ct] = *(const uint2*)(proja + (size_t)(tok0 + w * 32 + t2 * 16 + fr) * 1024 + g * 128 + ct * 16 + G * 4);
    f32x4 acc[2][8];
#pragma unroll
    for (int a = 0; a < 2; ++a)
#pragma unroll
        for (int b = 0; b < 8; ++b) acc[a][b] = (f32x4){0.f, 0.f, 0.f, 0.f};
    const int qrow = (lane & 15) >> 2, pcol = lane & 3;
    for (int ss = 0; ss <= w; ++ss) {
        bf16x8 bw[2];
#pragma unroll
        for (int t2 = 0; t2 < 2; ++t2) { const int t = w * 32 + t2 * 16 + fr; bw[t2] = *(const bf16x8*)(ldsW + t * 256 + (((ss * 4 + G) ^ (t & 15)) << 4)); }
#pragma unroll
        for (int ct = 0; ct < 8; ++ct) {
            const int ra = ss * 32 + 8 * G + qrow, rb2 = ra + 4;
            const int fa = (ra & 3) | (((ra >> 3) & 1) << 2), fb = (rb2 & 3) | (((rb2 >> 3) & 1) << 2);
            const v4i16_t lo = __builtin_amdgcn_ds_read_tr16_b64_v4i16((LAS v4i16_t*)(ldsV + ra * 256 + ((ct ^ fa) << 5) + pcol * 8));
            const v4i16_t hi = __builtin_amdgcn_ds_read_tr16_b64_v4i16((LAS v4i16_t*)(ldsV + rb2 * 256 + ((ct ^ fb) << 5) + pcol * 8));
            bf16x8 af; af[0] = lo[0]; af[1] = lo[1]; af[2] = lo[2]; af[3] = lo[3]; af[4] = hi[0]; af[5] = hi[1]; af[6] = hi[2]; af[7] = hi[3];
            acc[0][ct] = MFMA16(af, bw[0], acc[0][ct]);
            acc[1][ct] = MFMA16(af, bw[1], acc[1][ct]);
        }
    }
    const float* bs = (const float*)p.in[7] + ((size_t)l * 4 + g) * 128;
#pragma unroll
    for (int t2 = 0; t2 < 2; ++t2) {
        const int t = w * 32 + t2 * 16 + fr; const float bias = bs[t];
#pragma unroll
        for (int ct = 0; ct < 8; ++ct) {
            u16* pu = proja + (size_t)(tok0 + t) * 1024 + g * 128 + ct * 16 + G * 4;
            const f32x4 uu = unpk4(uq[t2][ct]);
            f32x4 y;
#pragma unroll
            for (int q = 0; q < 4; ++q) y[q] = uu[q] * (acc[t2][ct][q] + bias);
            if (!DRY) *(uint2*)pu = pk4(y); else asm volatile("" :: "v"(y[0] + y[1] + y[2] + y[3]));
        }
    }
    __syncthreads();
}

template <bool DRY>
__device__ void attn_unit(const Params& p, int u, char* lds) {
    const int hq = u & 3, combo = (u >> 2) % 48, b = (u >> 2) / 48;
    int g, r, n, dil;
    if (combo < 16) { g = 0; r = 0; n = combo; dil = 1; } else if (combo < 32) { g = 1; r = (combo - 16) >> 2; n = (combo - 16) & 3; dil = 4; } else { g = 2; r = combo - 32; n = 0; dil = 16; }
    const int head = g * 4 + hq;
    const int tid = tid_opaque();
    const int lane = tid & 63, w = tid >> 6, fr = lane & 15, G = lane >> 4;
    u16* projb = (u16*)(p.ws + OFF_R + R_PROJB);
    char* ldsK = lds; char* ldsV = lds + 32768;
    const size_t tokb = (size_t)b * SEQ + r;
#pragma unroll
    for (int i = 0; i < 8; ++i) {
        const int q = tid + 256 * i, row = q >> 3, ch = q & 7;
        const int idx = (n - 1) * 128 + row;
        uint4 kx = make_uint4(0, 0, 0, 0), vx = kx;
        if (idx >= 0) {
            const u16* src = projb + (tokb + (size_t)idx * dil) * 2304 + head * 64 + ch * 8;
            kx = *(const uint4*)(src + 768); vx = *(const uint4*)(src + 1536);
        }
        *(uint4*)(ldsK + toff(row, ch)) = kx;
        *(uint4*)(ldsV + row * 128 + (((ch >> 1) ^ ((row >> 1) & 3)) << 5) + ((ch & 1) << 4)) = vx;
    }
    bf16x8 qf[2][2]; size_t qtok[2];
#pragma unroll
    for (int qt = 0; qt < 2; ++qt) {
        qtok[qt] = tokb + (size_t)(n * 128 + w * 32 + qt * 16 + fr) * dil;
#pragma unroll
        for (int s = 0; s < 2; ++s) qf[qt][s] = mk8(*(const uint4*)(projb + qtok[qt] * 2304 + head * 64 + s * 32 + 8 * G));
    }
    __syncthreads();
    f32x4 sc[2][10];
#pragma unroll
    for (int qt = 0; qt < 2; ++qt)
#pragma unroll
        for (int uu = 0; uu < 10; ++uu) sc[qt][uu] = (f32x4){0.f, 0.f, 0.f, 0.f};
#pragma unroll
    for (int uu = 0; uu < 10; ++uu)
#pragma unroll
        for (int s = 0; s < 2; ++s) {
            const bf16x8 kf = *(const bf16x8*)(ldsK + toff((2 * w + uu) * 16 + fr, s * 4 + G));
            sc[0][uu] = MFMA16(kf, qf[0][s], sc[0][uu]);
            sc[1][uu] = MFMA16(kf, qf[1][s], sc[1][uu]);
        }
    float mx[2], sm[2];
#pragma unroll
    for (int qt = 0; qt < 2; ++qt) {
        const int qi = w * 32 + qt * 16 + fr;
        float m = -1e30f;
#pragma unroll
        for (int uu = 0; uu < 10; ++uu)
#pragma unroll
            for (int q = 0; q < 4; ++q) {
                const int kj = (2 * w + uu) * 16 + G * 4 + q;
                const bool valid = (kj >= qi) && (kj <= qi + 128) && (n > 0 || kj >= 128);
                const float v = valid ? sc[qt][uu][q] : -1e30f;
                sc[qt][uu][q] = v; m = fmaxf(m, v);
            }
        m = fmaxf(m, __shfl_xor(m, 16)); m = fmaxf(m, __shfl_xor(m, 32));
        float s = 0.f;
#pragma unroll
        for (int uu = 0; uu < 10; ++uu)
#pragma unroll
            for (int q = 0; q < 4; ++q) { const float e = fast_exp(sc[qt][uu][q] - m); sc[qt][uu][q] = e; s += e; }
        s += __shfl_xor(s, 16); s += __shfl_xor(s, 32);
        mx[qt] = m; sm[qt] = s;
    }
    f32x4 oc[2][4];
#pragma unroll
    for (int qt = 0; qt < 2; ++qt)
#pragma unroll
        for (int dt = 0; dt < 4; ++dt) oc[qt][dt] = (f32x4){0.f, 0.f, 0.f, 0.f};
    const int qrow = (lane & 15) >> 2, pcol = lane & 3;
#pragma unroll
    for (int ks = 0; ks < 5; ++ks) {
        bf16x8 pf[2];
#pragma unroll
        for (int qt = 0; qt < 2; ++qt)
            pf[qt] = mk8(make_uint4(pk_bf16(sc[qt][2 * ks][0], sc[qt][2 * ks][1]), pk_bf16(sc[qt][2 * ks][2], sc[qt][2 * ks][3]),
                                    pk_bf16(sc[qt][2 * ks + 1][0], sc[qt][2 * ks + 1][1]), pk_bf16(sc[qt][2 * ks + 1][2], sc[qt][2 * ks + 1][3])));
        const int ra = (2 * w + 2 * ks) * 16 + 4 * G + qrow, rb2 = ra + 16;
#pragma unroll
        for (int dt = 0; dt < 4; ++dt) {
            const v4i16_t lo = __builtin_amdgcn_ds_read_tr16_b64_v4i16((LAS v4i16_t*)(ldsV + ra * 128 + ((dt ^ ((ra >> 1) & 3)) << 5) + pcol * 8));
            const v4i16_t hi = __builtin_amdgcn_ds_read_tr16_b64_v4i16((LAS v4i16_t*)(ldsV + rb2 * 128 + ((dt ^ ((rb2 >> 1) & 3)) << 5) + pcol * 8));
            bf16x8 vf; vf[0] = lo[0]; vf[1] = lo[1]; vf[2] = lo[2]; vf[3] = lo[3]; vf[4] = hi[0]; vf[5] = hi[1]; vf[6] = hi[2]; vf[7] = hi[3];
            oc[0][dt] = MFMA16(vf, pf[0], oc[0][dt]);
            oc[1][dt] = MFMA16(vf, pf[1], oc[1][dt]);
        }
    }
    float* lse = (float*)(p.ws + OFF_LSE);
#pragma unroll
    for (int qt = 0; qt < 2; ++qt) {
        const float inv = fast_rcp(sm[qt]);
#pragma unroll
        for (int dt = 0; dt < 4; ++dt) { if (!DRY) *(uint2*)(projb + qtok[qt] * 2304 + head * 64 + dt * 16 + G * 4) = pk4(oc[qt][dt] * inv); else asm volatile("" :: "v"(oc[qt][dt][0] + oc[qt][dt][1] + oc[qt][dt][2] + oc[qt][dt][3])); }
        if (G == 0 && !DRY) lse[((size_t)g * NTOK + qtok[qt]) * 4 + hq] = mx[qt] + __logf(sm[qt]);
    }
    __syncthreads();
}

template <bool DRY>
__device__ void phase_post_yc(const Params& p, int l) {
    const int tid_ = tid_opaque();
    const int lane = tid_ & 63, j = lane & 15;
    const int gw = blockIdx.x * 4 + (tid_ >> 6), nw = gridDim.x * 4;
    const u16* yraw = (const u16*)(p.ws + OFF_YRAW); u16* gy = (u16*)(p.ws + OFF_G);
    const u16* vv = (const u16*)(p.ws + OFF_V + (size_t)l * NTOK * 1024);
    const float* bonus = (const float*)(p.ws + OFF_BONUS);
    const float* lnw = (const float*)p.in[21] + (size_t)l * 512; const float* lnb = (const float*)p.in[22] + (size_t)l * 512;
    for (int it0 = gw; it0 < NTOK * 8 / 4; it0 += 4 * nw) {
        uint2 yq[4], vq[4], gq[4]; float bq[4]; size_t offq[4]; int hq[4];
#pragma unroll
        for (int k = 0; k < 4; ++k) {
            const int it = min(it0 + k * nw, NTOK * 8 / 4 - 1);
            const int pr = it * 4 + (lane >> 4);
            const int tok = pr >> 3, hh = pr & 7;
            offq[k] = (size_t)tok * 512 + hh * 64 + j * 4; hq[k] = hh;
            yq[k] = *(const uint2*)(yraw + offq[k]); vq[k] = *(const uint2*)(vv + offq[k]); gq[k] = *(const uint2*)(gy + offq[k]); bq[k] = bonus[pr];
        }
#pragma unroll
        for (int k = 0; k < 4; ++k) {
            const f32x4 y = unpk4(yq[k]);
            const float mu = rowsum16(y[0] + y[1] + y[2] + y[3]) * (1.f / 64.f);
            const f32x4 d = y - mu;
            const float var = rowsum16(d[0] * d[0] + d[1] * d[1] + d[2] * d[2] + d[3] * d[3]) * (1.f / 64.f);
            const float rstd = rsqrtf(var + 64e-5f);
            const f32x4 w4 = *(const f32x4*)(lnw + hq[k] * 64 + j * 4), b4 = *(const f32x4*)(lnb + hq[k] * 64 + j * 4);
            const f32x4 v4 = unpk4(vq[k]), g4 = unpk4(gq[k]);
            f32x4 o;
#pragma unroll
            for (int q = 0; q < 4; ++q) o[q] = (d[q] * rstd * w4[q] + b4[q] + bq[k] * v4[q]) * g4[q];
            if (it0 + k * nw < NTOK * 8 / 4) { if (!DRY) *(uint2*)(gy + offq[k]) = pk4(o); else asm volatile("" :: "v"(o[0] + o[1] + o[2] + o[3])); }
        }
    }
}
template <bool DRY>
__device__ void phase_post(const Params& p, int l) {
    const int tid_ = tid_opaque();
    const int lane = tid_ & 63, j = lane & 15;
    const int gw = blockIdx.x * 4 + (tid_ >> 6), nw = gridDim.x * 4;
    u16* projb = (u16*)(p.ws + OFF_R + R_PROJB); const float* lse = (const float*)(p.ws + OFF_LSE);
#pragma unroll 1
    for (int it0 = gw; it0 < NTOK * 4 / 4; it0 += 4 * nw) {
        float lq[4][3]; uint2 oq[4][3]; size_t tq[4];
#pragma unroll
        for (int k = 0; k < 4; ++k) {
            const int it = min(it0 + k * nw, NTOK * 4 / 4 - 1);
            const int pr = it * 4 + (lane >> 4);
            const int tok = pr >> 2, hq = pr & 3;
            tq[k] = (size_t)tok * 2304 + hq * 64 + j * 4;
#pragma unroll
            for (int gq = 0; gq < 3; ++gq) { lq[k][gq] = lse[((size_t)gq * NTOK + tok) * 4 + hq]; oq[k][gq] = *(const uint2*)(projb + tq[k] + gq * 256); }
        }
#pragma unroll
        for (int k = 0; k < 4; ++k) {
            const float m = fmaxf(lq[k][0], fmaxf(lq[k][1], lq[k][2]));
            const float e0 = fast_exp(lq[k][0] - m), e1 = fast_exp(lq[k][1] - m), e2 = fast_exp(lq[k][2] - m); const float inv = fast_rcp(e0 + e1 + e2);
            const f32x4 o = (unpk4(oq[k][0]) * e0 + unpk4(oq[k][1]) * e1 + unpk4(oq[k][2]) * e2) * inv;
            if (it0 + k * nw < NTOK * 4 / 4) { if (!DRY) *(uint2*)(projb + tq[k] + 768) = pk4(o); else asm volatile("" :: "v"(o[0] + o[1] + o[2] + o[3])); }
        }
    }
    const uint4* hsrc = (const uint4*)(p.ws + OFF_H); uint2* h8 = (uint2*)(p.ws + OFF_YRAW);
    const int nth = gridDim.x * 256;
    for (int i0 = blockIdx.x * 256 + tid_; i0 < NTOK * 1024 / 8; i0 += 4 * nth) {
        uint4 hv[4];
#pragma unroll
        for (int k = 0; k < 4; ++k) hv[k] = hsrc[min(i0 + k * nth, NTOK * 1024 / 8 - 1)];
#pragma unroll
        for (int k = 0; k < 4; ++k) {
            const uint2 o8 = make_uint2(pk_fp8x4(bflo(hv[k].x), bfhi(hv[k].x), bflo(hv[k].y), bfhi(hv[k].y)), pk_fp8x4(bflo(hv[k].z), bfhi(hv[k].z), bflo(hv[k].w), bfhi(hv[k].w)));
            if (i0 + k * nth < NTOK * 1024 / 8) { if (!DRY) h8[i0 + k * nth] = o8; else asm volatile("" :: "v"(o8.x + o8.y)); }
        }
    }
}

__device__ void merge_unit(const Params& p, int l, int u, char* lds) {
    const int mt = u >> 3, nt = u & 7;
    const int tid = tid_opaque();
    const int lane = tid & 63, w = tid >> 6, wm = w >> 1, wn = w & 1, fr = lane & 15, fg = lane >> 4;
    const char* wne = p.ws + OFF_WNE + (size_t)l * WNE_SZ;
    const float* bgate = (const float*)p.in[31] + (size_t)l * 3072;
    u16* merged = (u16*)(p.ws + OFF_MERGED);
    uint2 tot[4][4];
#pragma unroll
    for (int i = 0; i < 4; ++i)
#pragma unroll
        for (int j = 0; j < 4; ++j) tot[i][j] = make_uint2(0u, 0u);
#pragma unroll 1
    for (int br = 0; br < 3; ++br) {
        const u16* ya; int lda, K; const u16* wb;
        if (br == 0) { ya = (const u16*)(p.ws + OFF_R + R_PROJA); lda = 1024; K = 512; wb = (const u16*)(wne + WNE_WBRA); }
        else if (br == 1) { ya = (const u16*)(p.ws + OFF_R + R_PROJB) + 768; lda = 2304; K = 256; wb = (const u16*)(wne + WNE_WBRB); }
        else { ya = (const u16*)(p.ws + OFF_G); lda = 512; K = 512; wb = (const u16*)(wne + WNE_WBRC); }
        f32x4 accg[4][4]; acc_zero<4, 4>(accg); uint2 yb[4][4];
#pragma unroll
        for (int i = 0; i < 4; ++i)
#pragma unroll
            for (int j = 0; j < 4; ++j) yb[i][j] = make_uint2(0u, 0u);
        gemm_kloop2(accg, yb, ya + (size_t)mt * 128 * lda, lda, wb + (size_t)nt * 128 * K, K, K / 64,
                    (const u16*)(p.ws + OFF_YRAW) + (size_t)mt * 128 * 512, 512, (const u16*)(wne + WNE_WGATE) + (size_t)(br * 1024 + nt * 128) * 512, 512, 8, lds, tid);
#pragma unroll
        for (int i = 0; i < 4; ++i)
#pragma unroll
            for (int j = 0; j < 4; ++j) {
                const int m = mt * 128 + wm * 64 + i * 16 + fr, n = nt * 128 + wn * 64 + j * 16 + fg * 4;
                const f32x4 bg = *(const f32x4*)(bgate + br * 1024 + n);
                f32x4 tv = unpk4(tot[i][j]);
                const f32x4 yv = unpk4(yb[i][j]);
#pragma unroll
                for (int q = 0; q < 4; ++q) tv[q] += sigmoidf_(accg[i][j][q] * (1.f / GATE_WSCALE) + bg[q]) * yv[q];
                tot[i][j] = pk4(tv);
                if (br == 2) *(uint2*)(merged + (size_t)m * 1024 + n) = tot[i][j];
            }
    }
}

__device__ void outproj_unit(const Params& p, int l, int u, char* lds) {
    const int mt = u >> 3, nt = u & 7;
    const int tid = tid_opaque();
    const int lane = tid & 63, w = tid >> 6, wm = w >> 1, wn = w & 1, fr = lane & 15, fg = lane >> 4;
    RowLoader al((const u16*)(p.ws + OFF_MERGED) + (size_t)mt * 128 * 1024, 1024, tid);
    RowLoader bl((const u16*)(p.ws + OFF_WNE + (size_t)l * WNE_SZ + WNE_WOUT) + (size_t)nt * 128 * 1024, 1024, tid);
    f32x4 acc[4][4]; acc_zero<4, 4>(acc);
    const float* xin = (l == 0) ? (const float*)p.in[0] : p.out;
    f32x4 xo[4][4];
#pragma unroll
    for (int i = 0; i < 4; ++i)
#pragma unroll
        for (int j = 0; j < 4; ++j) xo[i][j] = *(const f32x4*)(xin + (size_t)(mt * 128 + wm * 64 + i * 16 + fr) * 1024 + nt * 128 + wn * 64 + j * 16 + fg * 4);
    gemm_kloop<4, 4>(acc, al, bl, 16, lds, tid);
#pragma unroll
    for (int i = 0; i < 4; ++i)
#pragma unroll
        for (int j = 0; j < 4; ++j) {
            const int m = mt * 128 + wm * 64 + i * 16 + fr, n = nt * 128 + wn * 64 + j * 16 + fg * 4;
            *(f32x4*)(p.out + (size_t)m * 1024 + n) = xo[i][j] + acc[i][j];
        }
}

template <bool DRY>
__device__ void router_unit(const Params& p, int l, int u, char* lds) {
    const int tid = tid_opaque();
    const int lane = tid & 63, w = tid >> 6, fr = lane & 15, fg = lane >> 4;
    const int tok0 = u * 32;
    const float* g = (const float*)p.in[33] + (size_t)l * 1024;
    const u16* wr = (const u16*)(p.ws + OFF_WNE + (size_t)l * WNE_SZ + WNE_WR);
    uint4 bq[2][8];
#pragma unroll
    for (int j = 0; j < 2; ++j)
#pragma unroll
        for (int ks = 0; ks < 8; ++ks) bq[j][ks] = *(const uint4*)(wr + (size_t)(j * 16 + fr) * 1024 + w * 256 + ks * 32 + fg * 8);
    float4 gg[4];
#pragma unroll
    for (int i = 0; i < 4; ++i) gg[i] = ((const float4*)g)[lane + 64 * i];
#pragma unroll
    for (int h = 0; h < 2; ++h) {
        float4 v[4][4]; float ss[4];
#pragma unroll
        for (int rr = 0; rr < 4; ++rr) {
            const float4* xr = (const float4*)(p.out + (size_t)(tok0 + w * 8 + h * 4 + rr) * 1024);
#pragma unroll
            for (int i = 0; i < 4; ++i) v[rr][i] = xr[lane + 64 * i];
        }
#pragma unroll
        for (int rr = 0; rr < 4; ++rr) {
            float s_ = 0.f;
#pragma unroll
            for (int i = 0; i < 4; ++i) s_ += v[rr][i].x * v[rr][i].x + v[rr][i].y * v[rr][i].y + v[rr][i].z * v[rr][i].z + v[rr][i].w * v[rr][i].w;
            ss[rr] = wavesum(s_);
        }
#pragma unroll
        for (int rr = 0; rr < 4; ++rr) {
            const int rl = w * 8 + h * 4 + rr, row = tok0 + rl;
            const float rinv = rsqrtf(ss[rr] * (1.f / 1024.f) + 1e-6f);
#pragma unroll
            for (int i = 0; i < 4; ++i) {
                const uint2 pk = make_uint2(pk_bf16(v[rr][i].x * rinv * gg[i].x, v[rr][i].y * rinv * gg[i].y), pk_bf16(v[rr][i].z * rinv * gg[i].z, v[rr][i].w * rinv * gg[i].w));
                ((unsigned*)(p.ws + OFF_H + (size_t)row * 1024))[lane + 64 * i] = pk_fp8x4(v[rr][i].x * rinv * gg[i].x, v[rr][i].y * rinv * gg[i].y, v[rr][i].z * rinv * gg[i].z, v[rr][i].w * rinv * gg[i].w);
                const int c = (lane + 64 * i) >> 1;
                *(uint2*)(lds + rl * 2048 + ((c ^ (rl & 15)) << 4) + (lane & 1) * 8) = pk;
            }
        }
    }
    __syncthreads();
    f32x4 acc[2][2]; acc_zero<2, 2>(acc);
#pragma unroll
    for (int ks = 0; ks < 8; ++ks) {
        bf16x8 af[2];
#pragma unroll
        for (int i = 0; i < 2; ++i) af[i] = *(const bf16x8*)(lds + (i * 16 + fr) * 2048 + (((w * 32 + ks * 4 + fg) ^ fr) << 4));
#pragma unroll
        for (int i = 0; i < 2; ++i)
#pragma unroll
            for (int j = 0; j < 2; ++j) acc[i][j] = MFMA16(mk8(bq[j][ks]), af[i], acc[i][j]);
    }
    __syncthreads();
    float* part = (float*)lds;
#pragma unroll
    for (int i = 0; i < 2; ++i)
#pragma unroll
        for (int j = 0; j < 2; ++j) *(f32x4*)(part + w * 1024 + (i * 16 + fr) * 32 + j * 16 + fg * 4) = acc[i][j];
    float* lg = (float*)(lds + 16384);
    int* hist = (int*)(lds + 32768); int* base = hist + 32;
    if (tid < 32) hist[tid] = 0;
    __syncthreads();
    { const f32x4 s_ = (*(const f32x4*)(part + tid * 4) + *(const f32x4*)(part + 1024 + tid * 4)) + (*(const f32x4*)(part + 2048 + tid * 4) + *(const f32x4*)(part + 3072 + tid * 4));
      *(f32x4*)(lg + tid * 4) = s_; }
    __syncthreads();
    float c_lo = 0.f, c_hi = 0.f; int c = 0, rank = 0;
    if (tid < 32) {
        const float* rgb = (const float*)p.in[35] + (size_t)l * 4; const float* reb = (const float*)p.in[37] + (size_t)l * 16;
        float gl[4]; int gi = 0;
#pragma unroll
        for (int q = 0; q < 4; ++q) { gl[q] = lg[tid * 32 + q] + rgb[q]; if (gl[q] > gl[gi]) gi = q; }
        float den = 0.f;
#pragma unroll
        for (int q = 0; q < 4; ++q) den += __expf(gl[q] - gl[gi]);
        const float gp = 1.f / den;
        float el[4];
#pragma unroll
        for (int q = 0; q < 4; ++q) {
            float v = 0.f;
#pragma unroll
            for (int gg_ = 0; gg_ < 4; ++gg_) v = (gg_ == gi) ? (lg[tid * 32 + 4 + gg_ * 4 + q] + reb[gg_ * 4 + q]) : v;
            el[q] = v;
        }
        int i1 = 0;
#pragma unroll
        for (int q = 1; q < 4; ++q) if (el[q] > el[i1]) i1 = q;
        int i2 = (i1 == 0) ? 1 : 0;
#pragma unroll
        for (int q = 0; q < 4; ++q) if (q != i1 && el[q] > el[i2]) i2 = q;
        const float w1 = 1.f / (1.f + __expf(el[i2] - el[i1])), w2 = 1.f - w1;
        const int lo = i1 < i2 ? i1 : i2, hi = i1 < i2 ? i2 : i1;
        c_lo = gp * (i1 < i2 ? w1 : w2); c_hi = gp * (i1 < i2 ? w2 : w1);
        const int pidx = (lo == 0) ? (hi - 1) : (lo == 1 ? hi + 1 : 5);
        c = gi * 6 + pidx;
        rank = atomicAdd(&hist[c], 1);
    }
    __syncthreads();
    unsigned* cnt = (unsigned*)(p.ws + OFF_CTRL) + CT_CNT + l * 32;
    if (tid < 24) base[tid] = (hist[tid] > 0 && !DRY) ? (int)atomicAdd(&cnt[tid], (unsigned)hist[tid]) : 0;
    __syncthreads();
    if (tid < 32 && !DRY) {
        const int slot = base[c] + rank;
        ((int*)(p.ws + OFF_PERM))[(size_t)c * 16384 + slot] = tok0 + tid;
        ((float2*)(p.ws + OFF_CW))[(size_t)c * 16384 + slot] = make_float2(c_lo, c_hi);
    }
    __syncthreads();
}

struct ClsInfo { int cls, rt, cnt, segrow, elo, ehi; };
__device__ __forceinline__ int moe_setup(const Params& p, int l, int* tab) {
    if (threadIdx.x == 0) {
        const unsigned* cnt = (const unsigned*)(p.ws + OFF_CTRL) + CT_CNT + l * 32;
        int tot = 0;
        for (int c = 0; c < 24; ++c) { const int n = (int)__hip_atomic_load(&cnt[c], __ATOMIC_RELAXED, __HIP_MEMORY_SCOPE_AGENT); tab[24 + c] = n; tab[c] = (n + 127) >> 7; tot += tab[c]; }
        tab[48] = tot;
    }
    __syncthreads();
    return tab[48];
}
__device__ __forceinline__ ClsInfo moe_find(const int* tab, int gt) {
    ClsInfo ci; int c = 0, seg = 0;
    while (c < 23 && gt >= tab[c]) { gt -= tab[c]; seg += tab[c]; ++c; }
    ci.cls = c; ci.rt = gt; ci.cnt = tab[24 + c]; ci.segrow = seg * 128;
    const int gi = c / 6, pi = c % 6;
    const int lo = pi < 3 ? 0 : (pi < 5 ? 1 : 2), hi = pi < 3 ? pi + 1 : (pi < 5 ? pi - 1 : 3);
    ci.elo = gi * 4 + lo; ci.ehi = gi * 4 + hi;
    return ci;
}
struct GatherLoader {
    const u16* base; int tok0, tok1, tok2, tok3;
    __device__ __forceinline__ unsigned off(int q, int row, int c) const {
        const int tk = (q == 0) ? tok0 : (q == 1 ? tok1 : (q == 2 ? tok2 : tok3));
        return (unsigned)(tk * 1024 + c * 8) * 2u;
    }
    __device__ __forceinline__ const char* ub(int kt) const { return (const char*)base + kt * 128; }
};
struct GateUpLoader {
    const u16* gsrc; const u16* usrc;
    __device__ __forceinline__ unsigned off(int q, int row, int c) const {
        const unsigned r_ = (row < 64) ? (unsigned)(row * 1024) * 2u : (unsigned)((const char*)usrc - (const char*)gsrc) + (unsigned)((row - 64) * 1024) * 2u;
        return r_ + (unsigned)c * 16u;
    }
    __device__ __forceinline__ const char* ub(int kt) const { return (const char*)gsrc + kt * 128; }
};
struct Gather8Loader {
    const char* base; int tok0, tok1, tok2, tok3;
    __device__ __forceinline__ unsigned off(int q, int row, int c) const {
        const int tk = (q == 0) ? tok0 : (q == 1 ? tok1 : (q == 2 ? tok2 : tok3));
        return (unsigned)(tk * 1024 + c * 16);
    }
    __device__ __forceinline__ const char* ub(int kt) const { return base + kt * 128; }
};
struct GateUp8Loader {
    const char* gsrc; const char* usrc;
    __device__ __forceinline__ unsigned off(int q, int row, int c) const {
        const unsigned r_ = (row < 64) ? (unsigned)(row * 1024) : (unsigned)(usrc - gsrc) + (unsigned)((row - 64) * 1024);
        return r_ + (unsigned)c * 16u;
    }
    __device__ __forceinline__ const char* ub(int kt) const { return gsrc + kt * 128; }
};
struct Down8Loader {
    const char* lo; const char* hi;
    __device__ __forceinline__ unsigned off(int q, int row, int c) const { return (unsigned)(row * 512 + c * 16); }
    __device__ __forceinline__ const char* ub(int kt) const { return ((kt < 4) ? lo : hi) + (kt & 3) * 128; }
};
struct DownLoader {
    const u16* lo; const u16* hi;
    __device__ __forceinline__ unsigned off(int q, int row, int c) const { return (unsigned)(row * 512 + c * 8) * 2u; }
    __device__ __forceinline__ const char* ub(int kt) const { return (const char*)((kt < 8) ? lo : hi) + (kt & 7) * 128; }
};
__device__ void moe_up_phase(const Params& p, int l, char* lds) {
    int* tab = (int*)(lds + LDS_BYTES - 512);
    const int ntiles = moe_setup(p, l, tab);
    const int tid = tid_opaque();
    const int lane = tid & 63, w = tid >> 6, fr = lane & 15, fg = lane >> 4;
    const char* wgate8 = wexp_base(p, l, 0); const char* wup8 = wexp_base(p, l, 1);
    const int* perm = (const int*)(p.ws + OFF_PERM); const float2* cw = (const float2*)(p.ws + OFF_CW);
    u16* hid = (u16*)(p.ws + OFF_R + R_HID);
    for (int u = blockIdx.x; u < ntiles * 16; u += gridDim.x) {
        const int gt = u >> 4, nt = u & 15;
        const ClsInfo ci = moe_find(tab, gt);
        const int hc0 = nt * 64; const int e = hc0 < 512 ? ci.elo : ci.ehi; const int sel = hc0 < 512 ? 0 : 1;
        Gather8Loader al; al.base = (const char*)(p.ws + OFF_H);
        { const int sb = ci.rt * 128 + w * 32 + ((tid & 63) >> 3), cm = ci.cnt - 1; const int* pp = perm + (size_t)ci.cls * 16384;
          al.tok0 = pp[min(sb, cm)]; al.tok1 = pp[min(sb + 8, cm)]; al.tok2 = pp[min(sb + 16, cm)]; al.tok3 = pp[min(sb + 24, cm)]; }
        GateUp8Loader bl{wgate8 + ((size_t)e * 512 + (hc0 & 511)) * 1024, wup8 + ((size_t)e * 512 + (hc0 & 511)) * 1024};
        f32x4 acc[2][8]; acc_zero<2, 8>(acc);
        float cwq[2];
#pragma unroll
        for (int i = 0; i < 2; ++i) { const int slot = min(ci.rt * 128 + w * 32 + i * 16 + fr, ci.cnt - 1); const float2 cc = cw[(size_t)ci.cls * 16384 + slot]; cwq[i] = sel ? cc.y : cc.x; }
        int nk8 = 8; asm volatile("" : "+s"(nk8));
        gemm_kloop<2, 8, true>(acc, al, bl, nk8, lds, tid);
#pragma unroll
        for (int i = 0; i < 2; ++i) {
            const int slot = ci.rt * 128 + w * 32 + i * 16 + fr;
            if (slot < ci.cnt) {
                const float cwv = cwq[i];
#pragma unroll
                for (int j = 0; j < 4; ++j) {
                    f32x4 hv;
#pragma unroll
                    for (int q = 0; q < 4; ++q) { const float gq = acc[i][j][q] * (1.f / GATE_WSCALE); hv[q] = gq * sigmoidf_(gq) * (acc[i][j + 4][q] * (1.f / GATE_WSCALE)) * cwv; }
                    *(unsigned*)((char*)hid + (size_t)(ci.segrow + slot) * 1024 + hc0 + j * 16 + fg * 4) = pk_fp8x4(hv[0] * HID_SCALE, hv[1] * HID_SCALE, hv[2] * HID_SCALE, hv[3] * HID_SCALE);
                }
            }
        }
    }
}
template <bool DRY>
__device__ void moe_down_phase(const Params& p, int l, char* lds) {
    int* tab = (int*)(lds + LDS_BYTES - 512);
    const int ntiles = moe_setup(p, l, tab);
    const int tid = tid_opaque();
    const int lane = tid & 63, w = tid >> 6, wm = w >> 1, wn = w & 1, fr = lane & 15, fg = lane >> 4;
    const char* wdown = wexp_base(p, l, 2);
    const int* perm = (const int*)(p.ws + OFF_PERM);
    const u16* hid = (const u16*)(p.ws + OFF_R + R_HID);
    for (int u = blockIdx.x; u < ntiles * 8; u += gridDim.x) {
        const int gt = u >> 3, nt = u & 7;
        const ClsInfo ci = moe_find(tab, gt);
        RowLoader al(hid + (size_t)(ci.segrow + ci.rt * 128) * 512, 512, tid);
        Down8Loader bl{wdown + ((size_t)ci.elo * 1024 + nt * 128) * 512, wdown + ((size_t)ci.ehi * 1024 + nt * 128) * 512};
        f32x4 acc[4][4]; acc_zero<4, 4>(acc);
        int tkq[4];
#pragma unroll
        for (int i = 0; i < 4; ++i) tkq[i] = perm[(size_t)ci.cls * 16384 + min(ci.rt * 128 + wm * 64 + i * 16 + fr, ci.cnt - 1)];
        int nk8 = 8; asm volatile("" : "+s"(nk8));
        gemm_kloop<4, 4, true>(acc, al, bl, nk8, lds, tid);
#pragma unroll
        for (int i = 0; i < 4; ++i) {
            const int slot = ci.rt * 128 + wm * 64 + i * 16 + fr;
            if (slot < ci.cnt) {
                const int tok = tkq[i];
#pragma unroll
                for (int j = 0; j < 4; ++j) {
                    float* px = p.out + (size_t)tok * 1024 + nt * 128 + wn * 64 + j * 16 + fg * 4;
                    const f32x4 dv = acc[i][j] * (1.f / (HID_SCALE * GATE_WSCALE));
                    if (!DRY) *(f32x4*)px = *(const f32x4*)px + dv; else { const f32x4 t_ = *(const f32x4*)px + dv; asm volatile("" :: "v"(t_[0] + t_[1] + t_[2] + t_[3])); }
                }
            }
        }
    }
}

template <int S>
__device__ __forceinline__ void run_stage(const Params& p, int l, char* lds) {
    const int G = gridDim.x, bid = blockIdx.x;
    if (S == 100) { phase_conv_ne(p, lds); }
    else if (S == 101) { phase_norm<true>(p, p.out, (const float*)p.in[41]); }
    else if (S == 0) { phase_norm<false>(p, l == 0 ? (const float*)p.in[0] : p.out, (const float*)p.in[2] + (size_t)l * 1024); }
    else if (S == 1) { const int NT_ = (l == 0) ? 16 : 17, U = 128 * NT_; for (int u = bid; u < U; u += G) gemm2a_unit(p, l, (u & 7) * (U / 8) + (u >> 3), NT_, lds); }
    else if (S == 2) { for (int u = bid; u < 1024; u += G) prep_unit(p, l, (u & 7) * 128 + (u >> 3), lds); }
    else if (S == 3) {
        if (bid < 64) { __builtin_amdgcn_s_setprio(3); scan_unit(p, l, bid, lds); __builtin_amdgcn_s_setprio(0); }
        unsigned* ctr = (unsigned*)(p.ws + OFF_CTRL) + CT_CNT + 64 + l;
        int* tsl = (int*)(lds + LDS_BYTES - 16);
        for (;;) {
            __syncthreads();
            if (threadIdx.x == 0) *tsl = (int)atomicAdd(ctr, 1u);
            __syncthreads();
            const int u = *tsl;
            if (u >= 128 * 26 + 768) break;
            if (u < 128 * 26) gemm2b_unit(p, l, u, lds);
            else conv_expert_run(p, l, 3072 + 4 * (u - 128 * 26), 4, 1, 6144, lds);
        }
    }
    else if (S == 33) { if (bid < 64) scan_unit(p, l, bid, lds); }
    else if (S == 34) { for (int u = bid; u < 128 * 26; u += G) gemm2b_unit(p, l, u, lds); }
    else if (S == 4) { for (int u = bid; u < 512 + 1536; u += G) { if (u < 512) mixa_unit<false>(p, l, (u & 7) * 64 + (u >> 3), lds); else attn_unit<false>(p, u - 512, lds); } phase_post_yc<false>(p, l); }
    else if (S == 44) { for (int u = bid; u < 512 + 1536; u += G) { if (u < 512) mixa_unit<true>(p, l, u, lds); else attn_unit<true>(p, u - 512, lds); } }
    else if (S == 45) { for (int u = bid; u < 512; u += G) mixa_unit<true>(p, l, u, lds); }
    else if (S == 110) { moe_down_phase<true>(p, l, lds); }
    else if (S == 5) { phase_post<false>(p, l); }
    else if (S == 55) { phase_post<true>(p, l); }
    else if (S == 6) {
        const int ncv = (3072 + G - 1) / G;
        int cv = 0, mu = bid;
        auto conv_some = [&](int n) { const int c = min(n, ncv - cv); if (c > 0) { conv_expert_run(p, l, bid + cv * G, c, G, 3072, lds); cv += c; } };
        if (bid & 1) conv_some(ncv / 2);
        for (; mu < 1024; mu += G) { merge_unit(p, l, (mu & 7) * 128 + (mu >> 3), lds); conv_some(ncv / 2); }
        conv_some(ncv);
    }
    else if (S == 66) { for (int mu = bid; mu < 1024; mu += G) merge_unit(p, l, (mu & 7) * 128 + (mu >> 3), lds); }
    else if (S == 67) { const int ncv = (6144 + G - 1) / G; conv_expert_run(p, l, bid, ncv, G, 6144, lds); }
    else if (S == 7) { for (int u = bid; u < 1024; u += G) outproj_unit(p, l, (u & 7) * 128 + (u >> 3), lds); }
    else if (S == 8) { for (int u = bid; u < 512; u += G) router_unit<false>(p, l, u, lds); }
    else if (S == 88) { for (int u = bid; u < 512; u += G) router_unit<true>(p, l, u, lds); }
    else if (S == 9) { moe_up_phase(p, l, lds); }
    else if (S == 10) { moe_down_phase<false>(p, l, lds); }
}

template <int S>
__global__ void __launch_bounds__(256, 2) stage_kernel(Params p, int l) {
    __shared__ __attribute__((aligned(16))) char lds[LDS_BYTES + 16];
    run_stage<S>(p, l, lds);
}

#if MK_FUSED
__global__ void __launch_bounds__(256, 2) mega_kernel(Params p) {
    __shared__ __attribute__((aligned(16))) char lds[LDS_BYTES + 16];
    volatile LAS unsigned* st = (volatile LAS unsigned*)(lds + LDS_BYTES);
    if (threadIdx.x == 0) { st[0] = 0u; st[1] = 0u; st[2] = 0u; st[3] = 0u; }
    __syncthreads();
    XcdBarrier xb = xcd_barrier_post((unsigned*)(p.ws + OFF_CTRL), st);
#if TIMING_PHASE >= 0
    unsigned long long t_start = __builtin_amdgcn_s_memrealtime(), t_sel = 0; int t_k = 0;
#define XBAR() do { xcd_barrier(xb); if (t_k == TIMING_PHASE) t_sel = __builtin_amdgcn_s_memrealtime() - t_start; ++t_k; } while (0)
#else
#define XBAR() xcd_barrier(xb)
#endif
    run_stage<100>(p, 0, lds); run_stage<0>(p, 0, lds); XBAR();
    if (DUP_STAGE == 999) { for (int i_ = 0; i_ < 20; ++i_) XBAR(); }
    if (DUP_STAGE == 100) { run_stage<100>(p, 0, lds); XBAR(); }
#define MK_ST(S, l) run_stage<S>(p, l, lds); XBAR(); if (DUP_STAGE == S && !(S == 7 && l == 1)) { run_stage<S>(p, l, lds); XBAR(); } if (S == 4 && DUP_STAGE == 44) { run_stage<44>(p, l, lds); XBAR(); } if (S == 4 && DUP_STAGE == 45) { run_stage<45>(p, l, lds); XBAR(); } if (S == 10 && DUP_STAGE == 110) { run_stage<110>(p, l, lds); XBAR(); } if (S == 5 && DUP_STAGE == 55) { run_stage<55>(p, l, lds); XBAR(); } if (S == 8 && DUP_STAGE == 88) { run_stage<88>(p, l, lds); XBAR(); } if (S == 3 && DUP_STAGE == 33) { run_stage<33>(p, l, lds); XBAR(); } if (S == 3 && DUP_STAGE == 34) { run_stage<34>(p, l, lds); XBAR(); } if (S == 6 && DUP_STAGE == 66) { run_stage<66>(p, l, lds); XBAR(); } if (S == 6 && DUP_STAGE == 67) { run_stage<67>(p, l, lds); XBAR(); }
#define MK_ST0(l) if (l != 0) { MK_ST(0, l) }
#define MK_LAYER(l) MK_ST0(l) MK_ST(1, l) MK_ST(2, l) MK_ST(3, l) MK_ST(4, l) MK_ST(5, l) MK_ST(6, l) MK_ST(7, l) MK_ST(8, l) MK_ST(9, l) MK_ST(10, l)
    MK_LAYER(0)
    MK_LAYER(1)
    run_stage<101>(p, 0, lds);
#if TIMING_PHASE >= 0
    if (blockIdx.x == 0 && threadIdx.x == 0) { asm volatile("s_waitcnt vmcnt(0)" ::: "memory"); p.out[0] = (float)t_sel * 0.01f; }
#endif
}
#endif

#ifndef DBG
#define DBG 0
#endif
__global__ void dump_kernel(const u16* src, size_t stride, int width, float* out) {
    const size_t i = (size_t)blockIdx.x * 256 + threadIdx.x;
    const size_t tok = i >> 10; const int c = (int)(i & 1023);
    out[i] = bf2f(src[tok * stride + (c % width)]);
}
#define DUMP(off, stride, width) dump_kernel<<<dim3(NTOK * 1024 / 256), dim3(256), 0, stream>>>((const u16*)((char*)d_ws + (off)), stride, width, (float*)d_out)
#define LAUNCH_STAGE(S, l) stage_kernel<S><<<dim3(grid_blocks), dim3(256), 0, stream>>>(p, l)
extern "C" void kernel_launch(void* const* d_in, const int* in_sizes, int n_in, void* d_out, int out_size, void* d_ws, size_t ws_size, hipStream_t stream) {
    static int grid_blocks = 0;
    if (!grid_blocks) {
        int dev = 0, cus = 0, per_cu = 2;
        (void)hipGetDevice(&dev);
        (void)hipDeviceGetAttribute(&cus, hipDeviceAttributeMultiprocessorCount, dev);
#if MK_FUSED
        (void)hipOccupancyMaxActiveBlocksPerMultiprocessor(&per_cu, mega_kernel, 256, 0);
        if (per_cu > 2) per_cu = 2;
        if (per_cu < 1) per_cu = 1;
#endif
        if (cus <= 0) cus = 256;
        grid_blocks = cus * per_cu;
    }
    if (ws_size < OFF_END || n_in < 42) { fprintf(stderr, "workspace too small or bad inputs\n"); return; }
    Params p{};
    for (int i = 0; i < 42; ++i) p.in[i] = d_in[i];
    p.out = (float*)d_out; p.ws = (char*)d_ws;
    (void)hipMemsetAsync(d_ws, 0, 65536, stream);
#if MK_FUSED
    void* args[] = {&p};
    hipError_t e = hipLaunchCooperativeKernel((void*)mega_kernel, dim3(grid_blocks), dim3(256), args, 0, stream);
    if (e != hipSuccess) fprintf(stderr, "cooperative launch failed: %s (grid %d)\n", hipGetErrorString(e), grid_blocks);
#else
    LAUNCH_STAGE(100, 0);
    for (int l = 0; l < 2; ++l) {
        LAUNCH_STAGE(0, l); LAUNCH_STAGE(1, l);
        if (DBG == 1) { DUMP(OFF_R + R_PROJC, 1536, 1024); return; }
        LAUNCH_STAGE(2, l);
        if (DBG == 2) { DUMP(OFF_KR, 1024, 1024); return; }
        LAUNCH_STAGE(3, l);
        if (DBG == 3) { DUMP(OFF_YRAW, 512, 512); return; }
        if (DBG == 4) { DUMP(OFF_R + R_PROJB, 2304, 1024); return; }
        LAUNCH_STAGE(4, l);
        if (DBG == 5) { DUMP(OFF_R + R_PROJB, 2304, 1024); return; }
        if (DBG == 6) { DUMP(OFF_R + R_PROJA, 1024, 512); return; }
        LAUNCH_STAGE(5, l);
        if (DBG == 10) { DUMP(OFF_G, 512, 512); return; }
        if (DBG == 11) { DUMP(OFF_R + R_PROJB + 768 * 2, 2304, 256); return; }
        LAUNCH_STAGE(6, l);
        if (DBG == 7) { DUMP(OFF_MERGED, 1024, 1024); return; }
        LAUNCH_STAGE(7, l);
        if (DBG == 8) return;
        LAUNCH_STAGE(8, l); LAUNCH_STAGE(9, l); LAUNCH_STAGE(10, l);
        if (DBG == 9) return;
    }
    LAUNCH_STAGE(101, 0);
#endif
}
```

```cpp
#include <hip/hip_runtime.h>
#include <hip/hip_cooperative_groups.h>
#include <stdint.h>
#include <cstdio>

#ifndef MK_FUSED
#define MK_FUSED 1
#endif
#ifndef TIMING_PHASE
#define TIMING_PHASE -1
#endif
#ifndef DUP_STAGE
#define DUP_STAGE -1
#endif

typedef short bf16x8 __attribute__((ext_vector_type(8)));
typedef short bf16x4 __attribute__((ext_vector_type(4)));
typedef float f32x4 __attribute__((ext_vector_type(4)));
typedef __bf16 bf2_t __attribute__((ext_vector_type(2)));
typedef short v4i16_t __attribute__((ext_vector_type(4)));
typedef _Float16 h2_t __attribute__((ext_vector_type(2)));
typedef unsigned short u16;
#define LAS __attribute__((address_space(3)))

constexpr int NTOK = 16384, DM = 1024, SEQ = 2048;
constexpr int NPH = 24;
constexpr int LDS_BYTES = 66 * 1024;

constexpr size_t OFF_CTRL = 0;
constexpr size_t OFF_ROT  = 65536;
constexpr size_t OFF_WNE  = OFF_ROT + 2 * (size_t)NTOK * 8 * 4;
constexpr size_t WNE_WTC = 0, WNE_WTAB = 4456448, WNE_WGATE = 11272192, WNE_WBRA = 17563648, WNE_WBRB = 18612224,
                 WNE_WBRC = 19136512, WNE_WOUT = 20185088, WNE_W2T = 22282240, WNE_A2T = 22347776, WNE_G2T = 22413312,
                 WNE_V2T = 22544384, WNE_WR = 22577152, WNE_SZ = 22839296;
constexpr size_t OFF_H    = OFF_WNE + 2 * WNE_SZ;
constexpr size_t OFF_V    = OFF_H + (size_t)NTOK * 1024 * 2;
constexpr size_t OFF_KR   = OFF_V + 2 * (size_t)NTOK * 512 * 2;
constexpr size_t OFF_BK   = OFF_KR + (size_t)NTOK * 2048;
constexpr size_t OFF_W    = OFF_BK + (size_t)NTOK * 2048;
constexpr size_t OFF_G    = OFF_W + (size_t)NTOK * 1024;
constexpr size_t OFF_YRAW = OFF_G + (size_t)NTOK * 1024;
constexpr size_t OFF_BONUS= OFF_YRAW + (size_t)NTOK * 1024;
constexpr size_t OFF_LSE  = OFF_BONUS + (size_t)NTOK * 32;
constexpr size_t OFF_R    = OFF_LSE + (size_t)3 * NTOK * 16;
constexpr size_t R_PROJA = 0;
constexpr size_t R_PROJB = (size_t)NTOK * 2048;
constexpr size_t R_PROJC = 0;
constexpr size_t R_LORA1 = (size_t)NTOK * 3072;
constexpr size_t R_WEXP  = 0;
constexpr size_t R_HID   = 50331648;
constexpr size_t R_SZ    = (size_t)NTOK * (2048 + 4608);
constexpr size_t OFF_UP8  = OFF_R + R_SZ;
constexpr size_t OFF_WSA  = OFF_UP8 + (size_t)16 * 512 * 1024;
constexpr size_t OFF_END  = OFF_WSA + (size_t)2 * 4 * 128 * 128 * 2;
constexpr size_t OFF_KK = OFF_KR;
constexpr size_t OFF_RR = OFF_KR + (size_t)NTOK * 1024;
constexpr size_t OFF_PC = OFF_W;
constexpr size_t OFF_COEF = OFF_W + (size_t)4 * 1024 * 1024;
constexpr size_t OFF_MERGED = OFF_KR;
constexpr size_t OFF_DOWN8 = OFF_W + (size_t)8 * 1024 * 1024;
constexpr size_t OFF_WEXP = OFF_BK;
constexpr size_t OFF_PERM = OFF_YRAW;
constexpr size_t OFF_CW   = OFF_YRAW + (size_t)24 * 16384 * 4;
static_assert((size_t)NTOK * 2048 + (size_t)NTOK * 1024 >= 50331648, "WEXP overlay");
static_assert((size_t)24 * 16384 * 12 <= (size_t)NTOK * 1024, "perm/cw overlay");
static_assert(OFF_END <= 356000000, "workspace too large");
static_assert(R_HID + (size_t)19456 * 2048 <= R_SZ, "R region");
constexpr int CT_CNT = 8192;

struct Params {
    const void* in[42];
    float* out;
    char* ws;
    int pad0, pad1;
};

typedef float f2_t __attribute__((ext_vector_type(2)));
__device__ __forceinline__ unsigned pk_bf16(float lo, float hi) { f2_t f; f[0] = lo; f[1] = hi; return __builtin_bit_cast(unsigned, __builtin_convertvector(f, bf2_t)); }
__device__ __forceinline__ float bflo(unsigned u) { return __uint_as_float(u << 16); }
__device__ __forceinline__ float bfhi(unsigned u) { return __uint_as_float(u & 0xffff0000u); }
__device__ __forceinline__ float bf2f(u16 h) { return __uint_as_float(((unsigned)h) << 16); }
__device__ __forceinline__ u16 f2bf(float f) { return (u16)(pk_bf16(f, 0.f) & 0xffffu); }
__device__ __forceinline__ uint2 pk4(f32x4 v) { return make_uint2(pk_bf16(v[0], v[1]), pk_bf16(v[2], v[3])); }
__device__ __forceinline__ f32x4 unpk4(uint2 u) { f32x4 r; r[0] = bflo(u.x); r[1] = bfhi(u.x); r[2] = bflo(u.y); r[3] = bfhi(u.y); return r; }
__device__ __forceinline__ float fast_rcp(float x) { return __builtin_amdgcn_rcpf(x); }
__device__ __forceinline__ float fast_exp(float x) { return __builtin_amdgcn_exp2f(x * 1.4426950408889634f); }
__device__ __forceinline__ float sigmoidf_(float x) { return fast_rcp(1.f + fast_exp(-x)); }
__device__ __forceinline__ float gelu_tanh(float x) { const float z = 0.7978845608028654f * (x + 0.044715f * x * x * x); return x * fast_rcp(1.f + fast_exp(-2.f * z)); }
__device__ __forceinline__ float dot2bf(unsigned a, unsigned b, float c) { return __builtin_amdgcn_fdot2_f32_bf16(__builtin_bit_cast(bf2_t, a), __builtin_bit_cast(bf2_t, b), c, false); }
template <int CTRL> __device__ __forceinline__ float dpp_f(float x) { return __builtin_bit_cast(float, __builtin_amdgcn_update_dpp(0, __builtin_bit_cast(int, x), CTRL, 0xf, 0xf, false)); }
__device__ __forceinline__ float rowsum16(float x) { x += dpp_f<0x128>(x); x += dpp_f<0x124>(x); x += dpp_f<0x122>(x); x += dpp_f<0x121>(x); return x; }
__device__ __forceinline__ float wavesum(float x) { x += __shfl_xor(x, 32); x += __shfl_xor(x, 16); x += __shfl_xor(x, 8); x += __shfl_xor(x, 4); x += __shfl_xor(x, 2); x += __shfl_xor(x, 1); return x; }
__device__ __forceinline__ bf16x8 mk8(uint4 u) { return __builtin_bit_cast(bf16x8, u); }
__device__ __forceinline__ int tid_opaque() { int t = threadIdx.x; asm volatile("" : "+v"(t)); return t; }
#define MFMA16(a, b, c) __builtin_amdgcn_mfma_f32_16x16x32_bf16(a, b, c, 0, 0, 0)
typedef int i32x8 __attribute__((ext_vector_type(8)));
#define MFMA8X(a, b, c) __builtin_amdgcn_mfma_scale_f32_16x16x128_f8f6f4(a, b, c, 0, 0, 0, 0x7f7f7f7f, 0, 0x7f7f7f7f)
__device__ __forceinline__ unsigned pk_fp8x4(float a, float b, float c, float d) {
    int r = __builtin_amdgcn_cvt_pk_fp8_f32(a, b, 0, false);
    r = __builtin_amdgcn_cvt_pk_fp8_f32(c, d, r, true);
    return (unsigned)r;
}
constexpr float HID_SCALE = 8.f;
constexpr float GATE_WSCALE = 32.f;

#define XB_TMO      128
#define XB_XCNT(j)  (256  + 64 * (j))
#define XB_XSUB(j)  (1280 + 64 * (j))
#define XB_XGEN(j)  (2304 + 64 * (j))
#define XB_TOP      3328
#define XB_TOPGEN   3392
#define XCD_BAR_WORDS 3456
#define XB_SPIN_CAP (1u << 22)
__device__ __forceinline__ unsigned xb_ld(unsigned* p)              { return __hip_atomic_load(p, __ATOMIC_RELAXED, __HIP_MEMORY_SCOPE_AGENT); }
__device__ __forceinline__ unsigned xb_add(unsigned* p, unsigned v) { return __hip_atomic_fetch_add(p, v, __ATOMIC_RELAXED, __HIP_MEMORY_SCOPE_AGENT); }
__device__ __forceinline__ unsigned xb_xcc_id() { return (unsigned)__builtin_amdgcn_s_getreg((3 << 11) | 20) & 0xFu; }
#define XB_SPIN(cond, bar) do { unsigned _sp = 0; while (cond) { __builtin_amdgcn_s_sleep(1); \
    if ((++_sp & 255u) == 0u) { if (xb_ld(&(bar)[XB_TMO])) break; if (_sp > XB_SPIN_CAP) { atomicAdd(&(bar)[XB_TMO], 1u); break; } } } } while (0)
struct XcdBarrier { unsigned* bar; unsigned x; volatile LAS unsigned* st; };
__device__ __forceinline__ XcdBarrier xcd_barrier_post(unsigned* bar, volatile LAS unsigned* st) {
    XcdBarrier b; b.bar = bar; b.x = xb_xcc_id(); b.st = st;
    if (threadIdx.x == 0) (void)xb_add(&bar[XB_XCNT(b.x)], 1u);
    return b;
}
__device__ __forceinline__ void xcd_barrier_complete(unsigned* bar, unsigned x, unsigned& nloc, unsigned& nx) {
    const unsigned G = gridDim.x * gridDim.y * gridDim.z;
    unsigned sum, cnt, mine, sp = 0u;
    for (;;) {
        sum = 0u; cnt = 0u; mine = 0u;
#pragma unroll
        for (unsigned j = 0; j < 16; ++j) { const unsigned c = xb_ld(&bar[XB_XCNT(j)]); sum += c; cnt += (c > 0u) ? 1u : 0u; mine = (j == x) ? c : mine; }
        if (sum == G) break;
        __builtin_amdgcn_s_sleep(1);
        if ((++sp & 255u) == 0u) { if (xb_ld(&bar[XB_TMO])) break; if (sp > XB_SPIN_CAP) { atomicAdd(&bar[XB_TMO], 1u); break; } }
    }
    nloc = mine > 0u ? mine : 1u; nx = cnt > 0u ? cnt : 1u;
}
__device__ __forceinline__ void xcd_barrier(const XcdBarrier& b) {
    asm volatile("s_waitcnt vmcnt(0)" ::: "memory");
    __syncthreads();
    if (threadIdx.x == 0) {
        unsigned* bar = b.bar;
        __builtin_amdgcn_s_waitcnt(0);
        unsigned nloc = b.st[0], nx = b.st[1];
        if (nloc == 0u) { xcd_barrier_complete(bar, b.x, nloc, nx); b.st[0] = nloc; b.st[1] = nx; }
        const unsigned old = xb_add(&bar[XB_XSUB(b.x)], 1u);
        const unsigned gen = old / nloc;
        if (old + 1u == (gen + 1u) * nloc) {
            __builtin_amdgcn_fence(__ATOMIC_RELEASE, "agent");
            asm volatile("s_waitcnt vmcnt(0)" ::: "memory");
            const unsigned og = xb_add(&bar[XB_TOP], 1u);
            const unsigned tg = og / nx;
            if (og + 1u == (tg + 1u) * nx) xb_add(&bar[XB_TOPGEN], 1u);
            else XB_SPIN(xb_ld(&bar[XB_TOPGEN]) == tg, bar);
            __builtin_amdgcn_fence(__ATOMIC_ACQUIRE, "agent");
            xb_add(&bar[XB_XGEN(b.x)], 1u);
            asm volatile("s_waitcnt vmcnt(0)" ::: "memory");
        } else {
            XB_SPIN(xb_ld(&bar[XB_XGEN(b.x)]) == gen, bar);
            __builtin_amdgcn_fence(__ATOMIC_ACQUIRE, "agent");
            asm volatile("s_waitcnt vmcnt(0)" ::: "memory");
        }
    }
    __syncthreads();
}

__device__ __forceinline__ int toff(int row, int chunk) { return row * 128 + ((chunk ^ ((row >> 1) & 7)) << 4); }

template <int MT, int NT, bool F8 = false, class AL, class BL>
__device__ __forceinline__ void gemm_kloop(f32x4 (&acc)[MT][NT], const AL& al, const BL& bl, int nk, char* lds, int tid) {
    const int lane = tid & 63, w = tid >> 6;
    const int wm = (MT == 4) ? (w >> 1) : w, wn = (MT == 4) ? (w & 1) : 0;
    const int fr = lane & 15, fg = lane >> 4;
    const int lrow = lane >> 3, pc = lane & 7;
    unsigned va[4], vb[4];
#pragma unroll
    for (int q = 0; q < 4; ++q) { const int row = w * 32 + q * 8 + lrow; const int c = pc ^ ((row >> 1) & 7); va[q] = al.off(q, row, c); vb[q] = bl.off(q, row, c); }
    char* ldw = lds + __builtin_amdgcn_readfirstlane(w) * 4096;
#define GK_STAGE(kt_, buf_) do { const char* ua_ = al.ub(kt_); const char* ub_ = bl.ub(kt_); char* dA_ = ldw + (buf_) * 32768; \
        _Pragma("unroll") for (int q_ = 0; q_ < 4; ++q_) { \
            __builtin_amdgcn_global_load_lds((const unsigned*)(ua_ + va[q_]), (unsigned*)(dA_ + q_ * 1024), 16, 0, 0); \
            __builtin_amdgcn_global_load_lds((const unsigned*)(ub_ + vb[q_]), (unsigned*)(dA_ + 16384 + q_ * 1024), 16, 0, 0); } } while (0)
    GK_STAGE(0, 0);
    asm volatile("s_waitcnt vmcnt(0)" ::: "memory");
    __syncthreads();
    for (int kt = 0; kt < nk; ++kt) {
        const char* cA = lds + (kt & 1) * 32768; const char* cB = cA + 16384;
        if (kt + 1 < nk) GK_STAGE(kt + 1, (kt + 1) & 1);
        if (F8) {
            i32x8 af[MT], bfr[NT];
#pragma unroll
            for (int i = 0; i < MT; ++i) { const uint4 lo = *(const uint4*)(cA + toff(wm * MT * 16 + i * 16 + fr, fg)), hi = *(const uint4*)(cA + toff(wm * MT * 16 + i * 16 + fr, 4 + fg));
                                           af[i] = (i32x8){(int)lo.x, (int)lo.y, (int)lo.z, (int)lo.w, (int)hi.x, (int)hi.y, (int)hi.z, (int)hi.w}; }
#pragma unroll
            for (int j = 0; j < NT; ++j) { const uint4 lo = *(const uint4*)(cB + toff(wn * NT * 16 + j * 16 + fr, fg)), hi = *(const uint4*)(cB + toff(wn * NT * 16 + j * 16 + fr, 4 + fg));
                                           bfr[j] = (i32x8){(int)lo.x, (int)lo.y, (int)lo.z, (int)lo.w, (int)hi.x, (int)hi.y, (int)hi.z, (int)hi.w}; }
#pragma unroll
            for (int i = 0; i < MT; ++i)
#pragma unroll
                for (int j = 0; j < NT; ++j) acc[i][j] = MFMA8X(bfr[j], af[i], acc[i][j]);
        } else {
#pragma unroll
        for (int s = 0; s < 2; ++s) {
            bf16x8 af[MT], bfr[NT];
#pragma unroll
            for (int i = 0; i < MT; ++i) af[i] = *(const bf16x8*)(cA + toff(wm * MT * 16 + i * 16 + fr, s * 4 + fg));
#pragma unroll
            for (int j = 0; j < NT; ++j) bfr[j] = *(const bf16x8*)(cB + toff(wn * NT * 16 + j * 16 + fr, s * 4 + fg));
#pragma unroll
            for (int i = 0; i < MT; ++i)
#pragma unroll
                for (int j = 0; j < NT; ++j) acc[i][j] = MFMA16(bfr[j], af[i], acc[i][j]);
        }
        }
        asm volatile("s_waitcnt vmcnt(0)" ::: "memory");
        __syncthreads();
    }
#undef GK_STAGE
}
__device__ __forceinline__ void gemm_kloop2(f32x4 (&acc)[4][4], uint2 (&yb)[4][4], const u16* a1, int lda1, const u16* b1, int ldb1, int nk1,
                                            const u16* a2, int lda2, const u16* b2, int ldb2, int nk2, char* lds, int tid) {
    const int lane = tid & 63, w = tid >> 6;
    const int wm = w >> 1, wn = w & 1;
    const int fr = lane & 15, fg = lane >> 4;
    const int lrow = lane >> 3, pc = lane & 7;
    const int nk = nk1 + nk2;
#define GK_STAGE2(kt_, buf_) do { char* dA_ = lds + (buf_) * 32768 + w * 4096 + lane * 16; \
        const bool f_ = (kt_) < nk1; const u16* ab_ = f_ ? a1 : a2; const u16* bb_ = f_ ? b1 : b2; const int la_ = f_ ? lda1 : lda2, lb_ = f_ ? ldb1 : ldb2; \
        const int kk_ = (f_ ? (kt_) : (kt_) - nk1) * 64; \
        _Pragma("unroll") for (int q_ = 0; q_ < 4; ++q_) { const int row_ = w * 32 + q_ * 8 + lrow; const int c_ = (pc ^ ((row_ >> 1) & 7)) * 8 + kk_; \
            __builtin_amdgcn_global_load_lds((const unsigned*)(ab_ + (size_t)row_ * la_ + c_), (unsigned*)(dA_ + q_ * 1024), 16, 0, 0); \
            __builtin_amdgcn_global_load_lds((const unsigned*)(bb_ + (size_t)row_ * lb_ + c_), (unsigned*)(dA_ + 16384 + q_ * 1024), 16, 0, 0); } } while (0)
    GK_STAGE2(0, 0);
    asm volatile("s_waitcnt vmcnt(0)" ::: "memory");
    __syncthreads();
#pragma unroll 1
    for (int kt = 0; kt < nk1; ++kt) {
        const char* cA = lds + (kt & 1) * 32768; const char* cB = cA + 16384;
        if (kt + 1 < nk) GK_STAGE2(kt + 1, (kt + 1) & 1);
#pragma unroll
        for (int s = 0; s < 2; ++s) {
            bf16x8 af[4], bfr[4];
#pragma unroll
            for (int i = 0; i < 4; ++i) af[i] = *(const bf16x8*)(cA + toff(wm * 64 + i * 16 + fr, s * 4 + fg));
#pragma unroll
            for (int j = 0; j < 4; ++j) bfr[j] = *(const bf16x8*)(cB + toff(wn * 64 + j * 16 + fr, s * 4 + fg));
#pragma unroll
            for (int i = 0; i < 4; ++i)
#pragma unroll
                for (int j = 0; j < 4; ++j) acc[i][j] = MFMA16(bfr[j], af[i], acc[i][j]);
        }
        asm volatile("s_waitcnt vmcnt(0)" ::: "memory");
        __syncthreads();
    }
#pragma unroll
    for (int i = 0; i < 4; ++i)
#pragma unroll
        for (int j = 0; j < 4; ++j) { yb[i][j] = pk4(acc[i][j]); acc[i][j] = (f32x4){0.f, 0.f, 0.f, 0.f}; }
#pragma unroll 1
    for (int kt = nk1; kt < nk; ++kt) {
        const char* cA = lds + (kt & 1) * 32768; const char* cB = cA + 16384;
        if (kt + 1 < nk) GK_STAGE2(kt + 1, (kt + 1) & 1);
        {
            i32x8 af[4], bfr[4];
#pragma unroll
            for (int i = 0; i < 4; ++i) { const uint4 lo = *(const uint4*)(cA + toff(wm * 64 + i * 16 + fr, fg)), hi = *(const uint4*)(cA + toff(wm * 64 + i * 16 + fr, 4 + fg));
                                          af[i] = (i32x8){(int)lo.x, (int)lo.y, (int)lo.z, (int)lo.w, (int)hi.x, (int)hi.y, (int)hi.z, (int)hi.w}; }
#pragma unroll
            for (int j = 0; j < 4; ++j) { const uint4 lo = *(const uint4*)(cB + toff(wn * 64 + j * 16 + fr, fg)), hi = *(const uint4*)(cB + toff(wn * 64 + j * 16 + fr, 4 + fg));
                                          bfr[j] = (i32x8){(int)lo.x, (int)lo.y, (int)lo.z, (int)lo.w, (int)hi.x, (int)hi.y, (int)hi.z, (int)hi.w}; }
#pragma unroll
            for (int i = 0; i < 4; ++i)
#pragma unroll
                for (int j = 0; j < 4; ++j) acc[i][j] = MFMA8X(bfr[j], af[i], acc[i][j]);
        }
        asm volatile("s_waitcnt vmcnt(0)" ::: "memory");
        __syncthreads();
    }
#undef GK_STAGE2
}
template <int MT, int NT> __device__ __forceinline__ void acc_zero(f32x4 (&acc)[MT][NT]) {
#pragma unroll
    for (int i = 0; i < MT; ++i)
#pragma unroll
        for (int j = 0; j < NT; ++j) acc[i][j] = (f32x4){0.f, 0.f, 0.f, 0.f};
}
struct RowLoader {
    const u16* base; int ld;
    __device__ __forceinline__ RowLoader(const u16* b, int l, int) : base(b), ld(l) {}
    __device__ __forceinline__ unsigned off(int q, int row, int c) const { return (unsigned)(row * ld + c * 8) * 2u; }
    __device__ __forceinline__ const char* ub(int kt) const { return (const char*)base + kt * 128; }
};

struct ConvJob { const float* src; int ldsrc; int K; int nc; u16* dst; int ldd; const float* scale; int smode; };
__device__ __forceinline__ void conv_tile(const ConvJob& jb, int tk, int tn, char* lds) {
    float* T = (float*)lds;
    const int tid = tid_opaque();
    const int k0 = tk * 64, n0 = tn * 64;
    const bool full = (jb.src != nullptr) && (k0 + 64 <= jb.K) && (n0 + 64 <= jb.nc) && ((jb.ldsrc & 3) == 0);
    if (full) {
        const int n4 = (tid & 15) * 4, kb = tid >> 4;
#pragma unroll
        for (int i = 0; i < 4; ++i) {
            const int kl = kb + 16 * i; const int k = k0 + kl;
            f32x4 v = *(const f32x4*)(jb.src + (size_t)k * jb.ldsrc + n0 + n4);
            if (jb.smode == 1) v = v * (1.f - jb.scale[k]); else if (jb.smode == 2) v = v * jb.scale[k];
            T[kl * 65 + n4] = v[0]; T[kl * 65 + n4 + 1] = v[1]; T[kl * 65 + n4 + 2] = v[2]; T[kl * 65 + n4 + 3] = v[3];
        }
    } else {
        const int nl = tid & 63, kb = tid >> 6;
#pragma unroll
        for (int i = 0; i < 16; ++i) {
            const int kl = kb + 4 * i; const int k = k0 + kl, n = n0 + nl;
            float v = 0.f;
            if (jb.src != nullptr && k < jb.K && n < jb.nc) {
                v = jb.src[(size_t)k * jb.ldsrc + n];
                if (jb.smode == 1) v *= (1.f - jb.scale[k]); else if (jb.smode == 2) v *= jb.scale[k];
            }
            T[kl * 65 + nl] = v;
        }
    }
    __syncthreads();
    if (full || ((k0 + 64 <= jb.K) && (n0 + 64 <= jb.nc))) {
        const int k8 = (tid & 7) * 8, nb = tid >> 3;
#pragma unroll
        for (int i = 0; i < 2; ++i) {
            const int nl = nb + 32 * i;
            const uint4 o = make_uint4(pk_bf16(T[(k8 + 0) * 65 + nl], T[(k8 + 1) * 65 + nl]), pk_bf16(T[(k8 + 2) * 65 + nl], T[(k8 + 3) * 65 + nl]),
                                       pk_bf16(T[(k8 + 4) * 65 + nl], T[(k8 + 5) * 65 + nl]), pk_bf16(T[(k8 + 6) * 65 + nl], T[(k8 + 7) * 65 + nl]));
            *(uint4*)(jb.dst + (size_t)(n0 + nl) * jb.ldd + k0 + k8) = o;
        }
    } else {
        const int kp = tid & 31, nb = tid >> 5;
#pragma unroll
        for (int i = 0; i < 8; ++i) {
            const int nl = nb + 8 * i; const int n = n0 + nl, k = k0 + 2 * kp;
            if (n < jb.nc && k < jb.K) {
                const unsigned pv = pk_bf16(T[(2 * kp) * 65 + nl], T[(2 * kp + 1) * 65 + nl]);
                *(unsigned*)(jb.dst + (size_t)n * jb.ldd + k) = pv;
            }
        }
    }
    __syncthreads();
}
constexpr int NE_JOBS = 23;
__device__ __forceinline__ void ne_job_dims(int j, int& K, int& nc) {
    K = 1024; nc = 64;
    switch (j) {
        case 0: nc = 1536; break; case 1: case 2: case 5: case 6: nc = 64; break; case 3: case 7: nc = 128; break; case 4: case 8: nc = 32; break;
        case 9: nc = 64; break; case 10: nc = 3328; break; case 11: nc = 3072; break; case 12: K = 512; nc = 1024; break; case 13: K = 256; nc = 1024; break;
        case 14: K = 512; nc = 1024; break; case 15: nc = 1024; break; case 16: case 17: K = 64; nc = 512; break; case 18: K = 128; nc = 512; break;
        case 19: K = 32; nc = 512; break; case 20: nc = 4; break; case 21: nc = 16; break; case 22: nc = 108; break;
    }
}
__device__ __forceinline__ void ne_job(const Params& p, int l, int j, ConvJob& jb) {
    char* wne = p.ws + OFF_WNE + (size_t)l * WNE_SZ;
    int K, nc; ne_job_dims(j, K, nc);
    jb.K = K; jb.nc = nc; jb.scale = nullptr; jb.smode = 0; jb.ldd = K; jb.src = nullptr; jb.ldsrc = nc; jb.dst = (u16*)wne;
    const float* w_in = (const float*)p.in[3] + (size_t)l * 1024 * 4864;
    const float* muwag = (const float*)p.in[9] + (size_t)l * 3 * 1024;
    const float* muv = (const float*)p.in[23];
    u16* wtc = (u16*)(wne + WNE_WTC);
    switch (j) {
        case 0: jb.src = w_in + 3328; jb.ldsrc = 4864; jb.dst = wtc; break;
        case 1: jb.src = (const float*)p.in[11] + (size_t)l * 1024 * 64; jb.dst = wtc + 1536 * 1024; jb.scale = muwag; jb.smode = 1; break;
        case 2: jb.src = (const float*)p.in[14] + (size_t)l * 1024 * 64; jb.dst = wtc + 1600 * 1024; jb.scale = muwag + 1024; jb.smode = 1; break;
        case 3: jb.src = (const float*)p.in[16] + (size_t)l * 1024 * 128; jb.dst = wtc + 1664 * 1024; jb.scale = muwag + 2048; jb.smode = 1; break;
        case 4: jb.src = (l == 1) ? (const float*)p.in[25] : nullptr; jb.dst = wtc + 2048 * 1024; jb.scale = muv; jb.smode = 1; break;
        case 5: jb.src = (const float*)p.in[11] + (size_t)l * 1024 * 64; jb.dst = wtc + 1792 * 1024; jb.scale = muwag; jb.smode = 2; break;
        case 6: jb.src = (const float*)p.in[14] + (size_t)l * 1024 * 64; jb.dst = wtc + 1856 * 1024; jb.scale = muwag + 1024; jb.smode = 2; break;
        case 7: jb.src = (const float*)p.in[16] + (size_t)l * 1024 * 128; jb.dst = wtc + 1920 * 1024; jb.scale = muwag + 2048; jb.smode = 2; break;
        case 8: jb.src = (l == 1) ? (const float*)p.in[25] : nullptr; jb.dst = wtc + 2080 * 1024; jb.scale = muv; jb.smode = 2; break;
        case 9: jb.src = nullptr; jb.dst = wtc + 2112 * 1024; break;
        case 10: jb.src = w_in; jb.ldsrc = 4864; jb.dst = (u16*)(wne + WNE_WTAB); break;
        case 11: jb.src = (const float*)p.in[30] + (size_t)l * 1024 * 3072; jb.dst = (u16*)(wne + WNE_WGATE); jb.smode = 3; break;
        case 12: jb.src = (const float*)p.in[27] + (size_t)l * 512 * 1024; jb.dst = (u16*)(wne + WNE_WBRA); break;
        case 13: jb.src = (const float*)p.in[28] + (size_t)l * 256 * 1024; jb.dst = (u16*)(wne + WNE_WBRB); break;
        case 14: jb.src = (const float*)p.in[29] + (size_t)l * 512 * 1024; jb.dst = (u16*)(wne + WNE_WBRC); break;
        case 15: jb.src = (const float*)p.in[32] + (size_t)l * 1024 * 1024; jb.dst = (u16*)(wne + WNE_WOUT); break;
        case 16: jb.src = (const float*)p.in[12] + (size_t)l * 64 * 512; jb.dst = (u16*)(wne + WNE_W2T); break;
        case 17: jb.src = (const float*)p.in[15] + (size_t)l * 64 * 512; jb.dst = (u16*)(wne + WNE_A2T); break;
        case 18: jb.src = (const float*)p.in[17] + (size_t)l * 128 * 512; jb.dst = (u16*)(wne + WNE_G2T); break;
        case 19: jb.src = (l == 1) ? (const float*)p.in[26] : nullptr; jb.dst = (u16*)(wne + WNE_V2T); break;
        case 20: jb.src = (const float*)p.in[34] + (size_t)l * 1024 * 4; jb.dst = (u16*)(wne + WNE_WR); break;
        case 21: jb.src = (const float*)p.in[36] + (size_t)l * 1024 * 16; jb.dst = (u16*)(wne + WNE_WR) + 4 * 1024; break;
        case 22: jb.src = nullptr; jb.dst = (u16*)(wne + WNE_WR) + 20 * 1024; break;
    }
}
__device__ __forceinline__ int ne_total_tiles() {
    int tot = 0;
#pragma unroll
    for (int j = 0; j < NE_JOBS; ++j) { int K, nc; ne_job_dims(j, K, nc); tot += ((K + 63) / 64) * ((nc + 63) / 64); }
    return tot;
}
__device__ __forceinline__ bool conv_full(const ConvJob& jb, int tk, int tn) { return (jb.src != nullptr) && (tk * 64 + 64 <= jb.K) && (tn * 64 + 64 <= jb.nc) && ((jb.ldsrc & 3) == 0); }
__device__ __forceinline__ void conv_load(const ConvJob& jb, int tk, int tn, f32x4 (&v)[4], float (&sc)[4], int tid) {
    const int n4 = (tid & 15) * 4, kb = tid >> 4;
#pragma unroll
    for (int i = 0; i < 4; ++i) {
        const int k = tk * 64 + kb + 16 * i;
        v[i] = *(const f32x4*)(jb.src + (size_t)k * jb.ldsrc + tn * 64 + n4);
        sc[i] = (jb.smode == 1 || jb.smode == 2) ? jb.scale[k] : 1.f;
    }
}
__device__ __forceinline__ void conv_finish(const ConvJob& jb, int tk, int tn, const f32x4 (&v)[4], const float (&sc)[4], char* lds, int tid) {
    float* T = (float*)lds;
    const int k0 = tk * 64, n0 = tn * 64;
    {
        const int n4 = (tid & 15) * 4, kb = tid >> 4;
#pragma unroll
        for (int i = 0; i < 4; ++i) {
            const int kl = kb + 16 * i;
            const float m = (jb.smode == 1) ? (1.f - sc[i]) : (jb.smode == 3 ? GATE_WSCALE : sc[i]);
            const f32x4 w = v[i] * m;
            T[kl * 65 + n4] = w[0]; T[kl * 65 + n4 + 1] = w[1]; T[kl * 65 + n4 + 2] = w[2]; T[kl * 65 + n4 + 3] = w[3];
        }
    }
    __syncthreads();
    {
        const int k8 = (tid & 7) * 8, nb = tid >> 3;
#pragma unroll
        for (int i = 0; i < 2; ++i) {
            const int nl = nb + 32 * i;
            if (jb.smode == 3) {
                const uint2 o8 = make_uint2(pk_fp8x4(T[(k8 + 0) * 65 + nl], T[(k8 + 1) * 65 + nl], T[(k8 + 2) * 65 + nl], T[(k8 + 3) * 65 + nl]),
                                            pk_fp8x4(T[(k8 + 4) * 65 + nl], T[(k8 + 5) * 65 + nl], T[(k8 + 6) * 65 + nl], T[(k8 + 7) * 65 + nl]));
                *(uint2*)((char*)jb.dst + (size_t)(n0 + nl) * jb.ldd + k0 + k8) = o8;
            } else {
            const uint4 o = make_uint4(pk_bf16(T[(k8 + 0) * 65 + nl], T[(k8 + 1) * 65 + nl]), pk_bf16(T[(k8 + 2) * 65 + nl], T[(k8 + 3) * 65 + nl]),
                                       pk_bf16(T[(k8 + 4) * 65 + nl], T[(k8 + 5) * 65 + nl]), pk_bf16(T[(k8 + 6) * 65 + nl], T[(k8 + 7) * 65 + nl]));
            *(uint4*)(jb.dst + (size_t)(n0 + nl) * jb.ldd + k0 + k8) = o;
            }
        }
    }
    __syncthreads();
}
__device__ __forceinline__ void ne_decode(const Params& p, int per_layer, int u, ConvJob& jb, int& tk, int& tn) {
    const int l = u / per_layer; int t = u % per_layer; int j = 0;
    for (; j < NE_JOBS; ++j) { int K, nc; ne_job_dims(j, K, nc); const int c = ((K + 63) / 64) * ((nc + 63) / 64); if (t < c) break; t -= c; }
    ne_job(p, l, j, jb);
    const int ntn = (jb.nc + 63) / 64;
    tk = t / ntn; tn = t % ntn;
}
__device__ void phase_conv_ne(const Params& p, char* lds) {
    const int per_layer = ne_total_tiles();
    const int nconv = 2 * per_layer;
    const int nrot = NTOK * 8 / 256;
    const int tid = tid_opaque();
    const int G = gridDim.x;
    f32x4 v[4]; float sc[4]; bool fc = false;
#pragma unroll
    for (int i = 0; i < 4; ++i) { v[i] = (f32x4){0.f, 0.f, 0.f, 0.f}; sc[i] = 1.f; }
    { const int u = blockIdx.x; if (u < nconv) { ConvJob jb; int tk, tn; ne_decode(p, per_layer, u, jb, tk, tn); fc = conv_full(jb, tk, tn); if (fc) conv_load(jb, tk, tn, v, sc, tid); } }
#pragma unroll 1
    for (int u = blockIdx.x; u < nconv; u += G) {
        f32x4 vn[4]; float scn[4]; bool fn = false;
#pragma unroll
        for (int i = 0; i < 4; ++i) { vn[i] = (f32x4){0.f, 0.f, 0.f, 0.f}; scn[i] = 1.f; }
        const int un = u + G;
        if (un < nconv) { ConvJob jn; int tk, tn; ne_decode(p, per_layer, un, jn, tk, tn); fn = conv_full(jn, tk, tn); if (fn) conv_load(jn, tk, tn, vn, scn, tid); }
        { ConvJob jb; int tk, tn; ne_decode(p, per_layer, u, jb, tk, tn);
          if (fc) conv_finish(jb, tk, tn, v, sc, lds, tid); else conv_tile(jb, tk, tn, lds); }
#pragma unroll
        for (int i = 0; i < 4; ++i) { v[i] = vn[i]; sc[i] = scn[i]; }
        fc = fn;
    }
    for (int r = blockIdx.x; r < 64; r += G) {
        const int e8 = (r * 256 + threadIdx.x) * 8;
        const int t_ = (e8 >> 7) & 127, s0_ = e8 & 127;
        const f32x4 w0 = *(const f32x4*)((const float*)p.in[6] + e8), w1 = *(const f32x4*)((const float*)p.in[6] + e8 + 4);
        unsigned ow[4];
#pragma unroll
        for (int k = 0; k < 4; ++k) { const int si = s0_ + 2 * k; const float a = (k < 2) ? w0[2 * k] : w1[2 * k - 4], b2 = (k < 2) ? w0[2 * k + 1] : w1[2 * k - 3];
                                      ow[k] = pk_bf16(si <= t_ ? a : 0.f, (si + 1) <= t_ ? b2 : 0.f); }
        *(uint4*)(p.ws + OFF_WSA + (size_t)e8 * 2) = make_uint4(ow[0], ow[1], ow[2], ow[3]);
    }
    for (int r = blockIdx.x; r < nrot; r += G) {
        const int e = r * 256 + threadIdx.x;
        const int tok = e >> 3, i = e & 7;
        const float pos = (float)((const int*)p.in[1])[tok];
        const float inv = __expf(-(float)i * (13.122363377404328f / 8.f));
        float sn, cs; sincosf(pos * inv, &sn, &cs);
        ((float*)(p.ws + OFF_ROT))[e] = cs;
        ((float*)(p.ws + OFF_ROT))[(size_t)NTOK * 8 + e] = sn;
    }
}
__device__ __forceinline__ char* wexp_base(const Params& p, int l, int mat) {
    return p.ws + (mat == 0 ? (OFF_V + (l == 0 ? (size_t)NTOK * 1024 : 0)) : (mat == 1 ? OFF_UP8 : OFF_DOWN8));
}
__device__ __forceinline__ void expert_decode(const Params& p, int l, int u, ConvJob& jb, int& tk, int& tn) {
    const int mat = u >> 11, e = (u & 2047) >> 7, tile = u & 127;
    jb.scale = nullptr; jb.smode = 0;
    if (mat < 2) {
        jb.src = (const float*)p.in[38 + mat] + ((size_t)l * 16 + e) * 1024 * 512; jb.ldsrc = 512; jb.K = 1024; jb.nc = 512;
        jb.dst = (u16*)(wexp_base(p, l, mat) + (size_t)e * 512 * 1024); jb.ldd = 1024; jb.smode = 3;
        tk = tile >> 3; tn = tile & 7;
    } else {
        jb.src = (const float*)p.in[40] + ((size_t)l * 16 + e) * 512 * 1024; jb.ldsrc = 1024; jb.K = 512; jb.nc = 1024;
        jb.dst = (u16*)(wexp_base(p, l, 2) + (size_t)e * 512 * 1024); jb.ldd = 512; jb.smode = 3;
        tk = tile >> 4; tn = tile & 15;
    }
}
__device__ __forceinline__ void conv_expert_unit(const Params& p, int l, int u, char* lds) {
    ConvJob jb; int tk, tn; expert_decode(p, l, u, jb, tk, tn);
    conv_tile(jb, tk, tn, lds);
}
__device__ __forceinline__ void conv_expert_run(const Params& p, int l, int t0, int n, int G, int tend, char* lds) {
    const int tid = tid_opaque();
    f32x4 v[4]; float sc[4]; bool have = false;
#pragma unroll
    for (int i = 0; i < 4; ++i) { v[i] = (f32x4){0.f, 0.f, 0.f, 0.f}; sc[i] = 1.f; }
    if (n > 0 && t0 < tend) { ConvJob jb; int tk, tn; expert_decode(p, l, t0, jb, tk, tn); conv_load(jb, tk, tn, v, sc, tid); have = true; }
#pragma unroll 1
    for (int i = 0; i < n; ++i) {
        const int tc = t0 + i * G, tx = tc + G;
        f32x4 vn[4]; float scn[4]; bool hn = false;
#pragma unroll
        for (int q = 0; q < 4; ++q) { vn[q] = (f32x4){0.f, 0.f, 0.f, 0.f}; scn[q] = 1.f; }
        if (i + 1 < n && tx < tend) { ConvJob jn; int tk, tn; expert_decode(p, l, tx, jn, tk, tn); conv_load(jn, tk, tn, vn, scn, tid); hn = true; }
        if (have) { ConvJob jb; int tk, tn; expert_decode(p, l, tc, jb, tk, tn); conv_finish(jb, tk, tn, v, sc, lds, tid); }
#pragma unroll
        for (int q = 0; q < 4; ++q) { v[q] = vn[q]; sc[q] = scn[q]; }
        have = hn;
    }
}

template <bool FINAL>
__device__ void phase_norm(const Params& p, const float* x, const float* g) {
    const int tid_ = tid_opaque();
    const int lane = tid_ & 63;
    const int gw = blockIdx.x * 4 + (tid_ >> 6);
    const int nwv = gridDim.x * 4;
    float4 gg[4];
#pragma unroll
    for (int i = 0; i < 4; ++i) gg[i] = ((const float4*)g)[lane + 64 * i];
#pragma unroll 1
    for (int row0 = gw; row0 < NTOK; row0 += 8 * nwv) {
        float4 v[8][4];
#pragma unroll
        for (int rr = 0; rr < 8; ++rr) {
            const float4* xr = (const float4*)(x + (size_t)min(row0 + rr * nwv, NTOK - 1) * 1024);
#pragma unroll
            for (int i = 0; i < 4; ++i) v[rr][i] = xr[lane + 64 * i];
        }
#pragma unroll
        for (int rr = 0; rr < 8; ++rr) {
            const int row = row0 + rr * nwv;
            float ss = 0.f;
#pragma unroll
            for (int i = 0; i < 4; ++i) ss += v[rr][i].x * v[rr][i].x + v[rr][i].y * v[rr][i].y + v[rr][i].z * v[rr][i].z + v[rr][i].w * v[rr][i].w;
            ss = wavesum(ss);
            const float rinv = rsqrtf(ss * (1.f / 1024.f) + 1e-6f);
            if (row < NTOK) {
#pragma unroll
                for (int i = 0; i < 4; ++i) {
                    const float a = v[rr][i].x * rinv * gg[i].x, b = v[rr][i].y * rinv * gg[i].y, c = v[rr][i].z * rinv * gg[i].z, d = v[rr][i].w * rinv * gg[i].w;
                    if (FINAL) ((float4*)(p.out + (size_t)row * 1024))[lane + 64 * i] = make_float4(a, b, c, d);
                    else ((uint2*)(p.ws + OFF_H + (size_t)row * 2048))[lane + 64 * i] = make_uint2(pk_bf16(a, b), pk_bf16(c, d));
                }
            }
        }
    }
}

__device__ void gemm2a_unit(const Params& p, int l, int u, int ntn, char* lds) {
    const int mt = u / ntn, nt = u % ntn;
    const int tid = tid_opaque();
    const int lane = tid & 63, w = tid >> 6, wm = w >> 1, wn = w & 1, fr = lane & 15, fg = lane >> 4;
    RowLoader al((const u16*)(p.ws + OFF_H) + (size_t)mt * 128 * 1024, 1024, tid);
    RowLoader bl((const u16*)(p.ws + OFF_WNE + (size_t)l * WNE_SZ + WNE_WTC) + (size_t)nt * 128 * 1024, 1024, tid);
    f32x4 acc[4][4]; acc_zero<4, 4>(acc);
    gemm_kloop<4, 4>(acc, al, bl, 16, lds, tid);
    u16* projc = (u16*)(p.ws + OFF_R + R_PROJC); u16* lora1 = (u16*)(p.ws + OFF_R + R_LORA1);
#pragma unroll
    for (int i = 0; i < 4; ++i)
#pragma unroll
        for (int j = 0; j < 4; ++j) {
            const int m = mt * 128 + wm * 64 + i * 16 + fr, n = nt * 128 + wn * 64 + j * 16 + fg * 4;
            const uint2 v = pk4(acc[i][j]);
            if (n < 1536) *(uint2*)(projc + (size_t)m * 1536 + n) = v;
            else if (n < 2112) *(uint2*)(lora1 + (size_t)m * 576 + (n - 1536)) = v;
        }
}
__device__ void gemm2b_unit(const Params& p, int l, int u, char* lds) {
    const int mt = u / 26, nt = u % 26;
    const int tid = tid_opaque();
    const int lane = tid & 63, w = tid >> 6, wm = w >> 1, wn = w & 1, fr = lane & 15, fg = lane >> 4;
    RowLoader al((const u16*)(p.ws + OFF_H) + (size_t)mt * 128 * 1024, 1024, tid);
    RowLoader bl((const u16*)(p.ws + OFF_WNE + (size_t)l * WNE_SZ + WNE_WTAB) + (size_t)nt * 128 * 1024, 1024, tid);
    f32x4 acc[4][4]; acc_zero<4, 4>(acc);
    gemm_kloop<4, 4>(acc, al, bl, 16, lds, tid);
    u16* proja = (u16*)(p.ws + OFF_R + R_PROJA); u16* projb = (u16*)(p.ws + OFF_R + R_PROJB);
    const float* rc = (const float*)(p.ws + OFF_ROT); const float* rs = rc + (size_t)NTOK * 8;
    const int nbase = nt * 128 + wn * 64;
#pragma unroll
    for (int i = 0; i < 4; ++i) {
        const int m = mt * 128 + wm * 64 + i * 16 + fr;
#pragma unroll
        for (int j = 0; j < 4; ++j) {
            const int n = nbase + j * 16 + fg * 4;
            f32x4 v = acc[i][j];
            if (nbase < 1024) {
#pragma unroll
                for (int q = 0; q < 4; ++q) v[q] = gelu_tanh(v[q]);
                *(uint2*)(proja + (size_t)m * 1024 + n) = pk4(v);
            } else {
                const int nb = n - 1024;
                if (nbase < 1024 + 1536 && j == 0) {
                    f32x4 pv;
#pragma unroll
                    for (int q = 0; q < 4; ++q) pv[q] = __shfl_xor(v[q], 32);
                    const f32x4 cs = *(const f32x4*)(rc + (size_t)m * 8 + (fg & 1) * 4);
                    const f32x4 sn = *(const f32x4*)(rs + (size_t)m * 8 + (fg & 1) * 4);
#pragma unroll
                    for (int q = 0; q < 4; ++q) v[q] = (fg < 2) ? (v[q] * cs[q] - pv[q] * sn[q]) : (v[q] * cs[q] + pv[q] * sn[q]);
                }
                if (nbase < 1024 + 768) { v = v * 0.125f; }
                *(uint2*)(projb + (size_t)m * 2304 + nb) = pk4(v);
            }
        }
    }
}

__device__ __forceinline__ bf16x8 act8(uint4 a, uint4 b, int mode) {
    unsigned av[4] = {a.x, a.y, a.z, a.w}, bv[4] = {b.x, b.y, b.z, b.w}; unsigned o[4];
#pragma unroll
    for (int q = 0; q < 4; ++q) {
        float lo = bflo(av[q]) + bflo(bv[q]), hi = bfhi(av[q]) + bfhi(bv[q]);
        if (mode == 1) { lo = 1.f - 2.f * fast_rcp(fast_exp(2.f * lo) + 1.f); hi = 1.f - 2.f * fast_rcp(fast_exp(2.f * hi) + 1.f); }
        else if (mode == 2) { lo = sigmoidf_(lo); hi = sigmoidf_(hi); }
        o[q] = pk_bf16(lo, hi);
    }
    return mk8(make_uint4(o[0], o[1], o[2], o[3]));
}
__device__ void prep_unit(const Params& p, int l, int u, char* lds) {
    const int tt = u >> 3, hh = u & 7;
    const int tid = tid_opaque();
    const int lane = tid & 63, w = tid >> 6, tl = lane & 15, G = lane >> 4;
    const char* wne = p.ws + OFF_WNE + (size_t)l * WNE_SZ;
    const u16* lora1 = (const u16*)(p.ws + OFF_R + R_LORA1);
    const u16* projc = (const u16*)(p.ws + OFF_R + R_PROJC);
    const u16* vfirst = (const u16*)(p.ws + OFF_V);
    u16* vout = (u16*)(p.ws + OFF_V + (size_t)l * NTOK * 1024);
    u16* gout = (u16*)(p.ws + OFF_G);
    uint2* KKo = (uint2*)(p.ws + OFF_KK); uint2* RRo = (uint2*)(p.ws + OFF_RR); uint4* BKo = (uint4*)(p.ws + OFF_BK); float* PCo = (float*)(p.ws + OFF_PC);
    float* bonus = (float*)(p.ws + OFF_BONUS);
    char* ldsW = lds; char* ldsA = lds + 8192; char* ldsG = lds + 16384; char* ldsV = lds + 32768; float* prm = (float*)(lds + 36864);
    __syncthreads();
    {
        const u16* w2 = (const u16*)(wne + WNE_W2T) + (size_t)hh * 64 * 64; const u16* a2 = (const u16*)(wne + WNE_A2T) + (size_t)hh * 64 * 64;
        const u16* g2 = (const u16*)(wne + WNE_G2T) + (size_t)hh * 64 * 128; const u16* v2 = (const u16*)(wne + WNE_V2T) + (size_t)hh * 64 * 32;
#pragma unroll
        for (int k = 0; k < 2; ++k) { const int q = tid + 256 * k, row = q >> 3, ch = q & 7;
            *(uint4*)(ldsW + toff(row, ch)) = *(const uint4*)(w2 + row * 64 + ch * 8); *(uint4*)(ldsA + toff(row, ch)) = *(const uint4*)(a2 + row * 64 + ch * 8); }
#pragma unroll
        for (int k = 0; k < 4; ++k) { const int q = tid + 256 * k, row = q >> 4, ch = q & 15; *(uint4*)(ldsG + row * 256 + ((ch ^ (row & 15)) << 4)) = *(const uint4*)(g2 + row * 128 + ch * 8); }
        if (l == 1) { const int row = tid >> 2, ch = tid & 3; *(uint4*)(ldsV + row * 64 + ch * 16) = *(const uint4*)(v2 + row * 32 + ch * 8); }
        const float* mu_rkv = (const float*)p.in[8] + (size_t)l * 3 * 512 + hh * 64;
        for (int q = tid; q < 9 * 64; q += 256) {
            const int a_ = q >> 6, c_ = q & 63; float v_;
            if (a_ < 3) v_ = mu_rkv[a_ * 512 + c_];
            else if (a_ == 3) v_ = ((const float*)p.in[10])[(size_t)l * 512 + hh * 64 + c_];
            else if (a_ == 4) v_ = ((const float*)p.in[13])[(size_t)l * 512 + hh * 64 + c_];
            else if (a_ == 5) v_ = ((const float*)p.in[18])[(size_t)l * 512 + hh * 64 + c_];
            else if (a_ == 6) v_ = ((const float*)p.in[19])[(size_t)l * 512 + hh * 64 + c_];
            else if (a_ == 7) v_ = ((const float*)p.in[20])[(size_t)l * 512 + hh * 64 + c_];
            else v_ = (l == 1) ? ((const float*)p.in[24])[hh * 64 + c_] : 0.f;
            prm[q] = v_;
        }
    }
    __syncthreads();
#pragma unroll 1
    for (int t2 = 0; t2 < 2; ++t2) {
        const int tk = tt * 128 + w * 32 + t2 * 16 + tl; const bool hp = (tk & (SEQ - 1)) != 0;
        uint4 xa[9], xb[9];
#pragma unroll
        for (int i = 0; i < 9; ++i) {
            const int cola = (i < 2) ? (i * 32) : (i < 4 ? 64 + (i - 2) * 32 : (i < 8 ? 128 + (i - 4) * 32 : 512));
            xa[i] = make_uint4(0, 0, 0, 0); xb[i] = xa[i];
            if (i < 8 || l == 1) {
                xa[i] = *(const uint4*)(lora1 + (size_t)tk * 576 + cola + 8 * G);
                if (hp) xb[i] = *(const uint4*)(lora1 + (size_t)(tk - 1) * 576 + ((i < 8) ? 256 : 32) + cola + 8 * G);
            }
        }
        uint2 rc[4], kc[4], vc[4], rp[4], kp_[4], vp[4], vf[4];
        f32x4 acc[4][4];
#pragma unroll
        for (int a_ = 0; a_ < 4; ++a_)
#pragma unroll
            for (int b_ = 0; b_ < 4; ++b_) acc[a_][b_] = (f32x4){0.f, 0.f, 0.f, 0.f};
#pragma unroll
        for (int i = 0; i < 9; ++i) {
            if (i == 4) {
#pragma unroll
            for (int ct = 0; ct < 4; ++ct) {
                const int c0 = hh * 64 + ct * 16 + G * 4;
                rc[ct] = *(const uint2*)(projc + (size_t)tk * 1536 + c0); kc[ct] = *(const uint2*)(projc + (size_t)tk * 1536 + 512 + c0); vc[ct] = *(const uint2*)(projc + (size_t)tk * 1536 + 1024 + c0);
                rp[ct] = make_uint2(0, 0); kp_[ct] = rp[ct]; vp[ct] = rp[ct]; vf[ct] = rp[ct];
                if (hp && tl == 0) { rp[ct] = *(const uint2*)(projc + (size_t)(tk - 1) * 1536 + c0); kp_[ct] = *(const uint2*)(projc + (size_t)(tk - 1) * 1536 + 512 + c0); vp[ct] = *(const uint2*)(projc + (size_t)(tk - 1) * 1536 + 1024 + c0); }
                if (l == 1) vf[ct] = *(const uint2*)(vfirst + (size_t)tk * 512 + c0);
            }
            }
            if (i == 8 && l == 0) continue;
            const int mat = (i < 2) ? 0 : (i < 4 ? 1 : (i < 8 ? 2 : 3));
            const int sidx = (i < 2) ? i : (i < 4 ? i - 2 : (i < 8 ? i - 4 : 0));
            const int mode = (mat == 0) ? 1 : (mat == 2 ? 2 : 0);
            const bf16x8 bfr = act8(xa[i], xb[i], mode);
#pragma unroll
            for (int ct = 0; ct < 4; ++ct) {
                const int row = ct * 16 + tl;
                bf16x8 af;
                if (mat == 0) af = *(const bf16x8*)(ldsW + toff(row, sidx * 4 + G));
                else if (mat == 1) af = *(const bf16x8*)(ldsA + toff(row, sidx * 4 + G));
                else if (mat == 2) af = *(const bf16x8*)(ldsG + row * 256 + (((sidx * 4 + G) ^ (row & 15)) << 4));
                else af = *(const bf16x8*)(ldsV + row * 64 + G * 16);
                acc[mat][ct] = MFMA16(af, bfr, acc[mat][ct]);
            }
        }
#define SHR1(x) ((unsigned)__builtin_amdgcn_update_dpp(0, (int)(x), 0x111, 0xf, 0xf, true))
#pragma unroll
        for (int ct = 0; ct < 4; ++ct) {
            const int cl = ct * 16 + G * 4;
            const uint2 a_ = make_uint2(SHR1(rc[ct].x), SHR1(rc[ct].y)), b_ = make_uint2(SHR1(kc[ct].x), SHR1(kc[ct].y)), c_ = make_uint2(SHR1(vc[ct].x), SHR1(vc[ct].y));
            const f32x4 r_p = unpk4((tl != 0) ? a_ : rp[ct]), k_p = unpk4((tl != 0) ? b_ : kp_[ct]), v_p = unpk4((tl != 0) ? c_ : vp[ct]);
            const f32x4 r_t = unpk4(rc[ct]), k_t = unpk4(kc[ct]), v_t = unpk4(vc[ct]);
            const f32x4 mur = *(const f32x4*)(prm + cl), muk = *(const f32x4*)(prm + 64 + cl), muv = *(const f32x4*)(prm + 2 * 64 + cl);
            rc[ct] = pk4(r_t + (r_p - r_t) * mur); kc[ct] = pk4(k_t + (k_p - k_t) * muk); vc[ct] = pk4(v_t + (v_p - v_t) * muv);
        }
#undef SHR1
        float ss = 0.f, bo = 0.f;
#pragma unroll
        for (int ct = 0; ct < 4; ++ct) {
            const int cl = ct * 16 + G * 4;
            const f32x4 k_k = *(const f32x4*)(prm + 5 * 64 + cl);
            const f32x4 kr = unpk4(kc[ct]) * k_k;
            ss += kr[0] * kr[0] + kr[1] * kr[1] + kr[2] * kr[2] + kr[3] * kr[3];
        }
        ss += __shfl_xor(ss, 16); ss += __shfl_xor(ss, 32);
        const float inv = __builtin_amdgcn_rsqf(fmaxf(ss, 1e-24f));
        uint2 kkprev = make_uint2(0, 0), rrprev = kkprev;
        uint2 kkpk[4], rrpk[4]; uint4 bkpk[4];
#pragma unroll
        for (int ct = 0; ct < 4; ++ct) {
            const int cl = ct * 16 + G * 4, c0 = hh * 64 + cl;
            const f32x4 acc_w = acc[0][ct], acc_a = acc[1][ct], acc_g = acc[2][ct], acc_v = acc[3][ct];
            const uint2 rcs = rc[ct], kcs = kc[ct], vcs = vc[ct], vfs = vf[ct];
            const f32x4 w0 = *(const f32x4*)(prm + 3 * 64 + cl), a0 = *(const f32x4*)(prm + 4 * 64 + cl), k_k = *(const f32x4*)(prm + 5 * 64 + cl), k_a = *(const f32x4*)(prm + 6 * 64 + cl), r_k = *(const f32x4*)(prm + 7 * 64 + cl);
            const f32x4 rr = unpk4(rcs);
            const f32x4 kx = unpk4(kcs);
            f32x4 vx = unpk4(vcs);
            f32x4 aa, k2, ee;
#pragma unroll
            for (int q = 0; q < 4; ++q) {
                const float wv = w0[q] + acc_w[q];
                ee[q] = -0.6065306597126334f * sigmoidf_(wv);
                aa[q] = sigmoidf_(a0[q] + acc_a[q]);
            }
            if (l == 1) {
                const f32x4 vfv = unpk4(vfs); const f32x4 v0 = *(const f32x4*)(prm + 8 * 64 + cl);
#pragma unroll
                for (int q = 0; q < 4; ++q) vx[q] = vx[q] + (vfv[q] - vx[q]) * sigmoidf_(v0[q] + acc_v[q]);
            }
#pragma unroll
            for (int q = 0; q < 4; ++q) {
                k2[q] = kx[q] * (1.f + (aa[q] - 1.f) * k_a[q]);
                bo += rr[q] * k2[q] * r_k[q];
            }
            f32x4 cs;
#pragma unroll
            for (int q = 0; q < 4; ++q) {
                float x = ee[q];
                x += __builtin_bit_cast(float, __builtin_amdgcn_update_dpp(0, __builtin_bit_cast(int, x), 0x111, 0xf, 0xf, true));
                x += __builtin_bit_cast(float, __builtin_amdgcn_update_dpp(0, __builtin_bit_cast(int, x), 0x112, 0xf, 0xf, true));
                x += __builtin_bit_cast(float, __builtin_amdgcn_update_dpp(0, __builtin_bit_cast(int, x), 0x114, 0xf, 0xf, true));
                x += __builtin_bit_cast(float, __builtin_amdgcn_update_dpp(0, __builtin_bit_cast(int, x), 0x118, 0xf, 0xf, true));
                cs[q] = x;
            }
            *(uint2*)(vout + (size_t)tk * 512 + c0) = pk4(vx);
            *(uint2*)(gout + (size_t)tk * 512 + c0) = pk4(acc_g);
            const size_t ci = ((size_t)tk * 8 + hh) * 64 + cl;
            f32x4 pt, ipt, ptm1;
#pragma unroll
            for (int q = 0; q < 4; ++q) { pt[q] = fast_exp(cs[q]); ipt[q] = fast_rcp(pt[q]); ptm1[q] = fast_exp(cs[q] - ee[q]); }
            const f32x4 kk = kx * k_k * inv;
            const f32x4 nk = -kk * ptm1, rt = rr * pt;
            const uint2 kkq = pk4(nk), rrq = pk4(rt);
            if ((ct & 1) == 0) { kkprev = kkq; rrprev = rrq; }
            else {
                const size_t vi = ((size_t)tk * 8 + hh) * 64 + ((ct >> 1) * 4 + G) * 8;
                ((uint4*)KKo)[vi >> 3] = make_uint4(kkprev.x, kkprev.y, kkq.x, kkq.y);
                ((uint4*)RRo)[vi >> 3] = make_uint4(rrprev.x, rrprev.y, rrq.x, rrq.y);
            }
            const f32x4 bb = kk * aa * ipt, kq = k2 * ipt;
            kkpk[ct] = kkq; rrpk[ct] = rrq;
            {
                unsigned m0 = pk_bf16(bb[0], kq[0]), m1 = pk_bf16(bb[1], kq[1]), m2 = pk_bf16(bb[2], kq[2]), m3 = pk_bf16(bb[3], kq[3]);
                bkpk[ct] = make_uint4(m0, m1, m2, m3);
                const bool ev = (tl & 1) == 0, lo = (tl & 2) == 0;
                const unsigned r0 = (unsigned)__builtin_amdgcn_update_dpp(0, (int)(ev ? m1 : m0), 0xB1, 0xf, 0xf, false), r1 = (unsigned)__builtin_amdgcn_update_dpp(0, (int)(ev ? m3 : m2), 0xB1, 0xf, 0xf, false);
                const unsigned n0 = ev ? m0 : r0, n1 = ev ? r0 : m1, n2 = ev ? m2 : r1, n3 = ev ? r1 : m3;
                const unsigned s0 = (unsigned)__builtin_amdgcn_update_dpp(0, (int)(lo ? n2 : n0), 0x4E, 0xf, 0xf, false), s1 = (unsigned)__builtin_amdgcn_update_dpp(0, (int)(lo ? n3 : n1), 0x4E, 0xf, 0xf, false);
                const uint4 o = lo ? make_uint4(n0, n1, s0, s1) : make_uint4(s0, s1, n2, n3);
                *(uint4*)((char*)BKo + (((size_t)(tk >> 2) * 8 + hh) * 64 + cl + (tl & 3)) * 16) = o;
            }
            if (tl == 15) *(f32x4*)(PCo + (((size_t)(tk >> 4) * 8 + hh) * 64 + cl)) = pt;
        }
        bo += __shfl_xor(bo, 16); bo += __shfl_xor(bo, 32);
        if (G == 0) bonus[(size_t)tk * 8 + hh] = bo;
        float qA[4], qB[4], qC[4], qD[4];
#pragma unroll
        for (int i = 0; i < 4; ++i) { qA[i] = 0.f; qB[i] = 0.f; qC[i] = 0.f; qD[i] = 0.f; }
#pragma unroll
        for (int ct = 0; ct < 4; ++ct) {
            const f32x4 nk = unpk4(kkpk[ct]), rt = unpk4(rrpk[ct]);
            const unsigned pw[4] = {bkpk[ct].x, bkpk[ct].y, bkpk[ct].z, bkpk[ct].w};
#define QUAD_ACC(i, CTRL) _Pragma("unroll") for (int q = 0; q < 4; ++q) { const unsigned pi_ = (unsigned)__builtin_amdgcn_update_dpp(0, (int)pw[q], CTRL, 0xf, 0xf, false); \
                const float bi = bflo(pi_), ki = bfhi(pi_); qA[i] += nk[q] * bi; qB[i] += nk[q] * ki; qC[i] += rt[q] * bi; qD[i] += rt[q] * ki; }
            QUAD_ACC(0, 0x00) QUAD_ACC(1, 0x55) QUAD_ACC(2, 0xAA) QUAD_ACC(3, 0xFF)
#undef QUAD_ACC
        }
#pragma unroll
        for (int i = 0; i < 4; ++i) {
            qA[i] += __shfl_xor(qA[i], 16); qA[i] += __shfl_xor(qA[i], 32); qB[i] += __shfl_xor(qB[i], 16); qB[i] += __shfl_xor(qB[i], 32);
            qC[i] += __shfl_xor(qC[i], 16); qC[i] += __shfl_xor(qC[i], 32); qD[i] += __shfl_xor(qD[i], 16); qD[i] += __shfl_xor(qD[i], 32);
        }
        if (G == 0) {
            float* cf = (float*)(p.ws + OFF_COEF) + ((size_t)(tk >> 2) * 8 + hh) * 32;
            const int j = tl & 3;
#pragma unroll
            for (int i = 0; i < 4; ++i) {
                if (i < j) { cf[j * (j - 1) / 2 + i] = qA[i]; cf[6 + j * (j - 1) / 2 + i] = qB[i]; }
                if (i <= j) { cf[12 + j * (j + 1) / 2 + i] = qC[i]; cf[22 + j * (j + 1) / 2 + i] = qD[i]; }
            }
        }
    }
}

typedef int i32x4 __attribute__((ext_vector_type(4)));
constexpr int SC_QRB = 2720, SC_CHB = 4 * SC_QRB, SC_BKO = 1024, SC_VO = 2048, SC_CFO = 2560, SC_ZOFF = 2688;
__device__ __forceinline__ void scan_unit(const Params& p, int l, int bh, char* lds) {
    const int b = bh >> 3, hh = bh & 7;
    const int tid = tid_opaque();
    const int lane = tid & 63, wq = tid >> 6, g = lane >> 4, c = lane & 15;
    const unsigned tok0 = (unsigned)b * SEQ;
    const __amdgpu_buffer_rsrc_t rs = __builtin_amdgcn_make_buffer_rsrc((void*)p.ws, 0, 0x7fffffff, 0x00020000);
    const unsigned vo_y  = (unsigned)OFF_YRAW + (tok0 * 512 + hh * 64 + wq * 16 + c) * 2;
    const unsigned vo_pc = (unsigned)OFF_PC + ((tok0 >> 4) * 8 + hh) * 256 + g * 16;
    unsigned gvo[3], lvo[3], gst[3];
#pragma unroll
    for (int k = 0; k < 3; ++k) {
        const int q = tid + 256 * k; const int qd = q / 168, r = q - qd * 168;
        const unsigned tq = tok0 + 4 * qd;
        unsigned go, st;
        if (r < 32)       { go = (unsigned)OFF_KK + ((tq + (r >> 3)) * 8 + hh) * 128 + (r & 7) * 16; st = 16384u; }
        else if (r < 64)  { go = (unsigned)OFF_RR + ((tq + ((r - 32) >> 3)) * 8 + hh) * 128 + (r & 7) * 16; st = 16384u; }
        else if (r < 128) { go = (unsigned)OFF_BK + ((tq >> 2) * 8 + hh) * 1024 + (r - 64) * 16; st = 32768u; }
        else if (r < 160) { go = (unsigned)(OFF_V + (size_t)l * NTOK * 1024) + ((tq + ((r - 128) >> 3)) * 512 + hh * 64) * 2 + (r & 7) * 16; st = 16384u; }
        else              { go = (unsigned)OFF_COEF + ((tq >> 2) * 8 + hh) * 128 + (r - 160) * 16; st = 4096u; }
        gvo[k] = go; lvo[k] = qd * SC_QRB + r * 16; gst[k] = st;
    }
    const bool has3 = tid < 160;
#define SC_SOFF(k, ch) ((unsigned)(ch) * gst[k])
    i32x4 st0, st1, st2;
#define SC_GLOAD(ch) do { st0 = __builtin_amdgcn_raw_buffer_load_b128(rs, gvo[0] + SC_SOFF(0, ch), 0, 0); st1 = __builtin_amdgcn_raw_buffer_load_b128(rs, gvo[1] + SC_SOFF(1, ch), 0, 0); \
        if (has3) st2 = __builtin_amdgcn_raw_buffer_load_b128(rs, gvo[2] + SC_SOFF(2, ch), 0, 0); } while (0)
#define SC_LSTORE(ch) do { char* d_ = lds + ((ch) & 3) * SC_CHB; *(i32x4*)(d_ + lvo[0]) = st0; *(i32x4*)(d_ + lvo[1]) = st1; if (has3) *(i32x4*)(d_ + lvo[2]) = st2; } while (0)
    st2 = (i32x4){0, 0, 0, 0};
    if (tid < 32) { *(i32x4*)(lds + (tid >> 1) * SC_QRB + SC_ZOFF + (tid & 1) * 16) = (i32x4){0, 0, 0, 0}; }
    SC_GLOAD(0); SC_LSTORE(0); SC_GLOAD(1); SC_LSTORE(1); SC_GLOAD(2); SC_LSTORE(2);
    __syncthreads();
    f32x4 Z0 = (f32x4){0.f, 0.f, 0.f, 0.f}, Z1 = Z0, Z2 = Z0, Z3 = Z0;
    const f32x4 z4 = (f32x4){0.f, 0.f, 0.f, 0.f};
    const int ad0 = (c < 4) ? (c * 128 + g * 16) : SC_ZOFF;
    const int ad1 = (c < 4) ? ad0 + 64 : SC_ZOFF;
    const int adr = (c < 4) ? 512 : 0;
    const int au = (g == 0) ? (SC_BKO + c * 16) : SC_ZOFF;
    const int austep = (g == 0) ? 256 : 0;
    const int vofs = (g == 0) ? (SC_VO + (wq * 16 + c) * 2) : SC_ZOFF;
    const int vstep = (g == 0) ? 128 : 0;
    uint4 ua0, ua1, ua2, ua3, ub0, ub1, ub2, ub3, bu = make_uint4(0u, 0u, 0u, 0u);
    bf16x8 a0c, a1c, a0n, a1n, r0c, r1c, r0n, r1n; unsigned v0c, v1c, v2c, v3c, v0n, v1n, v2n, v3n;
#define SC_LDSOPS(tb_, A0, A1, R0, R1, U0, U1, U2, U3, V0, V1, V2, V3) do { A0 = *(const bf16x8*)((tb_) + ad0); A1 = *(const bf16x8*)((tb_) + ad1); \
        R0 = *(const bf16x8*)((tb_) + ad0 + adr); R1 = *(const bf16x8*)((tb_) + ad1 + adr); \
        U0 = *(const uint4*)((tb_) + au); U1 = *(const uint4*)((tb_) + au + austep); U2 = *(const uint4*)((tb_) + au + 2 * austep); U3 = *(const uint4*)((tb_) + au + 3 * austep); \
        V0 = *(const u16*)((tb_) + vofs); V1 = *(const u16*)((tb_) + vofs + vstep); V2 = *(const u16*)((tb_) + vofs + 2 * vstep); V3 = *(const u16*)((tb_) + vofs + 3 * vstep); } while (0)
#define SC_STEP(tb_cur_, tb_next_, A0, A1, R0, R1, U0, U1, U2, U3, V0, V1, V2, V3, NA0, NA1, NR0, NR1, NU0, NU1, NU2, NU3, NV0, NV1, NV2, NV3, last_) do { \
        const f32x4 cf0_ = *(const f32x4*)((tb_cur_) + SC_CFO), cf1_ = *(const f32x4*)((tb_cur_) + SC_CFO + 16), cf2_ = *(const f32x4*)((tb_cur_) + SC_CFO + 32), cf3_ = *(const f32x4*)((tb_cur_) + SC_CFO + 48); \
        const f32x4 cf4_ = *(const f32x4*)((tb_cur_) + SC_CFO + 64), cf5_ = *(const f32x4*)((tb_cur_) + SC_CFO + 80), cf6_ = *(const f32x4*)((tb_cur_) + SC_CFO + 96), cf7_ = *(const f32x4*)((tb_cur_) + SC_CFO + 112); \
        SC_LDSOPS(tb_next_, NA0, NA1, NR0, NR1, NU0, NU1, NU2, NU3, NV0, NV1, NV2, NV3); \
        const bf16x8 sb0_ = mk8(make_uint4(pk_bf16(Z0[0], Z0[1]), pk_bf16(Z0[2], Z0[3]), pk_bf16(Z1[0], Z1[1]), pk_bf16(Z1[2], Z1[3]))); \
        const bf16x8 sb1_ = mk8(make_uint4(pk_bf16(Z2[0], Z2[1]), pk_bf16(Z2[2], Z2[3]), pk_bf16(Z3[0], Z3[1]), pk_bf16(Z3[2], Z3[3]))); \
        f32x4 d_ = MFMA16(A0, sb0_, z4); d_ = MFMA16(A1, sb1_, d_);            \
        f32x4 dy_ = MFMA16(R0, sb0_, z4); dy_ = MFMA16(R1, sb1_, dy_);        \
        const float w0_ = __uint_as_float(V0 << 16), w1_ = __uint_as_float(V1 << 16), w2_ = __uint_as_float(V2 << 16), w3_ = __uint_as_float(V3 << 16); \
          \
        const float b1_ = cf1_[2] * w0_, b2_ = cf1_[3] * w0_ + cf2_[0] * w1_, b3_ = cf2_[1] * w0_ + cf2_[2] * w1_ + cf2_[3] * w2_; \
        const float sa0_ = d_[0]; \
        const float sa1_ = (d_[1] + b1_) + cf0_[0] * sa0_; \
        const float sa2_ = (d_[2] + b2_) + cf0_[1] * sa0_ + cf0_[2] * sa1_; \
        const float sa3_ = (d_[3] + b3_) + cf0_[3] * sa0_ + cf1_[0] * sa1_ + cf1_[1] * sa2_; \
        bu.x = (g == 0) ? pk_bf16(sa0_, w0_) : 0u; bu.y = (g == 0) ? pk_bf16(sa1_, w1_) : 0u; bu.z = (g == 0) ? pk_bf16(sa2_, w2_) : 0u; bu.w = (g == 0) ? pk_bf16(sa3_, w3_) : 0u; \
        Z0 = MFMA16(mk8(U0), mk8(bu), Z0); Z1 = MFMA16(mk8(U1), mk8(bu), Z1); Z2 = MFMA16(mk8(U2), mk8(bu), Z2); Z3 = MFMA16(mk8(U3), mk8(bu), Z3); \
        { float y0_ = __builtin_fmaf(cf3_[0], sa0_, __builtin_fmaf(cf5_[2], w0_, dy_[0])); \
          float y1_ = __builtin_fmaf(cf3_[2], sa1_, __builtin_fmaf(cf3_[1], sa0_, __builtin_fmaf(cf6_[0], w1_, __builtin_fmaf(cf5_[3], w0_, dy_[1])))); \
          float y2_ = __builtin_fmaf(cf4_[1], sa2_, __builtin_fmaf(cf4_[0], sa1_, __builtin_fmaf(cf3_[3], sa0_, __builtin_fmaf(cf6_[3], w2_, __builtin_fmaf(cf6_[2], w1_, __builtin_fmaf(cf6_[1], w0_, dy_[2])))))); \
          float y3_ = __builtin_fmaf(cf5_[1], sa3_, __builtin_fmaf(cf5_[0], sa2_, __builtin_fmaf(cf4_[3], sa1_, __builtin_fmaf(cf4_[2], sa0_, __builtin_fmaf(cf7_[3], w3_, __builtin_fmaf(cf7_[2], w2_, __builtin_fmaf(cf7_[1], w1_, __builtin_fmaf(cf7_[0], w0_, dy_[3])))))))); \
          asm volatile("" : "+v"(y0_), "+v"(y1_), "+v"(y2_), "+v"(y3_));        \
          if (g == 0) { __builtin_amdgcn_raw_buffer_store_b16((u16)(pk_bf16(y0_, 0.f) & 0xffffu), rs, vo_y, (unsigned)(tcur) * 1024u, 0); \
                        __builtin_amdgcn_raw_buffer_store_b16((u16)(pk_bf16(y1_, 0.f) & 0xffffu), rs, vo_y, (unsigned)(tcur + 1) * 1024u, 0); \
                        __builtin_amdgcn_raw_buffer_store_b16((u16)(pk_bf16(y2_, 0.f) & 0xffffu), rs, vo_y, (unsigned)(tcur + 2) * 1024u, 0); \
                        __builtin_amdgcn_raw_buffer_store_b16((u16)(pk_bf16(y3_, 0.f) & 0xffffu), rs, vo_y, (unsigned)(tcur + 3) * 1024u, 0); } } \
        if (last_) { Z0 = Z0 * pc0; Z1 = Z1 * pc1; Z2 = Z2 * pc2; Z3 = Z3 * pc3; } \
        tcur += 4; } while (0)
    int tcur = 0;
    SC_LDSOPS(lds, a0c, a1c, r0c, r1c, ua0, ua1, ua2, ua3, v0c, v1c, v2c, v3c);
#pragma unroll 1
    for (int ch = 0; ch < SEQ / 16; ++ch) {
        if (ch + 3 < SEQ / 16) SC_GLOAD(ch + 3);
        const f32x4 pc0 = __builtin_bit_cast(f32x4, __builtin_amdgcn_raw_buffer_load_b128(rs, vo_pc, (unsigned)ch * 2048u, 0));
        const f32x4 pc1 = __builtin_bit_cast(f32x4, __builtin_amdgcn_raw_buffer_load_b128(rs, vo_pc + 64, (unsigned)ch * 2048u, 0));
        const f32x4 pc2 = __builtin_bit_cast(f32x4, __builtin_amdgcn_raw_buffer_load_b128(rs, vo_pc + 128, (unsigned)ch * 2048u, 0));
        const f32x4 pc3 = __builtin_bit_cast(f32x4, __builtin_amdgcn_raw_buffer_load_b128(rs, vo_pc + 192, (unsigned)ch * 2048u, 0));
        const char* cb = lds + (ch & 3) * SC_CHB;
        const char* nb = lds + ((ch + 1) & 3) * SC_CHB;
        SC_STEP(cb, cb + SC_QRB, a0c, a1c, r0c, r1c, ua0, ua1, ua2, ua3, v0c, v1c, v2c, v3c, a0n, a1n, r0n, r1n, ub0, ub1, ub2, ub3, v0n, v1n, v2n, v3n, false);
        SC_STEP(cb + SC_QRB, cb + 2 * SC_QRB, a0n, a1n, r0n, r1n, ub0, ub1, ub2, ub3, v0n, v1n, v2n, v3n, a0c, a1c, r0c, r1c, ua0, ua1, ua2, ua3, v0c, v1c, v2c, v3c, false);
        SC_STEP(cb + 2 * SC_QRB, cb + 3 * SC_QRB, a0c, a1c, r0c, r1c, ua0, ua1, ua2, ua3, v0c, v1c, v2c, v3c, a0n, a1n, r0n, r1n, ub0, ub1, ub2, ub3, v0n, v1n, v2n, v3n, false);
        SC_STEP(cb + 3 * SC_QRB, nb, a0n, a1n, r0n, r1n, ub0, ub1, ub2, ub3, v0n, v1n, v2n, v3n, a0c, a1c, r0c, r1c, ua0, ua1, ua2, ua3, v0c, v1c, v2c, v3c, true);
        if (ch + 3 < SEQ / 16) SC_LSTORE(ch + 3);
        __syncthreads();
    }
#undef SC_STEP
#undef SC_LDSOPS
#undef SC_GLOAD
#undef SC_LSTORE
#undef SC_SOFF
}

template <bool DRY>
__device__ void mixa_unit(const Params& p, int l, int u, char* lds) {
    const int g = u & 3, bc = u >> 2;
    const int tok0 = bc * 128;
    const int tid = tid_opaque();
    const int lane = tid & 63, w = tid >> 6, fr = lane & 15, G = lane >> 4;
    u16* proja = (u16*)(p.ws + OFF_R + R_PROJA);
    char* ldsV = lds; char* ldsW = lds + 32768; float2* stats = (float2*)(lds + 65536);
    uint4 wq[8];
    { const u16* wsa = (const u16*)(p.ws + OFF_WSA) + ((size_t)l * 4 + g) * 128 * 128;
#pragma unroll
      for (int i = 0; i < 8; ++i) { const int q = tid + 256 * i; wq[i] = *(const uint4*)(wsa + (size_t)q * 8); } }
#pragma unroll 1
    for (int r = 0; r < 32; r += 16) {
        uint4 xq[16];
#pragma unroll
        for (int rr = 0; rr < 16; ++rr) xq[rr] = *(const uint4*)(proja + (size_t)(tok0 + w * 32 + r + rr) * 1024 + 512 + lane * 8);
#pragma unroll
        for (int rr = 0; rr < 16; ++rr) {
            const unsigned xv[4] = {xq[rr].x, xq[rr].y, xq[rr].z, xq[rr].w};
            float s_ = 0.f, q_ = 0.f;
#pragma unroll
            for (int i = 0; i < 4; ++i) { const float a = bflo(xv[i]), b2 = bfhi(xv[i]); s_ += a + b2; q_ += a * a + b2 * b2; }
            s_ = rowsum16(s_); q_ = rowsum16(q_);
            s_ += __shfl_xor(s_, 16); q_ += __shfl_xor(q_, 16); s_ += __shfl_xor(s_, 32); q_ += __shfl_xor(q_, 32);
            const float mu = s_ * (1.f / 512.f); const float var = fmaxf(q_ * (1.f / 512.f) - mu * mu, 0.f);
            if (lane == 0) stats[w * 32 + r + rr] = make_float2(mu, rsqrtf(var + 1e-5f));
        }
    }
#pragma unroll
    for (int i = 0; i < 8; ++i) { const int q = tid + 256 * i, row = q >> 4, ch = q & 15; *(uint4*)(ldsW + row * 256 + ((ch ^ (row & 15)) << 4)) = wq[i]; }
    __syncthreads();
    const float* lng = (const float*)p.in[4] + (size_t)l * 512 + g * 128;
    const float* lnb = (const float*)p.in[5] + (size_t)l * 512 + g * 128;
#pragma unroll
    for (int i = 0; i < 8; ++i) {
        const int q = tid + 256 * i, row = q >> 4, ch = q & 15;
        const uint4 x = *(const uint4*)(proja + (size_t)(tok0 + row) * 1024 + 512 + g * 128 + ch * 8);
        const float2 st = stats[row];
        const f32x4 g0 = *(const f32x4*)(lng + ch * 8), g1 = *(const f32x4*)(lng + ch * 8 + 4), b0 = *(const f32x4*)(lnb + ch * 8), b1 = *(const f32x4*)(lnb + ch * 8 + 4);
        const unsigned xv[4] = {x.x, x.y, x.z, x.w}; unsigned o[4];
#pragma unroll
        for (int k = 0; k < 4; ++k) {
            const float ga = (k < 2) ? g0[2 * k] : g1[2 * k - 4], gb = (k < 2) ? g0[2 * k + 1] : g1[2 * k - 3];
            const float ba = (k < 2) ? b0[2 * k] : b1[2 * k - 4], bb = (k < 2) ? b0[2 * k + 1] : b1[2 * k - 3];
            o[k] = pk_bf16((bflo(xv[k]) - st.x) * st.y * ga + ba, (bfhi(xv[k]) - st.x) * st.y * gb + bb);
        }
        const int f = (row & 3) | (((row >> 3) & 1) << 2);
        *(uint4*)(ldsV + row * 256 + (((ch >> 1) ^ f) << 5) + ((ch & 1) << 4)) = make_uint4(o[0], o[1], o[2], o[3]);
    }
    __syncthreads();
    uint2 uq[2][8];
#pragma unroll
    for (int t2 = 0; t2 < 2; ++t2)
#pragma unroll
        for (int ct = 0; ct < 8; ++ct) uq[t2][ct] = *(const uint2*)(proja + (size_t)(tok0 + w * 32 + t2 * 16 + fr) * 1024 + g * 128 + ct * 16 + G * 4);
    f32x4 acc[2][8];
#pragma unroll
    for (int a = 0; a < 2; ++a)
#pragma unroll
        for (int b = 0; b < 8; ++b) acc[a][b] = (f32x4){0.f, 0.f, 0.f, 0.f};
    const int qrow = (lane & 15) >> 2, pcol = lane & 3;
    for (int ss = 0; ss <= w; ++ss) {
        bf16x8 bw[2];
#pragma unroll
        for (int t2 = 0; t2 < 2; ++t2) { const int t = w * 32 + t2 * 16 + fr; bw[t2] = *(const bf16x8*)(ldsW + t * 256 + (((ss * 4 + G) ^ (t & 15)) << 4)); }
#pragma unroll
        for (int ct = 0; ct < 8; ++ct) {
            const int ra = ss * 32 + 8 * G + qrow, rb2 = ra + 4;
            const int fa = (ra & 3) | (((ra >> 3) & 1) << 2), fb = (rb2 & 3) | (((rb2 >> 3) & 1) << 2);
            const v4i16_t lo = __builtin_amdgcn_ds_read_tr16_b64_v4i16((LAS v4i16_t*)(ldsV + ra * 256 + ((ct ^ fa) << 5) + pcol * 8));
            const v4i16_t hi = __builtin_amdgcn_ds_read_tr16_b64_v4i16((LAS v4i16_t*)(ldsV + rb2 * 256 + ((ct ^ fb) << 5) + pcol * 8));
            bf16x8 af; af[0] = lo[0]; af[1] = lo[1]; af[2] = lo[2]; af[3] = lo[3]; af[4] = hi[0]; af[5] = hi[1]; af[6] = hi[2]; af[7] = hi[3];
            acc[0][ct] = MFMA16(af, bw[0], acc[0][ct]);
            acc[1][ct] = MFMA16(af, bw[1], acc[1][ct]);
        }
    }
    const float* bs = (const float*)p.in[7] + ((size_t)l * 4 + g) * 128;
#pragma unroll
    for (int t2 = 0; t2 < 2; ++t2) {
        const int t = w * 32 + t2 * 16 + fr; const float bias = bs[t];
#pragma unroll
        for (int ct = 0; ct < 8; ++ct) {
            u16* pu = proja + (size_t)(tok0 + t) * 1024 + g * 128 + ct * 16 + G * 4;
            const f32x4 uu = unpk4(uq[t2][ct]);
            f32x4 y;
#pragma unroll
            for (int q = 0; q < 4; ++q) y[q] = uu[q] * (acc[t2][ct][q] + bias);
            if (!DRY) *(uint2*)pu = pk4(y); else asm volatile("" :: "v"(y[0] + y[1] + y[2] + y[3]));
        }
    }
    __syncthreads();
}

template <bool DRY>
__device__ void attn_unit(const Params& p, int u, char* lds) {
    const int hq = u & 3, combo = (u >> 2) % 48, b = (u >> 2) / 48;
    int g, r, n, dil;
    if (combo < 16) { g = 0; r = 0; n = combo; dil = 1; } else if (combo < 32) { g = 1; r = (combo - 16) >> 2; n = (combo - 16) & 3; dil = 4; } else { g = 2; r = combo - 32; n = 0; dil = 16; }
    const int head = g * 4 + hq;
    const int tid = tid_opaque();
    const int lane = tid & 63, w = tid >> 6, fr = lane & 15, G = lane >> 4;
    u16* projb = (u16*)(p.ws + OFF_R + R_PROJB);
    char* ldsK = lds; char* ldsV = lds + 32768;
    const size_t tokb = (size_t)b * SEQ + r;
#pragma unroll
    for (int i = 0; i < 8; ++i) {
        const int q = tid + 256 * i, row = q >> 3, ch = q & 7;
        const int idx = (n - 1) * 128 + row;
        uint4 kx = make_uint4(0, 0, 0, 0), vx = kx;
        if (idx >= 0) {
            const u16* src = projb + (tokb + (size_t)idx * dil) * 2304 + head * 64 + ch * 8;
            kx = *(const uint4*)(src + 768); vx = *(const uint4*)(src + 1536);
        }
        *(uint4*)(ldsK + toff(row, ch)) = kx;
        *(uint4*)(ldsV + row * 128 + (((ch >> 1) ^ ((row >> 1) & 3)) << 5) + ((ch & 1) << 4)) = vx;
    }
    bf16x8 qf[2][2]; size_t qtok[2];
#pragma unroll
    for (int qt = 0; qt < 2; ++qt) {
        qtok[qt] = tokb + (size_t)(n * 128 + w * 32 + qt * 16 + fr) * dil;
#pragma unroll
        for (int s = 0; s < 2; ++s) qf[qt][s] = mk8(*(const uint4*)(projb + qtok[qt] * 2304 + head * 64 + s * 32 + 8 * G));
    }
    __syncthreads();
    f32x4 sc[2][10];
#pragma unroll
    for (int qt = 0; qt < 2; ++qt)
#pragma unroll
        for (int uu = 0; uu < 10; ++uu) sc[qt][uu] = (f32x4){0.f, 0.f, 0.f, 0.f};
#pragma unroll
    for (int uu = 0; uu < 10; ++uu)
#pragma unroll
        for (int s = 0; s < 2; ++s) {
            const bf16x8 kf = *(const bf16x8*)(ldsK + toff((2 * w + uu) * 16 + fr, s * 4 + G));
            sc[0][uu] = MFMA16(kf, qf[0][s], sc[0][uu]);
            sc[1][uu] = MFMA16(kf, qf[1][s], sc[1][uu]);
        }
    float mx[2], sm[2];
#pragma unroll
    for (int qt = 0; qt < 2; ++qt) {
        const int qi = w * 32 + qt * 16 + fr;
        float m = -1e30f;
#pragma unroll
        for (int uu = 0; uu < 10; ++uu)
#pragma unroll
            for (int q = 0; q < 4; ++q) {
                const int kj = (2 * w + uu) * 16 + G * 4 + q;
                const bool valid = (kj >= qi) && (kj <= qi + 128) && (n > 0 || kj >= 128);
                const float v = valid ? sc[qt][uu][q] : -1e30f;
                sc[qt][uu][q] = v; m = fmaxf(m, v);
            }
        m = fmaxf(m, __shfl_xor(m, 16)); m = fmaxf(m, __shfl_xor(m, 32));
        float s = 0.f;
#pragma unroll
        for (int uu = 0; uu < 10; ++uu)
#pragma unroll
            for (int q = 0; q < 4; ++q) { const float e = fast_exp(sc[qt][uu][q] - m); sc[qt][uu][q] = e; s += e; }
        s += __shfl_xor(s, 16); s += __shfl_xor(s, 32);
        mx[qt] = m; sm[qt] = s;
    }
    f32x4 oc[2][4];
#pragma unroll
    for (int qt = 0; qt < 2; ++qt)
#pragma unroll
        for (int dt = 0; dt < 4; ++dt) oc[qt][dt] = (f32x4){0.f, 0.f, 0.f, 0.f};
    const int qrow = (lane & 15) >> 2, pcol = lane & 3;
#pragma unroll
    for (int ks = 0; ks < 5; ++ks) {
        bf16x8 pf[2];
#pragma unroll
        for (int qt = 0; qt < 2; ++qt)
            pf[qt] = mk8(make_uint4(pk_bf16(sc[qt][2 * ks][0], sc[qt][2 * ks][1]), pk_bf16(sc[qt][2 * ks][2], sc[qt][2 * ks][3]),
                                    pk_bf16(sc[qt][2 * ks + 1][0], sc[qt][2 * ks + 1][1]), pk_bf16(sc[qt][2 * ks + 1][2], sc[qt][2 * ks + 1][3])));
        const int ra = (2 * w + 2 * ks) * 16 + 4 * G + qrow, rb2 = ra + 16;
#pragma unroll
        for (int dt = 0; dt < 4; ++dt) {
            const v4i16_t lo = __builtin_amdgcn_ds_read_tr16_b64_v4i16((LAS v4i16_t*)(ldsV + ra * 128 + ((dt ^ ((ra >> 1) & 3)) << 5) + pcol * 8));
            const v4i16_t hi = __builtin_amdgcn_ds_read_tr16_b64_v4i16((LAS v4i16_t*)(ldsV + rb2 * 128 + ((dt ^ ((rb2 >> 1) & 3)) << 5) + pcol * 8));
            bf16x8 vf; vf[0] = lo[0]; vf[1] = lo[1]; vf[2] = lo[2]; vf[3] = lo[3]; vf[4] = hi[0]; vf[5] = hi[1]; vf[6] = hi[2]; vf[7] = hi[3];
            oc[0][dt] = MFMA16(vf, pf[0], oc[0][dt]);
            oc[1][dt] = MFMA16(vf, pf[1], oc[1][dt]);
        }
    }
    float* lse = (float*)(p.ws + OFF_LSE);
#pragma unroll
    for (int qt = 0; qt < 2; ++qt) {
        const float inv = fast_rcp(sm[qt]);
#pragma unroll
        for (int dt = 0; dt < 4; ++dt) { if (!DRY) *(uint2*)(projb + qtok[qt] * 2304 + head * 64 + dt * 16 + G * 4) = pk4(oc[qt][dt] * inv); else asm volatile("" :: "v"(oc[qt][dt][0] + oc[qt][dt][1] + oc[qt][dt][2] + oc[qt][dt][3])); }
        if (G == 0 && !DRY) lse[((size_t)g * NTOK + qtok[qt]) * 4 + hq] = mx[qt] + __logf(sm[qt]);
    }
    __syncthreads();
}

template <bool DRY>
__device__ void phase_post_yc(const Params& p, int l) {
    const int tid_ = tid_opaque();
    const int lane = tid_ & 63, j = lane & 15;
    const int gw = blockIdx.x * 4 + (tid_ >> 6), nw = gridDim.x * 4;
    const u16* yraw = (const u16*)(p.ws + OFF_YRAW); u16* gy = (u16*)(p.ws + OFF_G);
    const u16* vv = (const u16*)(p.ws + OFF_V + (size_t)l * NTOK * 1024);
    const float* bonus = (const float*)(p.ws + OFF_BONUS);
    const float* lnw = (const float*)p.in[21] + (size_t)l * 512; const float* lnb = (const float*)p.in[22] + (size_t)l * 512;
    for (int it0 = gw; it0 < NTOK * 8 / 4; it0 += 8 * nw) {
        uint2 yq[8], vq[8], gq[8]; float bq[8]; size_t offq[8]; int hq[8];
#pragma unroll
        for (int k = 0; k < 8; ++k) {
            const int it = min(it0 + k * nw, NTOK * 8 / 4 - 1);
            const int pr = it * 4 + (lane >> 4);
            const int tok = pr >> 3, hh = pr & 7;
            offq[k] = (size_t)tok * 512 + hh * 64 + j * 4; hq[k] = hh;
            yq[k] = *(const uint2*)(yraw + offq[k]); vq[k] = *(const uint2*)(vv + offq[k]); gq[k] = *(const uint2*)(gy + offq[k]); bq[k] = bonus[pr];
        }
#pragma unroll
        for (int k = 0; k < 8; ++k) {
            const f32x4 y = unpk4(yq[k]);
            const float mu = rowsum16(y[0] + y[1] + y[2] + y[3]) * (1.f / 64.f);
            const f32x4 d = y - mu;
            const float var = rowsum16(d[0] * d[0] + d[1] * d[1] + d[2] * d[2] + d[3] * d[3]) * (1.f / 64.f);
            const float rstd = rsqrtf(var + 64e-5f);
            const f32x4 w4 = *(const f32x4*)(lnw + hq[k] * 64 + j * 4), b4 = *(const f32x4*)(lnb + hq[k] * 64 + j * 4);
            const f32x4 v4 = unpk4(vq[k]), g4 = unpk4(gq[k]);
            f32x4 o;
#pragma unroll
            for (int q = 0; q < 4; ++q) o[q] = (d[q] * rstd * w4[q] + b4[q] + bq[k] * v4[q]) * g4[q];
            if (it0 + k * nw < NTOK * 8 / 4) { if (!DRY) *(uint2*)(gy + offq[k]) = pk4(o); else asm volatile("" :: "v"(o[0] + o[1] + o[2] + o[3])); }
        }
    }
}
template <bool DRY>
__device__ void phase_post(const Params& p, int l) {
    const int tid_ = tid_opaque();
    const int lane = tid_ & 63, j = lane & 15;
    const int gw = blockIdx.x * 4 + (tid_ >> 6), nw = gridDim.x * 4;
    u16* projb = (u16*)(p.ws + OFF_R + R_PROJB); const float* lse = (const float*)(p.ws + OFF_LSE);
#pragma unroll 1
    for (int it0 = gw; it0 < NTOK * 4 / 4; it0 += 8 * nw) {
        float lq[8][3]; uint2 oq[8][3]; size_t tq[8];
#pragma unroll
        for (int k = 0; k < 8; ++k) {
            const int it = min(it0 + k * nw, NTOK * 4 / 4 - 1);
            const int pr = it * 4 + (lane >> 4);
            const int tok = pr >> 2, hq = pr & 3;
            tq[k] = (size_t)tok * 2304 + hq * 64 + j * 4;
#pragma unroll
            for (int gq = 0; gq < 3; ++gq) { lq[k][gq] = lse[((size_t)gq * NTOK + tok) * 4 + hq]; oq[k][gq] = *(const uint2*)(projb + tq[k] + gq * 256); }
        }
#pragma unroll
        for (int k = 0; k < 8; ++k) {
            const float m = fmaxf(lq[k][0], fmaxf(lq[k][1], lq[k][2]));
            const float e0 = fast_exp(lq[k][0] - m), e1 = fast_exp(lq[k][1] - m), e2 = fast_exp(lq[k][2] - m); const float inv = fast_rcp(e0 + e1 + e2);
            const f32x4 o = (unpk4(oq[k][0]) * e0 + unpk4(oq[k][1]) * e1 + unpk4(oq[k][2]) * e2) * inv;
            if (it0 + k * nw < NTOK * 4 / 4) { if (!DRY) *(uint2*)(projb + tq[k] + 768) = pk4(o); else asm volatile("" :: "v"(o[0] + o[1] + o[2] + o[3])); }
        }
    }
    const uint4* hsrc = (const uint4*)(p.ws + OFF_H); uint2* h8 = (uint2*)(p.ws + OFF_YRAW);
    const int nth = gridDim.x * 256;
    for (int i0 = blockIdx.x * 256 + tid_; i0 < NTOK * 1024 / 8; i0 += 8 * nth) {
        uint4 hv[8];
#pragma unroll
        for (int k = 0; k < 8; ++k) hv[k] = hsrc[min(i0 + k * nth, NTOK * 1024 / 8 - 1)];
#pragma unroll
        for (int k = 0; k < 8; ++k) {
            const uint2 o8 = make_uint2(pk_fp8x4(bflo(hv[k].x), bfhi(hv[k].x), bflo(hv[k].y), bfhi(hv[k].y)), pk_fp8x4(bflo(hv[k].z), bfhi(hv[k].z), bflo(hv[k].w), bfhi(hv[k].w)));
            if (i0 + k * nth < NTOK * 1024 / 8) { if (!DRY) h8[i0 + k * nth] = o8; else asm volatile("" :: "v"(o8.x + o8.y)); }
        }
    }
}

__device__ void merge_unit(const Params& p, int l, int u, char* lds) {
    const int mt = u >> 3, nt = u & 7;
    const int tid = tid_opaque();
    const int lane = tid & 63, w = tid >> 6, wm = w >> 1, wn = w & 1, fr = lane & 15, fg = lane >> 4;
    const char* wne = p.ws + OFF_WNE + (size_t)l * WNE_SZ;
    const float* bgate = (const float*)p.in[31] + (size_t)l * 3072;
    u16* merged = (u16*)(p.ws + OFF_MERGED);
    uint2 tot[4][4];
#pragma unroll
    for (int i = 0; i < 4; ++i)
#pragma unroll
        for (int j = 0; j < 4; ++j) tot[i][j] = make_uint2(0u, 0u);
#pragma unroll 1
    for (int br = 0; br < 3; ++br) {
        const u16* ya; int lda, K; const u16* wb;
        if (br == 0) { ya = (const u16*)(p.ws + OFF_R + R_PROJA); lda = 1024; K = 512; wb = (const u16*)(wne + WNE_WBRA); }
        else if (br == 1) { ya = (const u16*)(p.ws + OFF_R + R_PROJB) + 768; lda = 2304; K = 256; wb = (const u16*)(wne + WNE_WBRB); }
        else { ya = (const u16*)(p.ws + OFF_G); lda = 512; K = 512; wb = (const u16*)(wne + WNE_WBRC); }
        f32x4 accg[4][4]; acc_zero<4, 4>(accg); uint2 yb[4][4];
#pragma unroll
        for (int i = 0; i < 4; ++i)
#pragma unroll
            for (int j = 0; j < 4; ++j) yb[i][j] = make_uint2(0u, 0u);
        gemm_kloop2(accg, yb, ya + (size_t)mt * 128 * lda, lda, wb + (size_t)nt * 128 * K, K, K / 64,
                    (const u16*)(p.ws + OFF_YRAW) + (size_t)mt * 128 * 512, 512, (const u16*)(wne + WNE_WGATE) + (size_t)(br * 1024 + nt * 128) * 512, 512, 8, lds, tid);
#pragma unroll
        for (int i = 0; i < 4; ++i)
#pragma unroll
            for (int j = 0; j < 4; ++j) {
                const int m = mt * 128 + wm * 64 + i * 16 + fr, n = nt * 128 + wn * 64 + j * 16 + fg * 4;
                const f32x4 bg = *(const f32x4*)(bgate + br * 1024 + n);
                f32x4 tv = unpk4(tot[i][j]);
                const f32x4 yv = unpk4(yb[i][j]);
#pragma unroll
                for (int q = 0; q < 4; ++q) tv[q] += sigmoidf_(accg[i][j][q] * (1.f / GATE_WSCALE) + bg[q]) * yv[q];
                tot[i][j] = pk4(tv);
                if (br == 2) *(uint2*)(merged + (size_t)m * 1024 + n) = tot[i][j];
            }
    }
}

__device__ void outproj_unit(const Params& p, int l, int u, char* lds) {
    const int mt = u >> 3, nt = u & 7;
    const int tid = tid_opaque();
    const int lane = tid & 63, w = tid >> 6, wm = w >> 1, wn = w & 1, fr = lane & 15, fg = lane >> 4;
    RowLoader al((const u16*)(p.ws + OFF_MERGED) + (size_t)mt * 128 * 1024, 1024, tid);
    RowLoader bl((const u16*)(p.ws + OFF_WNE + (size_t)l * WNE_SZ + WNE_WOUT) + (size_t)nt * 128 * 1024, 1024, tid);
    f32x4 acc[4][4]; acc_zero<4, 4>(acc);
    gemm_kloop<4, 4>(acc, al, bl, 16, lds, tid);
    const float* xin = (l == 0) ? (const float*)p.in[0] : p.out;
#pragma unroll
    for (int i = 0; i < 4; ++i)
#pragma unroll
        for (int j = 0; j < 4; ++j) {
            const int m = mt * 128 + wm * 64 + i * 16 + fr, n = nt * 128 + wn * 64 + j * 16 + fg * 4;
            const f32x4 xo = *(const f32x4*)(xin + (size_t)m * 1024 + n);
            *(f32x4*)(p.out + (size_t)m * 1024 + n) = xo + acc[i][j];
        }
}

template <bool DRY>
__device__ void router_unit(const Params& p, int l, int u, char* lds) {
    const int tid = tid_opaque();
    const int lane = tid & 63, w = tid >> 6, fr = lane & 15, fg = lane >> 4;
    const int tok0 = u * 32;
    const float* g = (const float*)p.in[33] + (size_t)l * 1024;
    const u16* wr = (const u16*)(p.ws + OFF_WNE + (size_t)l * WNE_SZ + WNE_WR);
    uint4 bq[2][8];
#pragma unroll
    for (int j = 0; j < 2; ++j)
#pragma unroll
        for (int ks = 0; ks < 8; ++ks) bq[j][ks] = *(const uint4*)(wr + (size_t)(j * 16 + fr) * 1024 + w * 256 + ks * 32 + fg * 8);
    float4 gg[4];
#pragma unroll
    for (int i = 0; i < 4; ++i) gg[i] = ((const float4*)g)[lane + 64 * i];
#pragma unroll
    for (int h = 0; h < 2; ++h) {
        float4 v[4][4]; float ss[4];
#pragma unroll
        for (int rr = 0; rr < 4; ++rr) {
            const float4* xr = (const float4*)(p.out + (size_t)(tok0 + w * 8 + h * 4 + rr) * 1024);
#pragma unroll
            for (int i = 0; i < 4; ++i) v[rr][i] = xr[lane + 64 * i];
        }
#pragma unroll
        for (int rr = 0; rr < 4; ++rr) {
            float s_ = 0.f;
#pragma unroll
            for (int i = 0; i < 4; ++i) s_ += v[rr][i].x * v[rr][i].x + v[rr][i].y * v[rr][i].y + v[rr][i].z * v[rr][i].z + v[rr][i].w * v[rr][i].w;
            ss[rr] = wavesum(s_);
        }
#pragma unroll
        for (int rr = 0; rr < 4; ++rr) {
            const int rl = w * 8 + h * 4 + rr, row = tok0 + rl;
            const float rinv = rsqrtf(ss[rr] * (1.f / 1024.f) + 1e-6f);
#pragma unroll
            for (int i = 0; i < 4; ++i) {
                const uint2 pk = make_uint2(pk_bf16(v[rr][i].x * rinv * gg[i].x, v[rr][i].y * rinv * gg[i].y), pk_bf16(v[rr][i].z * rinv * gg[i].z, v[rr][i].w * rinv * gg[i].w));
                ((unsigned*)(p.ws + OFF_H + (size_t)row * 1024))[lane + 64 * i] = pk_fp8x4(v[rr][i].x * rinv * gg[i].x, v[rr][i].y * rinv * gg[i].y, v[rr][i].z * rinv * gg[i].z, v[rr][i].w * rinv * gg[i].w);
                const int c = (lane + 64 * i) >> 1;
                *(uint2*)(lds + rl * 2048 + ((c ^ (rl & 15)) << 4) + (lane & 1) * 8) = pk;
            }
        }
    }
    __syncthreads();
    f32x4 acc[2][2]; acc_zero<2, 2>(acc);
#pragma unroll
    for (int ks = 0; ks < 8; ++ks) {
        bf16x8 af[2];
#pragma unroll
        for (int i = 0; i < 2; ++i) af[i] = *(const bf16x8*)(lds + (i * 16 + fr) * 2048 + (((w * 32 + ks * 4 + fg) ^ fr) << 4));
#pragma unroll
        for (int i = 0; i < 2; ++i)
#pragma unroll
            for (int j = 0; j < 2; ++j) acc[i][j] = MFMA16(mk8(bq[j][ks]), af[i], acc[i][j]);
    }
    __syncthreads();
    float* part = (float*)lds;
#pragma unroll
    for (int i = 0; i < 2; ++i)
#pragma unroll
        for (int j = 0; j < 2; ++j) *(f32x4*)(part + w * 1024 + (i * 16 + fr) * 32 + j * 16 + fg * 4) = acc[i][j];
    float* lg = (float*)(lds + 16384);
    int* hist = (int*)(lds + 32768); int* base = hist + 32;
    if (tid < 32) hist[tid] = 0;
    __syncthreads();
    { const f32x4 s_ = (*(const f32x4*)(part + tid * 4) + *(const f32x4*)(part + 1024 + tid * 4)) + (*(const f32x4*)(part + 2048 + tid * 4) + *(const f32x4*)(part + 3072 + tid * 4));
      *(f32x4*)(lg + tid * 4) = s_; }
    __syncthreads();
    float c_lo = 0.f, c_hi = 0.f; int c = 0, rank = 0;
    if (tid < 32) {
        const float* rgb = (const float*)p.in[35] + (size_t)l * 4; const float* reb = (const float*)p.in[37] + (size_t)l * 16;
        float gl[4]; int gi = 0;
#pragma unroll
        for (int q = 0; q < 4; ++q) { gl[q] = lg[tid * 32 + q] + rgb[q]; if (gl[q] > gl[gi]) gi = q; }
        float den = 0.f;
#pragma unroll
        for (int q = 0; q < 4; ++q) den += __expf(gl[q] - gl[gi]);
        const float gp = 1.f / den;
        float el[4];
#pragma unroll
        for (int q = 0; q < 4; ++q) {
            float v = 0.f;
#pragma unroll
            for (int gg_ = 0; gg_ < 4; ++gg_) v = (gg_ == gi) ? (lg[tid * 32 + 4 + gg_ * 4 + q] + reb[gg_ * 4 + q]) : v;
            el[q] = v;
        }
        int i1 = 0;
#pragma unroll
        for (int q = 1; q < 4; ++q) if (el[q] > el[i1]) i1 = q;
        int i2 = (i1 == 0) ? 1 : 0;
#pragma unroll
        for (int q = 0; q < 4; ++q) if (q != i1 && el[q] > el[i2]) i2 = q;
        const float w1 = 1.f / (1.f + __expf(el[i2] - el[i1])), w2 = 1.f - w1;
        const int lo = i1 < i2 ? i1 : i2, hi = i1 < i2 ? i2 : i1;
        c_lo = gp * (i1 < i2 ? w1 : w2); c_hi = gp * (i1 < i2 ? w2 : w1);
        const int pidx = (lo == 0) ? (hi - 1) : (lo == 1 ? hi + 1 : 5);
        c = gi * 6 + pidx;
        rank = atomicAdd(&hist[c], 1);
    }
    __syncthreads();
    unsigned* cnt = (unsigned*)(p.ws + OFF_CTRL) + CT_CNT + l * 32;
    if (tid < 24) base[tid] = (hist[tid] > 0 && !DRY) ? (int)atomicAdd(&cnt[tid], (unsigned)hist[tid]) : 0;
    __syncthreads();
    if (tid < 32 && !DRY) {
        const int slot = base[c] + rank;
        ((int*)(p.ws + OFF_PERM))[(size_t)c * 16384 + slot] = tok0 + tid;
        ((float2*)(p.ws + OFF_CW))[(size_t)c * 16384 + slot] = make_float2(c_lo, c_hi);
    }
    __syncthreads();
}

struct ClsInfo { int cls, rt, cnt, segrow, elo, ehi; };
__device__ __forceinline__ int moe_setup(const Params& p, int l, int* tab) {
    if (threadIdx.x == 0) {
        const unsigned* cnt = (const unsigned*)(p.ws + OFF_CTRL) + CT_CNT + l * 32;
        int tot = 0;
        for (int c = 0; c < 24; ++c) { const int n = (int)__hip_atomic_load(&cnt[c], __ATOMIC_RELAXED, __HIP_MEMORY_SCOPE_AGENT); tab[24 + c] = n; tab[c] = (n + 127) >> 7; tot += tab[c]; }
        tab[48] = tot;
    }
    __syncthreads();
    return tab[48];
}
__device__ __forceinline__ ClsInfo moe_find(const int* tab, int gt) {
    ClsInfo ci; int c = 0, seg = 0;
    while (c < 23 && gt >= tab[c]) { gt -= tab[c]; seg += tab[c]; ++c; }
    ci.cls = c; ci.rt = gt; ci.cnt = tab[24 + c]; ci.segrow = seg * 128;
    const int gi = c / 6, pi = c % 6;
    const int lo = pi < 3 ? 0 : (pi < 5 ? 1 : 2), hi = pi < 3 ? pi + 1 : (pi < 5 ? pi - 1 : 3);
    ci.elo = gi * 4 + lo; ci.ehi = gi * 4 + hi;
    return ci;
}
struct GatherLoader {
    const u16* base; int tok0, tok1, tok2, tok3;
    __device__ __forceinline__ unsigned off(int q, int row, int c) const {
        const int tk = (q == 0) ? tok0 : (q == 1 ? tok1 : (q == 2 ? tok2 : tok3));
        return (unsigned)(tk * 1024 + c * 8) * 2u;
    }
    __device__ __forceinline__ const char* ub(int kt) const { return (const char*)base + kt * 128; }
};
struct GateUpLoader {
    const u16* gsrc; const u16* usrc;
    __device__ __forceinline__ unsigned off(int q, int row, int c) const {
        const unsigned r_ = (row < 64) ? (unsigned)(row * 1024) * 2u : (unsigned)((const char*)usrc - (const char*)gsrc) + (unsigned)((row - 64) * 1024) * 2u;
        return r_ + (unsigned)c * 16u;
    }
    __device__ __forceinline__ const char* ub(int kt) const { return (const char*)gsrc + kt * 128; }
};
struct Gather8Loader {
    const char* base; int tok0, tok1, tok2, tok3;
    __device__ __forceinline__ unsigned off(int q, int row, int c) const {
        const int tk = (q == 0) ? tok0 : (q == 1 ? tok1 : (q == 2 ? tok2 : tok3));
        return (unsigned)(tk * 1024 + c * 16);
    }
    __device__ __forceinline__ const char* ub(int kt) const { return base + kt * 128; }
};
struct GateUp8Loader {
    const char* gsrc; const char* usrc;
    __device__ __forceinline__ unsigned off(int q, int row, int c) const {
        const unsigned r_ = (row < 64) ? (unsigned)(row * 1024) : (unsigned)(usrc - gsrc) + (unsigned)((row - 64) * 1024);
        return r_ + (unsigned)c * 16u;
    }
    __device__ __forceinline__ const char* ub(int kt) const { return gsrc + kt * 128; }
};
struct Down8Loader {
    const char* lo; const char* hi;
    __device__ __forceinline__ unsigned off(int q, int row, int c) const { return (unsigned)(row * 512 + c * 16); }
    __device__ __forceinline__ const char* ub(int kt) const { return ((kt < 4) ? lo : hi) + (kt & 3) * 128; }
};
struct DownLoader {
    const u16* lo; const u16* hi;
    __device__ __forceinline__ unsigned off(int q, int row, int c) const { return (unsigned)(row * 512 + c * 8) * 2u; }
    __device__ __forceinline__ const char* ub(int kt) const { return (const char*)((kt < 8) ? lo : hi) + (kt & 7) * 128; }
};
__device__ void moe_up_phase(const Params& p, int l, char* lds) {
    int* tab = (int*)(lds + LDS_BYTES - 512);
    const int ntiles = moe_setup(p, l, tab);
    const int tid = tid_opaque();
    const int lane = tid & 63, w = tid >> 6, fr = lane & 15, fg = lane >> 4;
    const char* wgate8 = wexp_base(p, l, 0); const char* wup8 = wexp_base(p, l, 1);
    const int* perm = (const int*)(p.ws + OFF_PERM); const float2* cw = (const float2*)(p.ws + OFF_CW);
    u16* hid = (u16*)(p.ws + OFF_R + R_HID);
    for (int u = blockIdx.x; u < ntiles * 16; u += gridDim.x) {
        const int gt = u >> 4, nt = u & 15;
        const ClsInfo ci = moe_find(tab, gt);
        const int hc0 = nt * 64; const int e = hc0 < 512 ? ci.elo : ci.ehi; const int sel = hc0 < 512 ? 0 : 1;
        Gather8Loader al; al.base = (const char*)(p.ws + OFF_H);
        { const int sb = ci.rt * 128 + w * 32 + ((tid & 63) >> 3), cm = ci.cnt - 1; const int* pp = perm + (size_t)ci.cls * 16384;
          al.tok0 = pp[min(sb, cm)]; al.tok1 = pp[min(sb + 8, cm)]; al.tok2 = pp[min(sb + 16, cm)]; al.tok3 = pp[min(sb + 24, cm)]; }
        GateUp8Loader bl{wgate8 + ((size_t)e * 512 + (hc0 & 511)) * 1024, wup8 + ((size_t)e * 512 + (hc0 & 511)) * 1024};
        f32x4 acc[2][8]; acc_zero<2, 8>(acc);
        float cwq[2];
#pragma unroll
        for (int i = 0; i < 2; ++i) { const int slot = min(ci.rt * 128 + w * 32 + i * 16 + fr, ci.cnt - 1); const float2 cc = cw[(size_t)ci.cls * 16384 + slot]; cwq[i] = sel ? cc.y : cc.x; }
        int nk8 = 8; asm volatile("" : "+s"(nk8));
        gemm_kloop<2, 8, true>(acc, al, bl, nk8, lds, tid);
#pragma unroll
        for (int i = 0; i < 2; ++i) {
            const int slot = ci.rt * 128 + w * 32 + i * 16 + fr;
            if (slot < ci.cnt) {
                const float cwv = cwq[i];
#pragma unroll
                for (int j = 0; j < 4; ++j) {
                    f32x4 hv;
#pragma unroll
                    for (int q = 0; q < 4; ++q) { const float gq = acc[i][j][q] * (1.f / GATE_WSCALE); hv[q] = gq * sigmoidf_(gq) * (acc[i][j + 4][q] * (1.f / GATE_WSCALE)) * cwv; }
                    *(unsigned*)((char*)hid + (size_t)(ci.segrow + slot) * 1024 + hc0 + j * 16 + fg * 4) = pk_fp8x4(hv[0] * HID_SCALE, hv[1] * HID_SCALE, hv[2] * HID_SCALE, hv[3] * HID_SCALE);
                }
            }
        }
    }
}
template <bool DRY>
__device__ void moe_down_phase(const Params& p, int l, char* lds) {
    int* tab = (int*)(lds + LDS_BYTES - 512);
    const int ntiles = moe_setup(p, l, tab);
    const int tid = tid_opaque();
    const int lane = tid & 63, w = tid >> 6, wm = w >> 1, wn = w & 1, fr = lane & 15, fg = lane >> 4;
    const char* wdown = wexp_base(p, l, 2);
    const int* perm = (const int*)(p.ws + OFF_PERM);
    const u16* hid = (const u16*)(p.ws + OFF_R + R_HID);
    for (int u = blockIdx.x; u < ntiles * 8; u += gridDim.x) {
        const int gt = u >> 3, nt = u & 7;
        const ClsInfo ci = moe_find(tab, gt);
        RowLoader al(hid + (size_t)(ci.segrow + ci.rt * 128) * 512, 512, tid);
        Down8Loader bl{wdown + ((size_t)ci.elo * 1024 + nt * 128) * 512, wdown + ((size_t)ci.ehi * 1024 + nt * 128) * 512};
        f32x4 acc[4][4]; acc_zero<4, 4>(acc);
        int tkq[4];
#pragma unroll
        for (int i = 0; i < 4; ++i) tkq[i] = perm[(size_t)ci.cls * 16384 + min(ci.rt * 128 + wm * 64 + i * 16 + fr, ci.cnt - 1)];
        int nk8 = 8; asm volatile("" : "+s"(nk8));
        gemm_kloop<4, 4, true>(acc, al, bl, nk8, lds, tid);
#pragma unroll
        for (int i = 0; i < 4; ++i) {
            const int slot = ci.rt * 128 + wm * 64 + i * 16 + fr;
            if (slot < ci.cnt) {
                const int tok = tkq[i];
#pragma unroll
                for (int j = 0; j < 4; ++j) {
                    float* px = p.out + (size_t)tok * 1024 + nt * 128 + wn * 64 + j * 16 + fg * 4;
                    const f32x4 dv = acc[i][j] * (1.f / (HID_SCALE * GATE_WSCALE));
                    if (!DRY) *(f32x4*)px = *(const f32x4*)px + dv; else { const f32x4 t_ = *(const f32x4*)px + dv; asm volatile("" :: "v"(t_[0] + t_[1] + t_[2] + t_[3])); }
                }
            }
        }
    }
}

template <int S>
__device__ __forceinline__ void run_stage(const Params& p, int l, char* lds) {
    const int G = gridDim.x, bid = blockIdx.x;
    if (S == 100) { phase_conv_ne(p, lds); }
    else if (S == 101) { phase_norm<true>(p, p.out, (const float*)p.in[41]); }
    else if (S == 0) { phase_norm<false>(p, l == 0 ? (const float*)p.in[0] : p.out, (const float*)p.in[2] + (size_t)l * 1024); }
    else if (S == 1) { const int NT_ = (l == 0) ? 16 : 17, U = 128 * NT_; for (int u = bid; u < U; u += G) gemm2a_unit(p, l, (u & 7) * (U / 8) + (u >> 3), NT_, lds); }
    else if (S == 2) { for (int u = bid; u < 1024; u += G) prep_unit(p, l, (u & 7) * 128 + (u >> 3), lds); }
    else if (S == 3) {
        if (bid < 64) { __builtin_amdgcn_s_setprio(3); scan_unit(p, l, bid, lds); __builtin_amdgcn_s_setprio(0); }
        unsigned* ctr = (unsigned*)(p.ws + OFF_CTRL) + CT_CNT + 64 + l;
        int* tsl = (int*)(lds + LDS_BYTES - 16);
        for (;;) {
            __syncthreads();
            if (threadIdx.x == 0) *tsl = (int)atomicAdd(ctr, 1u);
            __syncthreads();
            const int u = *tsl;
            if (u >= 128 * 26 + 768) break;
            if (u < 128 * 26) gemm2b_unit(p, l, u, lds);
            else conv_expert_run(p, l, 3072 + 4 * (u - 128 * 26), 4, 1, 6144, lds);
        }
    }
    else if (S == 33) { if (bid < 64) scan_unit(p, l, bid, lds); }
    else if (S == 34) { for (int u = bid; u < 128 * 26; u += G) gemm2b_unit(p, l, u, lds); }
    else if (S == 4) { for (int u = bid; u < 512 + 1536; u += G) { if (u < 512) mixa_unit<false>(p, l, (u & 7) * 64 + (u >> 3), lds); else attn_unit<false>(p, u - 512, lds); } phase_post_yc<false>(p, l); }
    else if (S == 44) { for (int u = bid; u < 512 + 1536; u += G) { if (u < 512) mixa_unit<true>(p, l, u, lds); else attn_unit<true>(p, u - 512, lds); } }
    else if (S == 45) { for (int u = bid; u < 512; u += G) mixa_unit<true>(p, l, u, lds); }
    else if (S == 110) { moe_down_phase<true>(p, l, lds); }
    else if (S == 5) { phase_post<false>(p, l); }
    else if (S == 55) { phase_post<true>(p, l); }
    else if (S == 6) {
        const int ncv = (3072 + G - 1) / G;
        int cv = 0, mu = bid;
        auto conv_some = [&](int n) { const int c = min(n, ncv - cv); if (c > 0) { conv_expert_run(p, l, bid + cv * G, c, G, 3072, lds); cv += c; } };
        if (bid & 1) conv_some(ncv / 2);
        for (; mu < 1024; mu += G) { merge_unit(p, l, (mu & 7) * 128 + (mu >> 3), lds); conv_some(ncv / 2); }
        conv_some(ncv);
    }
    else if (S == 66) { for (int mu = bid; mu < 1024; mu += G) merge_unit(p, l, (mu & 7) * 128 + (mu >> 3), lds); }
    else if (S == 67) { const int ncv = (6144 + G - 1) / G; conv_expert_run(p, l, bid, ncv, G, 6144, lds); }
    else if (S == 7) { for (int u = bid; u < 1024; u += G) outproj_unit(p, l, (u & 7) * 128 + (u >> 3), lds); }
    else if (S == 8) { for (int u = bid; u < 512; u += G) router_unit<false>(p, l, u, lds); }
    else if (S == 88) { for (int u = bid; u < 512; u += G) router_unit<true>(p, l, u, lds); }
    else if (S == 9) { moe_up_phase(p, l, lds); }
    else if (S == 10) { moe_down_phase<false>(p, l, lds); }
}

template <int S>
__global__ void __launch_bounds__(256, 2) stage_kernel(Params p, int l) {
    __shared__ __attribute__((aligned(16))) char lds[LDS_BYTES + 16];
    run_stage<S>(p, l, lds);
}

#if MK_FUSED
__global__ void __launch_bounds__(256, 2) mega_kernel(Params p) {
    __shared__ __attribute__((aligned(16))) char lds[LDS_BYTES + 16];
    volatile LAS unsigned* st = (volatile LAS unsigned*)(lds + LDS_BYTES);
    if (threadIdx.x == 0) { st[0] = 0u; st[1] = 0u; st[2] = 0u; st[3] = 0u; }
    __syncthreads();
    XcdBarrier xb = xcd_barrier_post((unsigned*)(p.ws + OFF_CTRL), st);
#if TIMING_PHASE >= 0
    unsigned long long t_start = __builtin_amdgcn_s_memrealtime(), t_sel = 0; int t_k = 0;
#define XBAR() do { xcd_barrier(xb); if (t_k == TIMING_PHASE) t_sel = __builtin_amdgcn_s_memrealtime() - t_start; ++t_k; } while (0)
#else
#define XBAR() xcd_barrier(xb)
#endif
    run_stage<100>(p, 0, lds); run_stage<0>(p, 0, lds); XBAR();
    if (DUP_STAGE == 999) { for (int i_ = 0; i_ < 20; ++i_) XBAR(); }
    if (DUP_STAGE == 100) { run_stage<100>(p, 0, lds); XBAR(); }
#define MK_ST(S, l) run_stage<S>(p, l, lds); XBAR(); if (DUP_STAGE == S && !(S == 7 && l == 1)) { run_stage<S>(p, l, lds); XBAR(); } if (S == 4 && DUP_STAGE == 44) { run_stage<44>(p, l, lds); XBAR(); } if (S == 4 && DUP_STAGE == 45) { run_stage<45>(p, l, lds); XBAR(); } if (S == 10 && DUP_STAGE == 110) { run_stage<110>(p, l, lds); XBAR(); } if (S == 5 && DUP_STAGE == 55) { run_stage<55>(p, l, lds); XBAR(); } if (S == 8 && DUP_STAGE == 88) { run_stage<88>(p, l, lds); XBAR(); } if (S == 3 && DUP_STAGE == 33) { run_stage<33>(p, l, lds); XBAR(); } if (S == 3 && DUP_STAGE == 34) { run_stage<34>(p, l, lds); XBAR(); } if (S == 6 && DUP_STAGE == 66) { run_stage<66>(p, l, lds); XBAR(); } if (S == 6 && DUP_STAGE == 67) { run_stage<67>(p, l, lds); XBAR(); }
#define MK_ST0(l) if (l != 0) { MK_ST(0, l) }
#define MK_LAYER(l) MK_ST0(l) MK_ST(1, l) MK_ST(2, l) MK_ST(3, l) MK_ST(4, l) MK_ST(5, l) MK_ST(6, l) MK_ST(7, l) MK_ST(8, l) MK_ST(9, l) MK_ST(10, l)
    MK_LAYER(0)
    MK_LAYER(1)
    run_stage<101>(p, 0, lds);
#if TIMING_PHASE >= 0
    if (blockIdx.x == 0 && threadIdx.x == 0) { asm volatile("s_waitcnt vmcnt(0)" ::: "memory"); p.out[0] = (float)t_sel * 0.01f; }
#endif
}
#endif

#ifndef DBG
#define DBG 0
#endif
__global__ void dump_kernel(const u16* src, size_t stride, int width, float* out) {
    const size_t i = (size_t)blockIdx.x * 256 + threadIdx.x;
    const size_t tok = i >> 10; const int c = (int)(i & 1023);
    out[i] = bf2f(src[tok * stride + (c % width)]);
}
#define DUMP(off, stride, width) dump_kernel<<<dim3(NTOK * 1024 / 256), dim3(256), 0, stream>>>((const u16*)((char*)d_ws + (off)), stride, width, (float*)d_out)
#define LAUNCH_STAGE(S, l) stage_kernel<S><<<dim3(grid_blocks), dim3(256), 0, stream>>>(p, l)
extern "C" void kernel_launch(void* const* d_in, const int* in_sizes, int n_in, void* d_out, int out_size, void* d_ws, size_t ws_size, hipStream_t stream) {
    static int grid_blocks = 0;
    if (!grid_blocks) {
        int dev = 0, cus = 0, per_cu = 2;
        (void)hipGetDevice(&dev);
        (void)hipDeviceGetAttribute(&cus, hipDeviceAttributeMultiprocessorCount, dev);
#if MK_FUSED
        (void)hipOccupancyMaxActiveBlocksPerMultiprocessor(&per_cu, mega_kernel, 256, 0);
        if (per_cu > 2) per_cu = 2;
        if (per_cu < 1) per_cu = 1;
#endif
        if (cus <= 0) cus = 256;
        grid_blocks = cus * per_cu;
    }
    if (ws_size < OFF_END || n_in < 42) { fprintf(stderr, "workspace too small or bad inputs\n"); return; }
    Params p{};
    for (int i = 0; i < 42; ++i) p.in[i] = d_in[i];
    p.out = (float*)d_out; p.ws = (char*)d_ws;
    (void)hipMemsetAsync(d_ws, 0, 65536, stream);
#if MK_FUSED
    void* args[] = {&p};
    hipError_t e = hipLaunchCooperativeKernel((void*)mega_kernel, dim3(grid_blocks), dim3(256), args, 0, stream);
    if (e != hipSuccess) fprintf(stderr, "cooperative launch failed: %s (grid %d)\n", hipGetErrorString(e), grid_blocks);
#else
    LAUNCH_STAGE(100, 0);
    for (int l = 0; l < 2; ++l) {
        LAUNCH_STAGE(0, l); LAUNCH_STAGE(1, l);
        if (DBG == 1) { DUMP(OFF_R + R_PROJC, 1536, 1024); return; }
        LAUNCH_STAGE(2, l);
        if (DBG == 2) { DUMP(OFF_KR, 1024, 1024); return; }
        LAUNCH_STAGE(3, l);
        if (DBG == 3) { DUMP(OFF_YRAW, 512, 512); return; }
        if (DBG == 4) { DUMP(OFF_R + R_PROJB, 2304, 1024); return; }
        LAUNCH_STAGE(4, l);
        if (DBG == 5) { DUMP(OFF_R + R_PROJB, 2304, 1024); return; }
        if (DBG == 6) { DUMP(OFF_R + R_PROJA, 1024, 512); return; }
        LAUNCH_STAGE(5, l);
        if (DBG == 10) { DUMP(OFF_G, 512, 512); return; }
        if (DBG == 11) { DUMP(OFF_R + R_PROJB + 768 * 2, 2304, 256); return; }
        LAUNCH_STAGE(6, l);
        if (DBG == 7) { DUMP(OFF_MERGED, 1024, 1024); return; }
        LAUNCH_STAGE(7, l);
        if (DBG == 8) return;
        LAUNCH_STAGE(8, l); LAUNCH_STAGE(9, l); LAUNCH_STAGE(10, l);
        if (DBG == 9) return;
    }
    LAUNCH_STAGE(101, 0);
#endif
}
```

```cpp
#include <hip/hip_runtime.h>
#include <hip/hip_cooperative_groups.h>
#include <stdint.h>
#include <cstdio>

#ifndef MK_FUSED
#define MK_FUSED 1
#endif
#ifndef TIMING_PHASE
#define TIMING_PHASE -1
#endif
#ifndef DUP_STAGE
#define DUP_STAGE -1
#endif

typedef short bf16x8 __attribute__((ext_vector_type(8)));
typedef short bf16x4 __attribute__((ext_vector_type(4)));
typedef float f32x4 __attribute__((ext_vector_type(4)));
typedef __bf16 bf2_t __attribute__((ext_vector_type(2)));
typedef short v4i16_t __attribute__((ext_vector_type(4)));
typedef _Float16 h2_t __attribute__((ext_vector_type(2)));
typedef unsigned short u16;
#define LAS __attribute__((address_space(3)))

constexpr int NTOK = 16384, DM = 1024, SEQ = 2048;
constexpr int NPH = 24;
constexpr int LDS_BYTES = 66 * 1024;

constexpr size_t OFF_CTRL = 0;
constexpr size_t OFF_ROT  = 65536;
constexpr size_t OFF_WNE  = OFF_ROT + 2 * (size_t)NTOK * 8 * 4;
constexpr size_t WNE_WTC = 0, WNE_WTAB = 4456448, WNE_WGATE = 11272192, WNE_WBRA = 17563648, WNE_WBRB = 18612224,
                 WNE_WBRC = 19136512, WNE_WOUT = 20185088, WNE_W2T = 22282240, WNE_A2T = 22347776, WNE_G2T = 22413312,
                 WNE_V2T = 22544384, WNE_WR = 22577152, WNE_SZ = 22839296;
constexpr size_t OFF_H    = OFF_WNE + 2 * WNE_SZ;
constexpr size_t OFF_V    = OFF_H + (size_t)NTOK * 1024 * 2;
constexpr size_t OFF_KR   = OFF_V + 2 * (size_t)NTOK * 512 * 2;
constexpr size_t OFF_BK   = OFF_KR + (size_t)NTOK * 2048;
constexpr size_t OFF_W    = OFF_BK + (size_t)NTOK * 2048;
constexpr size_t OFF_G    = OFF_W + (size_t)NTOK * 1024;
constexpr size_t OFF_YRAW = OFF_G + (size_t)NTOK * 1024;
constexpr size_t OFF_BONUS= OFF_YRAW + (size_t)NTOK * 1024;
constexpr size_t OFF_LSE  = OFF_BONUS + (size_t)NTOK * 32;
constexpr size_t OFF_R    = OFF_LSE + (size_t)3 * NTOK * 16;
constexpr size_t R_PROJA = 0;
constexpr size_t R_PROJB = (size_t)NTOK * 2048;
constexpr size_t R_PROJC = 0;
constexpr size_t R_LORA1 = (size_t)NTOK * 3072;
constexpr size_t R_WEXP  = 0;
constexpr size_t R_HID   = 50331648;
constexpr size_t R_SZ    = (size_t)NTOK * (2048 + 4608);
constexpr size_t OFF_UP8  = OFF_R + R_SZ;
constexpr size_t OFF_WSA  = OFF_UP8 + (size_t)16 * 512 * 1024;
constexpr size_t OFF_END  = OFF_WSA + (size_t)2 * 4 * 128 * 128 * 2;
constexpr size_t OFF_KK = OFF_KR;
constexpr size_t OFF_RR = OFF_KR + (size_t)NTOK * 1024;
constexpr size_t OFF_PC = OFF_W;
constexpr size_t OFF_COEF = OFF_W + (size_t)4 * 1024 * 1024;
constexpr size_t OFF_MERGED = OFF_KR;
constexpr size_t OFF_DOWN8 = OFF_W + (size_t)8 * 1024 * 1024;
constexpr size_t OFF_WEXP = OFF_BK;
constexpr size_t OFF_PERM = OFF_YRAW;
constexpr size_t OFF_CW   = OFF_YRAW + (size_t)24 * 16384 * 4;
static_assert((size_t)NTOK * 2048 + (size_t)NTOK * 1024 >= 50331648, "WEXP overlay");
static_assert((size_t)24 * 16384 * 12 <= (size_t)NTOK * 1024, "perm/cw overlay");
static_assert(OFF_END <= 356000000, "workspace too large");
static_assert(R_HID + (size_t)19456 * 2048 <= R_SZ, "R region");
constexpr int CT_CNT = 8192;

struct Params {
    const void* in[42];
    float* out;
    char* ws;
    int pad0, pad1;
};

typedef float f2_t __attribute__((ext_vector_type(2)));
__device__ __forceinline__ unsigned pk_bf16(float lo, float hi) { f2_t f; f[0] = lo; f[1] = hi; return __builtin_bit_cast(unsigned, __builtin_convertvector(f, bf2_t)); }
__device__ __forceinline__ float bflo(unsigned u) { return __uint_as_float(u << 16); }
__device__ __forceinline__ float bfhi(unsigned u) { return __uint_as_float(u & 0xffff0000u); }
__device__ __forceinline__ float bf2f(u16 h) { return __uint_as_float(((unsigned)h) << 16); }
__device__ __forceinline__ u16 f2bf(float f) { return (u16)(pk_bf16(f, 0.f) & 0xffffu); }
__device__ __forceinline__ uint2 pk4(f32x4 v) { return make_uint2(pk_bf16(v[0], v[1]), pk_bf16(v[2], v[3])); }
__device__ __forceinline__ f32x4 unpk4(uint2 u) { f32x4 r; r[0] = bflo(u.x); r[1] = bfhi(u.x); r[2] = bflo(u.y); r[3] = bfhi(u.y); return r; }
__device__ __forceinline__ float fast_rcp(float x) { return __builtin_amdgcn_rcpf(x); }
__device__ __forceinline__ float fast_exp(float x) { return __builtin_amdgcn_exp2f(x * 1.4426950408889634f); }
__device__ __forceinline__ float sigmoidf_(float x) { return fast_rcp(1.f + fast_exp(-x)); }
__device__ __forceinline__ float gelu_tanh(float x) { const float z = 0.7978845608028654f * (x + 0.044715f * x * x * x); return x * fast_rcp(1.f + fast_exp(-2.f * z)); }
__device__ __forceinline__ float dot2bf(unsigned a, unsigned b, float c) { return __builtin_amdgcn_fdot2_f32_bf16(__builtin_bit_cast(bf2_t, a), __builtin_bit_cast(bf2_t, b), c, false); }
template <int CTRL> __device__ __forceinline__ float dpp_f(float x) { return __builtin_bit_cast(float, __builtin_amdgcn_update_dpp(0, __builtin_bit_cast(int, x), CTRL, 0xf, 0xf, false)); }
__device__ __forceinline__ float rowsum16(float x) { x += dpp_f<0x128>(x); x += dpp_f<0x124>(x); x += dpp_f<0x122>(x); x += dpp_f<0x121>(x); return x; }
__device__ __forceinline__ float wavesum(float x) { x += __shfl_xor(x, 32); x += __shfl_xor(x, 16); x += __shfl_xor(x, 8); x += __shfl_xor(x, 4); x += __shfl_xor(x, 2); x += __shfl_xor(x, 1); return x; }
__device__ __forceinline__ bf16x8 mk8(uint4 u) { return __builtin_bit_cast(bf16x8, u); }
__device__ __forceinline__ int tid_opaque() { int t = threadIdx.x; asm volatile("" : "+v"(t)); return t; }
#define MFMA16(a, b, c) __builtin_amdgcn_mfma_f32_16x16x32_bf16(a, b, c, 0, 0, 0)
typedef int i32x8 __attribute__((ext_vector_type(8)));
#define MFMA8X(a, b, c) __builtin_amdgcn_mfma_scale_f32_16x16x128_f8f6f4(a, b, c, 0, 0, 0, 0x7f7f7f7f, 0, 0x7f7f7f7f)
__device__ __forceinline__ unsigned pk_fp8x4(float a, float b, float c, float d) {
    int r = __builtin_amdgcn_cvt_pk_fp8_f32(a, b, 0, false);
    r = __builtin_amdgcn_cvt_pk_fp8_f32(c, d, r, true);
    return (unsigned)r;
}
constexpr float HID_SCALE = 8.f;
constexpr float GATE_WSCALE = 32.f;

#define XB_TMO      128
#define XB_XCNT(j)  (256  + 64 * (j))
#define XB_XSUB(j)  (1280 + 64 * (j))
#define XB_XGEN(j)  (2304 + 64 * (j))
#define XB_TOP      3328
#define XB_TOPGEN   3392
#define XCD_BAR_WORDS 3456
#define XB_SPIN_CAP (1u << 22)
__device__ __forceinline__ unsigned xb_ld(unsigned* p)              { return __hip_atomic_load(p, __ATOMIC_RELAXED, __HIP_MEMORY_SCOPE_AGENT); }
__device__ __forceinline__ unsigned xb_add(unsigned* p, unsigned v) { return __hip_atomic_fetch_add(p, v, __ATOMIC_RELAXED, __HIP_MEMORY_SCOPE_AGENT); }
__device__ __forceinline__ unsigned xb_xcc_id() { return (unsigned)__builtin_amdgcn_s_getreg((3 << 11) | 20) & 0xFu; }
#define XB_SPIN(cond, bar) do { unsigned _sp = 0; while (cond) { __builtin_amdgcn_s_sleep(1); \
    if ((++_sp & 255u) == 0u) { if (xb_ld(&(bar)[XB_TMO])) break; if (_sp > XB_SPIN_CAP) { atomicAdd(&(bar)[XB_TMO], 1u); break; } } } } while (0)
struct XcdBarrier { unsigned* bar; unsigned x; volatile LAS unsigned* st; };
__device__ __forceinline__ XcdBarrier xcd_barrier_post(unsigned* bar, volatile LAS unsigned* st) {
    XcdBarrier b; b.bar = bar; b.x = xb_xcc_id(); b.st = st;
    if (threadIdx.x == 0) (void)xb_add(&bar[XB_XCNT(b.x)], 1u);
    return b;
}
__device__ __forceinline__ void xcd_barrier_complete(unsigned* bar, unsigned x, unsigned& nloc, unsigned& nx) {
    const unsigned G = gridDim.x * gridDim.y * gridDim.z;
    unsigned sum, cnt, mine, sp = 0u;
    for (;;) {
        sum = 0u; cnt = 0u; mine = 0u;
#pragma unroll
        for (unsigned j = 0; j < 16; ++j) { const unsigned c = xb_ld(&bar[XB_XCNT(j)]); sum += c; cnt += (c > 0u) ? 1u : 0u; mine = (j == x) ? c : mine; }
        if (sum == G) break;
        __builtin_amdgcn_s_sleep(1);
        if ((++sp & 255u) == 0u) { if (xb_ld(&bar[XB_TMO])) break; if (sp > XB_SPIN_CAP) { atomicAdd(&bar[XB_TMO], 1u); break; } }
    }
    nloc = mine > 0u ? mine : 1u; nx = cnt > 0u ? cnt : 1u;
}
__device__ __forceinline__ void xcd_barrier(const XcdBarrier& b) {
    asm volatile("s_waitcnt vmcnt(0)" ::: "memory");
    __syncthreads();
    if (threadIdx.x == 0) {
        unsigned* bar = b.bar;
        __builtin_amdgcn_s_waitcnt(0);
        unsigned nloc = b.st[0], nx = b.st[1];
        if (nloc == 0u) { xcd_barrier_complete(bar, b.x, nloc, nx); b.st[0] = nloc; b.st[1] = nx; }
        const unsigned old = xb_add(&bar[XB_XSUB(b.x)], 1u);
        const unsigned gen = old / nloc;
        if (old + 1u == (gen + 1u) * nloc) {
            __builtin_amdgcn_fence(__ATOMIC_RELEASE, "agent");
            asm volatile("s_waitcnt vmcnt(0)" ::: "memory");
            const unsigned og = xb_add(&bar[XB_TOP], 1u);
            const unsigned tg = og / nx;
            if (og + 1u == (tg + 1u) * nx) xb_add(&bar[XB_TOPGEN], 1u);
            else XB_SPIN(xb_ld(&bar[XB_TOPGEN]) == tg, bar);
            __builtin_amdgcn_fence(__ATOMIC_ACQUIRE, "agent");
            xb_add(&bar[XB_XGEN(b.x)], 1u);
            asm volatile("s_waitcnt vmcnt(0)" ::: "memory");
        } else {
            XB_SPIN(xb_ld(&bar[XB_XGEN(b.x)]) == gen, bar);
            __builtin_amdgcn_fence(__ATOMIC_ACQUIRE, "agent");
            asm volatile("s_waitcnt vmcnt(0)" ::: "memory");
        }
    }
    __syncthreads();
}

__device__ __forceinline__ int toff(int row, int chunk) { return row * 128 + ((chunk ^ ((row >> 1) & 7)) << 4); }

template <int MT, int NT, bool F8 = false, class AL, class BL>
__device__ __forceinline__ void gemm_kloop(f32x4 (&acc)[MT][NT], const AL& al, const BL& bl, int nk, char* lds, int tid, bool primed, bool has_next, const AL& nal, const BL& nbl) {
    const int lane = tid & 63, w = tid >> 6;
    const int wm = (MT == 4) ? (w >> 1) : w, wn = (MT == 4) ? (w & 1) : 0;
    const int fr = lane & 15, fg = lane >> 4;
    const int lrow = lane >> 3, pc = lane & 7;
    unsigned va[4], vb[4];
#pragma unroll
    for (int q = 0; q < 4; ++q) { const int row = w * 32 + q * 8 + lrow; const int c = pc ^ ((row >> 1) & 7); va[q] = al.off(q, row, c); vb[q] = bl.off(q, row, c); }
    char* ldw = lds + __builtin_amdgcn_readfirstlane(w) * 4096;
#define GK_STAGE(kt_, buf_) do { const char* ua_ = al.ub(kt_); const char* ub_ = bl.ub(kt_); char* dA_ = ldw + (buf_) * 32768; \
        _Pragma("unroll") for (int q_ = 0; q_ < 4; ++q_) { \
            __builtin_amdgcn_global_load_lds((const unsigned*)(ua_ + va[q_]), (unsigned*)(dA_ + q_ * 1024), 16, 0, 0); \
            __builtin_amdgcn_global_load_lds((const unsigned*)(ub_ + vb[q_]), (unsigned*)(dA_ + 16384 + q_ * 1024), 16, 0, 0); } } while (0)
    if (!primed) GK_STAGE(0, 0);
    asm volatile("s_waitcnt vmcnt(0)" ::: "memory");
    __syncthreads();
    for (int kt = 0; kt < nk; ++kt) {
        const char* cA = lds + (kt & 1) * 32768; const char* cB = cA + 16384;
        if (kt + 1 < nk) GK_STAGE(kt + 1, (kt + 1) & 1);
        else if (has_next) {
            const char* ua_ = nal.ub(0); const char* ub_ = nbl.ub(0);
#pragma unroll
            for (int q = 0; q < 4; ++q) { const int row = w * 32 + q * 8 + lrow; const int c = pc ^ ((row >> 1) & 7);
                __builtin_amdgcn_global_load_lds((const unsigned*)(ua_ + nal.off(q, row, c)), (unsigned*)(ldw + q * 1024), 16, 0, 0);
                __builtin_amdgcn_global_load_lds((const unsigned*)(ub_ + nbl.off(q, row, c)), (unsigned*)(ldw + 16384 + q * 1024), 16, 0, 0); }
        }
        if (F8) {
            i32x8 af[MT], bfr[NT];
#pragma unroll
            for (int i = 0; i < MT; ++i) { const uint4 lo = *(const uint4*)(cA + toff(wm * MT * 16 + i * 16 + fr, fg)), hi = *(const uint4*)(cA + toff(wm * MT * 16 + i * 16 + fr, 4 + fg));
                                           af[i] = (i32x8){(int)lo.x, (int)lo.y, (int)lo.z, (int)lo.w, (int)hi.x, (int)hi.y, (int)hi.z, (int)hi.w}; }
#pragma unroll
            for (int j = 0; j < NT; ++j) { const uint4 lo = *(const uint4*)(cB + toff(wn * NT * 16 + j * 16 + fr, fg)), hi = *(const uint4*)(cB + toff(wn * NT * 16 + j * 16 + fr, 4 + fg));
                                           bfr[j] = (i32x8){(int)lo.x, (int)lo.y, (int)lo.z, (int)lo.w, (int)hi.x, (int)hi.y, (int)hi.z, (int)hi.w}; }
#pragma unroll
            for (int i = 0; i < MT; ++i)
#pragma unroll
                for (int j = 0; j < NT; ++j) acc[i][j] = MFMA8X(bfr[j], af[i], acc[i][j]);
        } else {
#pragma unroll
        for (int s = 0; s < 2; ++s) {
            bf16x8 af[MT], bfr[NT];
#pragma unroll
            for (int i = 0; i < MT; ++i) af[i] = *(const bf16x8*)(cA + toff(wm * MT * 16 + i * 16 + fr, s * 4 + fg));
#pragma unroll
            for (int j = 0; j < NT; ++j) bfr[j] = *(const bf16x8*)(cB + toff(wn * NT * 16 + j * 16 + fr, s * 4 + fg));
#pragma unroll
            for (int i = 0; i < MT; ++i)
#pragma unroll
                for (int j = 0; j < NT; ++j) acc[i][j] = MFMA16(bfr[j], af[i], acc[i][j]);
        }
        }
        asm volatile("s_waitcnt vmcnt(0)" ::: "memory");
        __syncthreads();
    }
#undef GK_STAGE
}
template <int MT, int NT, bool F8 = false, class AL, class BL>
__device__ __forceinline__ void gemm_kloop(f32x4 (&acc)[MT][NT], const AL& al, const BL& bl, int nk, char* lds, int tid) { gemm_kloop<MT, NT, F8>(acc, al, bl, nk, lds, tid, false, false, al, bl); }
__device__ __forceinline__ void gemm_kloop2(f32x4 (&acc)[4][4], uint2 (&yb)[4][4], const u16* a1, int lda1, const u16* b1, int ldb1, int nk1,
                                            const u16* a2, int lda2, const u16* b2, int ldb2, int nk2, const float* bias2, float bscale, char* lds, int tid) {
    const int lane = tid & 63, w = tid >> 6;
    const int wm = w >> 1, wn = w & 1;
    const int fr = lane & 15, fg = lane >> 4;
    const int lrow = lane >> 3, pc = lane & 7;
    const int nk = nk1 + nk2;
    f32x4 bz[4];
#pragma unroll
    for (int j = 0; j < 4; ++j) bz[j] = *(const f32x4*)(bias2 + wn * 64 + j * 16 + fg * 4);
#define GK_STAGE2(kt_, buf_) do { char* dA_ = lds + (buf_) * 32768 + w * 4096 + lane * 16; \
        const bool f_ = (kt_) < nk1; const u16* ab_ = f_ ? a1 : a2; const u16* bb_ = f_ ? b1 : b2; const int la_ = f_ ? lda1 : lda2, lb_ = f_ ? ldb1 : ldb2; \
        const int kk_ = (f_ ? (kt_) : (kt_) - nk1) * 64; \
        _Pragma("unroll") for (int q_ = 0; q_ < 4; ++q_) { const int row_ = w * 32 + q_ * 8 + lrow; const int c_ = (pc ^ ((row_ >> 1) & 7)) * 8 + kk_; \
            __builtin_amdgcn_global_load_lds((const unsigned*)(ab_ + (size_t)row_ * la_ + c_), (unsigned*)(dA_ + q_ * 1024), 16, 0, 0); \
            __builtin_amdgcn_global_load_lds((const unsigned*)(bb_ + (size_t)row_ * lb_ + c_), (unsigned*)(dA_ + 16384 + q_ * 1024), 16, 0, 0); } } while (0)
    GK_STAGE2(0, 0);
    asm volatile("s_waitcnt vmcnt(0)" ::: "memory");
    __syncthreads();
#pragma unroll 1
    for (int kt = 0; kt < nk1; ++kt) {
        const char* cA = lds + (kt & 1) * 32768; const char* cB = cA + 16384;
        if (kt + 1 < nk) GK_STAGE2(kt + 1, (kt + 1) & 1);
#pragma unroll
        for (int s = 0; s < 2; ++s) {
            bf16x8 af[4], bfr[4];
#pragma unroll
            for (int i = 0; i < 4; ++i) af[i] = *(const bf16x8*)(cA + toff(wm * 64 + i * 16 + fr, s * 4 + fg));
#pragma unroll
            for (int j = 0; j < 4; ++j) bfr[j] = *(const bf16x8*)(cB + toff(wn * 64 + j * 16 + fr, s * 4 + fg));
#pragma unroll
            for (int i = 0; i < 4; ++i)
#pragma unroll
                for (int j = 0; j < 4; ++j) acc[i][j] = MFMA16(bfr[j], af[i], acc[i][j]);
        }
        asm volatile("s_waitcnt vmcnt(0)" ::: "memory");
        __syncthreads();
    }
#pragma unroll
    for (int i = 0; i < 4; ++i)
#pragma unroll
        for (int j = 0; j < 4; ++j) { yb[i][j] = pk4(acc[i][j]); acc[i][j] = bz[j] * bscale; }
#pragma unroll 1
    for (int kt = nk1; kt < nk; ++kt) {
        const char* cA = lds + (kt & 1) * 32768; const char* cB = cA + 16384;
        if (kt + 1 < nk) GK_STAGE2(kt + 1, (kt + 1) & 1);
        {
            i32x8 af[4], bfr[4];
#pragma unroll
            for (int i = 0; i < 4; ++i) { const uint4 lo = *(const uint4*)(cA + toff(wm * 64 + i * 16 + fr, fg)), hi = *(const uint4*)(cA + toff(wm * 64 + i * 16 + fr, 4 + fg));
                                          af[i] = (i32x8){(int)lo.x, (int)lo.y, (int)lo.z, (int)lo.w, (int)hi.x, (int)hi.y, (int)hi.z, (int)hi.w}; }
#pragma unroll
            for (int j = 0; j < 4; ++j) { const uint4 lo = *(const uint4*)(cB + toff(wn * 64 + j * 16 + fr, fg)), hi = *(const uint4*)(cB + toff(wn * 64 + j * 16 + fr, 4 + fg));
                                          bfr[j] = (i32x8){(int)lo.x, (int)lo.y, (int)lo.z, (int)lo.w, (int)hi.x, (int)hi.y, (int)hi.z, (int)hi.w}; }
#pragma unroll
            for (int i = 0; i < 4; ++i)
#pragma unroll
                for (int j = 0; j < 4; ++j) acc[i][j] = MFMA8X(bfr[j], af[i], acc[i][j]);
        }
        asm volatile("s_waitcnt vmcnt(0)" ::: "memory");
        __syncthreads();
    }
#undef GK_STAGE2
}
template <int MT, int NT> __device__ __forceinline__ void acc_zero(f32x4 (&acc)[MT][NT]) {
#pragma unroll
    for (int i = 0; i < MT; ++i)
#pragma unroll
        for (int j = 0; j < NT; ++j) acc[i][j] = (f32x4){0.f, 0.f, 0.f, 0.f};
}
struct RowLoader {
    const u16* base; int ld;
    __device__ __forceinline__ RowLoader(const u16* b, int l, int) : base(b), ld(l) {}
    __device__ __forceinline__ unsigned off(int q, int row, int c) const { return (unsigned)(row * ld + c * 8) * 2u; }
    __device__ __forceinline__ const char* ub(int kt) const { return (const char*)base + kt * 128; }
};

struct ConvJob { const float* src; int ldsrc; int K; int nc; u16* dst; int ldd; const float* scale; int smode; };
__device__ __forceinline__ void conv_tile(const ConvJob& jb, int tk, int tn, char* lds) {
    float* T = (float*)lds;
    const int tid = tid_opaque();
    const int k0 = tk * 64, n0 = tn * 64;
    const bool full = (jb.src != nullptr) && (k0 + 64 <= jb.K) && (n0 + 64 <= jb.nc) && ((jb.ldsrc & 3) == 0);
    if (full) {
        const int n4 = (tid & 15) * 4, kb = tid >> 4;
#pragma unroll
        for (int i = 0; i < 4; ++i) {
            const int kl = kb + 16 * i; const int k = k0 + kl;
            f32x4 v = __builtin_nontemporal_load((const f32x4*)(jb.src + (size_t)k * jb.ldsrc + n0 + n4));
            if (jb.smode == 1) v = v * (1.f - jb.scale[k]); else if (jb.smode == 2) v = v * jb.scale[k];
            T[kl * 65 + n4] = v[0]; T[kl * 65 + n4 + 1] = v[1]; T[kl * 65 + n4 + 2] = v[2]; T[kl * 65 + n4 + 3] = v[3];
        }
    } else {
        const int nl = tid & 63, kb = tid >> 6;
#pragma unroll
        for (int i = 0; i < 16; ++i) {
            const int kl = kb + 4 * i; const int k = k0 + kl, n = n0 + nl;
            float v = 0.f;
            if (jb.src != nullptr && k < jb.K && n < jb.nc) {
                v = jb.src[(size_t)k * jb.ldsrc + n];
                if (jb.smode == 1) v *= (1.f - jb.scale[k]); else if (jb.smode == 2) v *= jb.scale[k];
            }
            T[kl * 65 + nl] = v;
        }
    }
    __syncthreads();
    if (full || ((k0 + 64 <= jb.K) && (n0 + 64 <= jb.nc))) {
        const int k8 = (tid & 7) * 8, nb = tid >> 3;
#pragma unroll
        for (int i = 0; i < 2; ++i) {
            const int nl = nb + 32 * i;
            const uint4 o = make_uint4(pk_bf16(T[(k8 + 0) * 65 + nl], T[(k8 + 1) * 65 + nl]), pk_bf16(T[(k8 + 2) * 65 + nl], T[(k8 + 3) * 65 + nl]),
                                       pk_bf16(T[(k8 + 4) * 65 + nl], T[(k8 + 5) * 65 + nl]), pk_bf16(T[(k8 + 6) * 65 + nl], T[(k8 + 7) * 65 + nl]));
            *(uint4*)(jb.dst + (size_t)(n0 + nl) * jb.ldd + k0 + k8) = o;
        }
    } else {
        const int kp = tid & 31, nb = tid >> 5;
#pragma unroll
        for (int i = 0; i < 8; ++i) {
            const int nl = nb + 8 * i; const int n = n0 + nl, k = k0 + 2 * kp;
            if (n < jb.nc && k < jb.K) {
                const unsigned pv = pk_bf16(T[(2 * kp) * 65 + nl], T[(2 * kp + 1) * 65 + nl]);
                *(unsigned*)(jb.dst + (size_t)n * jb.ldd + k) = pv;
            }
        }
    }
    __syncthreads();
}
constexpr int NE_JOBS = 23;
constexpr int NE_Q1 = 1024, NE_Q2 = 1024;
__device__ __forceinline__ void ne_job_dims(int j, int& K, int& nc) {
    K = 1024; nc = 64;
    switch (j) {
        case 0: nc = 1536; break; case 1: case 2: case 5: case 6: nc = 64; break; case 3: case 7: nc = 128; break; case 4: case 8: nc = 32; break;
        case 9: nc = 64; break; case 10: nc = 3328; break; case 11: nc = 3072; break; case 12: K = 512; nc = 1024; break; case 13: K = 256; nc = 1024; break;
        case 14: K = 512; nc = 1024; break; case 15: nc = 1024; break; case 16: case 17: K = 64; nc = 512; break; case 18: K = 128; nc = 512; break;
        case 19: K = 32; nc = 512; break; case 20: nc = 4; break; case 21: nc = 16; break; case 22: nc = 108; break;
    }
}
__device__ __forceinline__ void ne_job(const Params& p, int l, int j, ConvJob& jb) {
    char* wne = p.ws + OFF_WNE + (size_t)l * WNE_SZ;
    int K, nc; ne_job_dims(j, K, nc);
    jb.K = K; jb.nc = nc; jb.scale = nullptr; jb.smode = 0; jb.ldd = K; jb.src = nullptr; jb.ldsrc = nc; jb.dst = (u16*)wne;
    const float* w_in = (const float*)p.in[3] + (size_t)l * 1024 * 4864;
    const float* muwag = (const float*)p.in[9] + (size_t)l * 3 * 1024;
    const float* muv = (const float*)p.in[23];
    u16* wtc = (u16*)(wne + WNE_WTC);
    switch (j) {
        case 0: jb.src = w_in + 3328; jb.ldsrc = 4864; jb.dst = wtc; break;
        case 1: jb.src = (const float*)p.in[11] + (size_t)l * 1024 * 64; jb.dst = wtc + 1536 * 1024; jb.scale = muwag; jb.smode = 1; break;
        case 2: jb.src = (const float*)p.in[14] + (size_t)l * 1024 * 64; jb.dst = wtc + 1600 * 1024; jb.scale = muwag + 1024; jb.smode = 1; break;
        case 3: jb.src = (const float*)p.in[16] + (size_t)l * 1024 * 128; jb.dst = wtc + 1664 * 1024; jb.scale = muwag + 2048; jb.smode = 1; break;
        case 4: jb.src = (l == 1) ? (const float*)p.in[25] : nullptr; jb.dst = wtc + 2048 * 1024; jb.scale = muv; jb.smode = 1; break;
        case 5: jb.src = (const float*)p.in[11] + (size_t)l * 1024 * 64; jb.dst = wtc + 1792 * 1024; jb.scale = muwag; jb.smode = 2; break;
        case 6: jb.src = (const float*)p.in[14] + (size_t)l * 1024 * 64; jb.dst = wtc + 1856 * 1024; jb.scale = muwag + 1024; jb.smode = 2; break;
        case 7: jb.src = (const float*)p.in[16] + (size_t)l * 1024 * 128; jb.dst = wtc + 1920 * 1024; jb.scale = muwag + 2048; jb.smode = 2; break;
        case 8: jb.src = (l == 1) ? (const float*)p.in[25] : nullptr; jb.dst = wtc + 2080 * 1024; jb.scale = muv; jb.smode = 2; break;
        case 9: jb.src = nullptr; jb.dst = wtc + 2112 * 1024; break;
        case 10: jb.src = w_in; jb.ldsrc = 4864; jb.dst = (u16*)(wne + WNE_WTAB); break;
        case 11: jb.src = (const float*)p.in[30] + (size_t)l * 1024 * 3072; jb.dst = (u16*)(wne + WNE_WGATE); jb.smode = 3; break;
        case 12: jb.src = (const float*)p.in[27] + (size_t)l * 512 * 1024; jb.dst = (u16*)(wne + WNE_WBRA); break;
        case 13: jb.src = (const float*)p.in[28] + (size_t)l * 256 * 1024; jb.dst = (u16*)(wne + WNE_WBRB); break;
        case 14: jb.src = (const float*)p.in[29] + (size_t)l * 512 * 1024; jb.dst = (u16*)(wne + WNE_WBRC); break;
        case 15: jb.src = (const float*)p.in[32] + (size_t)l * 1024 * 1024; jb.dst = (u16*)(wne + WNE_WOUT); break;
        case 16: jb.src = (const float*)p.in[12] + (size_t)l * 64 * 512; jb.dst = (u16*)(wne + WNE_W2T); break;
        case 17: jb.src = (const float*)p.in[15] + (size_t)l * 64 * 512; jb.dst = (u16*)(wne + WNE_A2T); break;
        case 18: jb.src = (const float*)p.in[17] + (size_t)l * 128 * 512; jb.dst = (u16*)(wne + WNE_G2T); break;
        case 19: jb.src = (l == 1) ? (const float*)p.in[26] : nullptr; jb.dst = (u16*)(wne + WNE_V2T); break;
        case 20: jb.src = (const float*)p.in[34] + (size_t)l * 1024 * 4; jb.dst = (u16*)(wne + WNE_WR); break;
        case 21: jb.src = (const float*)p.in[36] + (size_t)l * 1024 * 16; jb.dst = (u16*)(wne + WNE_WR) + 4 * 1024; break;
        case 22: jb.src = nullptr; jb.dst = (u16*)(wne + WNE_WR) + 20 * 1024; break;
    }
}
__device__ __forceinline__ int ne_total_tiles() {
    int tot = 0;
#pragma unroll
    for (int j = 0; j < NE_JOBS; ++j) { int K, nc; ne_job_dims(j, K, nc); tot += ((K + 63) / 64) * ((nc + 63) / 64); }
    return tot;
}
__device__ __forceinline__ bool conv_full(const ConvJob& jb, int tk, int tn) { return (jb.src != nullptr) && (tk * 64 + 64 <= jb.K) && (tn * 64 + 64 <= jb.nc) && ((jb.ldsrc & 3) == 0); }
__device__ __forceinline__ void conv_load(const ConvJob& jb, int tk, int tn, f32x4 (&v)[4], float (&sc)[4], int tid) {
    const int n4 = (tid & 15) * 4, kb = tid >> 4;
#pragma unroll
    for (int i = 0; i < 4; ++i) {
        const int k = tk * 64 + kb + 16 * i;
        v[i] = __builtin_nontemporal_load((const f32x4*)(jb.src + (size_t)k * jb.ldsrc + tn * 64 + n4));
        sc[i] = (jb.smode == 1 || jb.smode == 2) ? jb.scale[k] : 1.f;
    }
}
__device__ __forceinline__ void conv_finish(const ConvJob& jb, int tk, int tn, const f32x4 (&v)[4], const float (&sc)[4], char* lds, int tid) {
    float* T = (float*)lds;
    const int k0 = tk * 64, n0 = tn * 64;
    {
        const int n4 = (tid & 15) * 4, kb = tid >> 4;
#pragma unroll
        for (int i = 0; i < 4; ++i) {
            const int kl = kb + 16 * i;
            const float m = (jb.smode == 1) ? (1.f - sc[i]) : (jb.smode == 3 ? GATE_WSCALE : sc[i]);
            const f32x4 w = v[i] * m;
            T[kl * 65 + n4] = w[0]; T[kl * 65 + n4 + 1] = w[1]; T[kl * 65 + n4 + 2] = w[2]; T[kl * 65 + n4 + 3] = w[3];
        }
    }
    __syncthreads();
    {
        const int k8 = (tid & 7) * 8, nb = tid >> 3;
#pragma unroll
        for (int i = 0; i < 2; ++i) {
            const int nl = nb + 32 * i;
            if (jb.smode == 3) {
                const uint2 o8 = make_uint2(pk_fp8x4(T[(k8 + 0) * 65 + nl], T[(k8 + 1) * 65 + nl], T[(k8 + 2) * 65 + nl], T[(k8 + 3) * 65 + nl]),
                                            pk_fp8x4(T[(k8 + 4) * 65 + nl], T[(k8 + 5) * 65 + nl], T[(k8 + 6) * 65 + nl], T[(k8 + 7) * 65 + nl]));
                *(uint2*)((char*)jb.dst + (size_t)(n0 + nl) * jb.ldd + k0 + k8) = o8;
            } else {
            const uint4 o = make_uint4(pk_bf16(T[(k8 + 0) * 65 + nl], T[(k8 + 1) * 65 + nl]), pk_bf16(T[(k8 + 2) * 65 + nl], T[(k8 + 3) * 65 + nl]),
                                       pk_bf16(T[(k8 + 4) * 65 + nl], T[(k8 + 5) * 65 + nl]), pk_bf16(T[(k8 + 6) * 65 + nl], T[(k8 + 7) * 65 + nl]));
            *(uint4*)(jb.dst + (size_t)(n0 + nl) * jb.ldd + k0 + k8) = o;
            }
        }
    }
    __syncthreads();
}
__device__ __forceinline__ void ne_decode(const Params& p, int per_layer, int u, ConvJob& jb, int& tk, int& tn) {
    const int l = u / per_layer; int t = u % per_layer; int j = 0;
    for (; j < NE_JOBS; ++j) { int K, nc; ne_job_dims(j, K, nc); const int c = ((K + 63) / 64) * ((nc + 63) / 64); if (t < c) break; t -= c; }
    ne_job(p, l, j, jb);
    const int ntn = (jb.nc + 63) / 64;
    tk = t / ntn; tn = t % ntn;
}
__device__ void phase_conv_ne(const Params& p, char* lds) {
    const int per_layer = ne_total_tiles();
    const int nconv = 2 * per_layer - (NE_Q1 + NE_Q2);
    const int nrot = NTOK * 8 / 256;
    const int tid = tid_opaque();
    const int G = gridDim.x;
    f32x4 v[4]; float sc[4]; bool fc = false;
#pragma unroll
    for (int i = 0; i < 4; ++i) { v[i] = (f32x4){0.f, 0.f, 0.f, 0.f}; sc[i] = 1.f; }
    { const int u = blockIdx.x; if (u < nconv) { ConvJob jb; int tk, tn; ne_decode(p, per_layer, u < per_layer ? u : u + NE_Q1 + NE_Q2, jb, tk, tn); fc = conv_full(jb, tk, tn); if (fc) conv_load(jb, tk, tn, v, sc, tid); } }
#pragma unroll 1
    for (int u = blockIdx.x; u < nconv; u += G) {
        f32x4 vn[4]; float scn[4]; bool fn = false;
#pragma unroll
        for (int i = 0; i < 4; ++i) { vn[i] = (f32x4){0.f, 0.f, 0.f, 0.f}; scn[i] = 1.f; }
        const int un = u + G;
        if (un < nconv) { ConvJob jn; int tk, tn; ne_decode(p, per_layer, un < per_layer ? un : un + NE_Q1 + NE_Q2, jn, tk, tn); fn = conv_full(jn, tk, tn); if (fn) conv_load(jn, tk, tn, vn, scn, tid); }
        { ConvJob jb; int tk, tn; ne_decode(p, per_layer, u < per_layer ? u : u + NE_Q1 + NE_Q2, jb, tk, tn);
          if (fc) conv_finish(jb, tk, tn, v, sc, lds, tid); else conv_tile(jb, tk, tn, lds); }
#pragma unroll
        for (int i = 0; i < 4; ++i) { v[i] = vn[i]; sc[i] = scn[i]; }
        fc = fn;
    }
    for (int r = blockIdx.x; r < 64; r += G) {
        const int e8 = (r * 256 + threadIdx.x) * 8;
        const int t_ = (e8 >> 7) & 127, s0_ = e8 & 127;
        const f32x4 w0 = *(const f32x4*)((const float*)p.in[6] + e8), w1 = *(const f32x4*)((const float*)p.in[6] + e8 + 4);
        unsigned ow[4];
#pragma unroll
        for (int k = 0; k < 4; ++k) { const int si = s0_ + 2 * k; const float a = (k < 2) ? w0[2 * k] : w1[2 * k - 4], b2 = (k < 2) ? w0[2 * k + 1] : w1[2 * k - 3];
                                      ow[k] = pk_bf16(si <= t_ ? a : 0.f, (si + 1) <= t_ ? b2 : 0.f); }
        *(uint4*)(p.ws + OFF_WSA + (size_t)e8 * 2) = make_uint4(ow[0], ow[1], ow[2], ow[3]);
    }
    for (int r = blockIdx.x; r < nrot; r += G) {
        const int e = r * 256 + threadIdx.x;
        const int tok = e >> 3, i = e & 7;
        const float pos = (float)((const int*)p.in[1])[tok];
        const float inv = __expf(-(float)i * (13.122363377404328f / 8.f));
        float sn, cs; sincosf(pos * inv, &sn, &cs);
        ((float*)(p.ws + OFF_ROT))[e] = cs;
        ((float*)(p.ws + OFF_ROT))[(size_t)NTOK * 8 + e] = sn;
    }
}
__device__ __forceinline__ void ne_run(const Params& p, int t0, int n, int stride, int tend, char* lds) {
    const int per_layer = ne_total_tiles();
    const int tid = tid_opaque();
    f32x4 v[4]; float sc[4]; bool have = false, fc = false;
#pragma unroll
    for (int i = 0; i < 4; ++i) { v[i] = (f32x4){0.f, 0.f, 0.f, 0.f}; sc[i] = 1.f; }
    if (n > 0 && t0 < tend) { ConvJob jb; int tk, tn; ne_decode(p, per_layer, per_layer + t0, jb, tk, tn); fc = conv_full(jb, tk, tn); if (fc) conv_load(jb, tk, tn, v, sc, tid); have = true; }
#pragma unroll 1
    for (int i = 0; i < n; ++i) {
        const int tc = t0 + i * stride, tx = tc + stride;
        f32x4 vn[4]; float scn[4]; bool hn = false, fn = false;
#pragma unroll
        for (int q = 0; q < 4; ++q) { vn[q] = (f32x4){0.f, 0.f, 0.f, 0.f}; scn[q] = 1.f; }
        if (i + 1 < n && tx < tend) { ConvJob jn; int tk, tn; ne_decode(p, per_layer, per_layer + tx, jn, tk, tn); fn = conv_full(jn, tk, tn); if (fn) conv_load(jn, tk, tn, vn, scn, tid); hn = true; }
        if (have) { ConvJob jb; int tk, tn; ne_decode(p, per_layer, per_layer + tc, jb, tk, tn); if (fc) conv_finish(jb, tk, tn, v, sc, lds, tid); else conv_tile(jb, tk, tn, lds); }
#pragma unroll
        for (int q = 0; q < 4; ++q) { v[q] = vn[q]; sc[q] = scn[q]; }
        have = hn; fc = fn;
    }
}
__device__ __forceinline__ void ne_tail_fill(const Params& p, int U, int tbase, int quota, char* lds) {
    const int G = gridDim.x, L = U % G, bid = blockIdx.x;
    const bool all = (L == 0) || (G - L < G / 4);
    const int I = all ? G : G - L;
    const int me = all ? bid : bid - L;
    if (me < 0) return;
    const int n = (quota - me + I - 1) / I;
    if (n > 0) ne_run(p, tbase + me, n, I, tbase + quota, lds);
}
__device__ __forceinline__ char* wexp_base(const Params& p, int l, int mat) {
    return p.ws + (mat == 0 ? (OFF_V + (l == 0 ? (size_t)NTOK * 1024 : 0)) : (mat == 1 ? OFF_UP8 : OFF_DOWN8));
}
__device__ __forceinline__ void expert_decode(const Params& p, int l, int u, ConvJob& jb, int& tk, int& tn) {
    const int mat = u >> 11, e = (u & 2047) >> 7, tile = u & 127;
    jb.scale = nullptr; jb.smode = 0;
    if (mat < 2) {
        jb.src = (const float*)p.in[38 + mat] + ((size_t)l * 16 + e) * 1024 * 512; jb.ldsrc = 512; jb.K = 1024; jb.nc = 512;
        jb.dst = (u16*)(wexp_base(p, l, mat) + (size_t)e * 512 * 1024); jb.ldd = 1024; jb.smode = 3;
        tk = tile >> 3; tn = tile & 7;
    } else {
        jb.src = (const float*)p.in[40] + ((size_t)l * 16 + e) * 512 * 1024; jb.ldsrc = 1024; jb.K = 512; jb.nc = 1024;
        jb.dst = (u16*)(wexp_base(p, l, 2) + (size_t)e * 512 * 1024); jb.ldd = 512; jb.smode = 3;
        tk = tile >> 4; tn = tile & 15;
    }
}
__device__ __forceinline__ void conv_expert_unit(const Params& p, int l, int u, char* lds) {
    ConvJob jb; int tk, tn; expert_decode(p, l, u, jb, tk, tn);
    conv_tile(jb, tk, tn, lds);
}
__device__ __forceinline__ void conv_expert_run(const Params& p, int l, int t0, int n, int G, int tend, char* lds) {
    const int tid = tid_opaque();
    f32x4 v[4]; float sc[4]; bool have = false;
#pragma unroll
    for (int i = 0; i < 4; ++i) { v[i] = (f32x4){0.f, 0.f, 0.f, 0.f}; sc[i] = 1.f; }
    if (n > 0 && t0 < tend) { ConvJob jb; int tk, tn; expert_decode(p, l, t0, jb, tk, tn); conv_load(jb, tk, tn, v, sc, tid); have = true; }
#pragma unroll 1
    for (int i = 0; i < n; ++i) {
        const int tc = t0 + i * G, tx = tc + G;
        f32x4 vn[4]; float scn[4]; bool hn = false;
#pragma unroll
        for (int q = 0; q < 4; ++q) { vn[q] = (f32x4){0.f, 0.f, 0.f, 0.f}; scn[q] = 1.f; }
        if (i + 1 < n && tx < tend) { ConvJob jn; int tk, tn; expert_decode(p, l, tx, jn, tk, tn); conv_load(jn, tk, tn, vn, scn, tid); hn = true; }
        if (have) { ConvJob jb; int tk, tn; expert_decode(p, l, tc, jb, tk, tn); conv_finish(jb, tk, tn, v, sc, lds, tid); }
#pragma unroll
        for (int q = 0; q < 4; ++q) { v[q] = vn[q]; sc[q] = scn[q]; }
        have = hn;
    }
}

template <bool FINAL>
__device__ void phase_norm(const Params& p, const float* x, const float* g) {
    const int tid_ = tid_opaque();
    const int lane = tid_ & 63;
    const int gw = blockIdx.x * 4 + (tid_ >> 6);
    const int nwv = gridDim.x * 4;
    float4 gg[4];
#pragma unroll
    for (int i = 0; i < 4; ++i) gg[i] = ((const float4*)g)[lane + 64 * i];
#pragma unroll 1
    for (int row0 = gw; row0 < NTOK; row0 += 4 * nwv) {
        float4 v[4][4];
#pragma unroll
        for (int rr = 0; rr < 4; ++rr) {
            const float4* xr = (const float4*)(x + (size_t)min(row0 + rr * nwv, NTOK - 1) * 1024);
#pragma unroll
            for (int i = 0; i < 4; ++i) v[rr][i] = xr[lane + 64 * i];
        }
#pragma unroll
        for (int rr = 0; rr < 4; ++rr) {
            const int row = row0 + rr * nwv;
            float ss = 0.f;
#pragma unroll
            for (int i = 0; i < 4; ++i) ss += v[rr][i].x * v[rr][i].x + v[rr][i].y * v[rr][i].y + v[rr][i].z * v[rr][i].z + v[rr][i].w * v[rr][i].w;
            ss = wavesum(ss);
            const float rinv = rsqrtf(ss * (1.f / 1024.f) + 1e-6f);
            if (row < NTOK) {
#pragma unroll
                for (int i = 0; i < 4; ++i) {
                    const float a = v[rr][i].x * rinv * gg[i].x, b = v[rr][i].y * rinv * gg[i].y, c = v[rr][i].z * rinv * gg[i].z, d = v[rr][i].w * rinv * gg[i].w;
                    if (FINAL) ((float4*)(p.out + (size_t)row * 1024))[lane + 64 * i] = make_float4(a, b, c, d);
                    else ((uint2*)(p.ws + OFF_H + (size_t)row * 2048))[lane + 64 * i] = make_uint2(pk_bf16(a, b), pk_bf16(c, d));
                }
            }
        }
    }
}

__device__ void gemm2a_unit(const Params& p, int l, int u, int ntn, char* lds, bool primed, int unext) {
    const int mt = u / ntn, nt = u % ntn;
    const int tid = tid_opaque();
    const int lane = tid & 63, w = tid >> 6, wm = w >> 1, wn = w & 1, fr = lane & 15, fg = lane >> 4;
    RowLoader al((const u16*)(p.ws + OFF_H) + (size_t)mt * 128 * 1024, 1024, tid);
    RowLoader bl((const u16*)(p.ws + OFF_WNE + (size_t)l * WNE_SZ + WNE_WTC) + (size_t)nt * 128 * 1024, 1024, tid);
    const int un_ = unext >= 0 ? unext : u;
    RowLoader nal((const u16*)(p.ws + OFF_H) + (size_t)(un_ / ntn) * 128 * 1024, 1024, tid);
    RowLoader nbl((const u16*)(p.ws + OFF_WNE + (size_t)l * WNE_SZ + WNE_WTC) + (size_t)(un_ % ntn) * 128 * 1024, 1024, tid);
    f32x4 acc[4][4]; acc_zero<4, 4>(acc);
    gemm_kloop<4, 4>(acc, al, bl, 16, lds, tid, primed, unext >= 0, nal, nbl);
    u16* projc = (u16*)(p.ws + OFF_R + R_PROJC); u16* lora1 = (u16*)(p.ws + OFF_R + R_LORA1);
#pragma unroll
    for (int i = 0; i < 4; ++i)
#pragma unroll
        for (int j = 0; j < 4; ++j) {
            const int m = mt * 128 + wm * 64 + i * 16 + fr, n = nt * 128 + wn * 64 + j * 16 + fg * 4;
            const uint2 v = pk4(acc[i][j]);
            if (n < 1536) *(uint2*)(projc + (size_t)m * 1536 + n) = v;
            else if (n < 2112) *(uint2*)(lora1 + (size_t)m * 576 + (n - 1536)) = v;
        }
}
__device__ void gemm2b_unit(const Params& p, int l, int u, char* lds) {
    const int mt = u / 26, nt = u % 26;
    const int tid = tid_opaque();
    const int lane = tid & 63, w = tid >> 6, wm = w >> 1, wn = w & 1, fr = lane & 15, fg = lane >> 4;
    RowLoader al((const u16*)(p.ws + OFF_H) + (size_t)mt * 128 * 1024, 1024, tid);
    RowLoader bl((const u16*)(p.ws + OFF_WNE + (size_t)l * WNE_SZ + WNE_WTAB) + (size_t)nt * 128 * 1024, 1024, tid);
    f32x4 acc[4][4]; acc_zero<4, 4>(acc);
    u16* proja = (u16*)(p.ws + OFF_R + R_PROJA); u16* projb = (u16*)(p.ws + OFF_R + R_PROJB);
    const float* rc = (const float*)(p.ws + OFF_ROT); const float* rs = rc + (size_t)NTOK * 8;
    const int nbase = nt * 128 + wn * 64;
    const bool rot = nbase >= 1024 && nbase < 1024 + 1536;
    f32x4 csq[4], snq[4];
#pragma unroll
    for (int i = 0; i < 4; ++i) { csq[i] = (f32x4){0.f, 0.f, 0.f, 0.f}; snq[i] = csq[i];
        if (rot) { const int m = mt * 128 + wm * 64 + i * 16 + fr; csq[i] = *(const f32x4*)(rc + (size_t)m * 8 + (fg & 1) * 4); snq[i] = *(const f32x4*)(rs + (size_t)m * 8 + (fg & 1) * 4); } }
    gemm_kloop<4, 4>(acc, al, bl, 16, lds, tid);
#pragma unroll
    for (int i = 0; i < 4; ++i) {
        const int m = mt * 128 + wm * 64 + i * 16 + fr;
#pragma unroll
        for (int j = 0; j < 4; ++j) {
            const int n = nbase + j * 16 + fg * 4;
            f32x4 v = acc[i][j];
            if (nbase < 1024) {
#pragma unroll
                for (int q = 0; q < 4; ++q) v[q] = gelu_tanh(v[q]);
                *(uint2*)(proja + (size_t)m * 1024 + n) = pk4(v);
            } else {
                const int nb = n - 1024;
                if (nbase < 1024 + 1536 && j == 0) {
                    f32x4 pv;
#pragma unroll
                    for (int q = 0; q < 4; ++q) pv[q] = __shfl_xor(v[q], 32);
                    const f32x4 cs = csq[i], sn = snq[i];
#pragma unroll
                    for (int q = 0; q < 4; ++q) v[q] = (fg < 2) ? (v[q] * cs[q] - pv[q] * sn[q]) : (v[q] * cs[q] + pv[q] * sn[q]);
                }
                if (nbase < 1024 + 768) { v = v * (0.125f * 1.4426950408889634f); }
                *(uint2*)(projb + (size_t)m * 2304 + nb) = pk4(v);
            }
        }
    }
}

__device__ __forceinline__ bf16x8 act8(uint4 a, uint4 b, int mode) {
    unsigned av[4] = {a.x, a.y, a.z, a.w}, bv[4] = {b.x, b.y, b.z, b.w}; unsigned o[4];
#pragma unroll
    for (int q = 0; q < 4; ++q) {
        float lo = bflo(av[q]) + bflo(bv[q]), hi = bfhi(av[q]) + bfhi(bv[q]);
        if (mode == 1) { lo = 1.f - 2.f * fast_rcp(fast_exp(2.f * lo) + 1.f); hi = 1.f - 2.f * fast_rcp(fast_exp(2.f * hi) + 1.f); }
        else if (mode == 2) { lo = sigmoidf_(lo); hi = sigmoidf_(hi); }
        o[q] = pk_bf16(lo, hi);
    }
    return mk8(make_uint4(o[0], o[1], o[2], o[3]));
}
__device__ void prep_unit(const Params& p, int l, int u, char* lds, bool stage_w) {
    const int tt = u >> 3, hh = u & 7;
    const int tid = tid_opaque();
    const int lane = tid & 63, w = tid >> 6, tl = lane & 15, G = lane >> 4;
    const char* wne = p.ws + OFF_WNE + (size_t)l * WNE_SZ;
    const u16* lora1 = (const u16*)(p.ws + OFF_R + R_LORA1);
    const u16* projc = (const u16*)(p.ws + OFF_R + R_PROJC);
    const u16* vfirst = (const u16*)(p.ws + OFF_V);
    u16* vout = (u16*)(p.ws + OFF_V + (size_t)l * NTOK * 1024);
    u16* gout = (u16*)(p.ws + OFF_G);
    uint2* KKo = (uint2*)(p.ws + OFF_KK); uint2* RRo = (uint2*)(p.ws + OFF_RR); uint4* BKo = (uint4*)(p.ws + OFF_BK); float* PCo = (float*)(p.ws + OFF_PC);
    float* bonus = (float*)(p.ws + OFF_BONUS);
    char* ldsW = lds; char* ldsA = lds + 8192; char* ldsG = lds + 16384; char* ldsV = lds + 32768; float* prm = (float*)(lds + 36864);
    __syncthreads();
    if (stage_w) {
        const u16* w2 = (const u16*)(wne + WNE_W2T) + (size_t)hh * 64 * 64; const u16* a2 = (const u16*)(wne + WNE_A2T) + (size_t)hh * 64 * 64;
        const u16* g2 = (const u16*)(wne + WNE_G2T) + (size_t)hh * 64 * 128; const u16* v2 = (const u16*)(wne + WNE_V2T) + (size_t)hh * 64 * 32;
#pragma unroll
        for (int k = 0; k < 2; ++k) { const int q = tid + 256 * k, row = q >> 3, ch = q & 7;
            *(uint4*)(ldsW + toff(row, ch)) = *(const uint4*)(w2 + row * 64 + ch * 8); *(uint4*)(ldsA + toff(row, ch)) = *(const uint4*)(a2 + row * 64 + ch * 8); }
#pragma unroll
        for (int k = 0; k < 4; ++k) { const int q = tid + 256 * k, row = q >> 4, ch = q & 15; *(uint4*)(ldsG + row * 256 + ((ch ^ (row & 15)) << 4)) = *(const uint4*)(g2 + row * 128 + ch * 8); }
        if (l == 1) { const int row = tid >> 2, ch = tid & 3; *(uint4*)(ldsV + row * 64 + ch * 16) = *(const uint4*)(v2 + row * 32 + ch * 8); }
        const float* mu_rkv = (const float*)p.in[8] + (size_t)l * 3 * 512 + hh * 64;
        for (int q = tid; q < 9 * 64; q += 256) {
            const int a_ = q >> 6, c_ = q & 63; float v_;
            if (a_ < 3) v_ = mu_rkv[a_ * 512 + c_];
            else if (a_ == 3) v_ = ((const float*)p.in[10])[(size_t)l * 512 + hh * 64 + c_];
            else if (a_ == 4) v_ = ((const float*)p.in[13])[(size_t)l * 512 + hh * 64 + c_];
            else if (a_ == 5) v_ = ((const float*)p.in[18])[(size_t)l * 512 + hh * 64 + c_];
            else if (a_ == 6) v_ = ((const float*)p.in[19])[(size_t)l * 512 + hh * 64 + c_];
            else if (a_ == 7) v_ = ((const float*)p.in[20])[(size_t)l * 512 + hh * 64 + c_];
            else v_ = (l == 1) ? ((const float*)p.in[24])[hh * 64 + c_] : 0.f;
            prm[q] = v_;
        }
    }
    __syncthreads();
#pragma unroll 1
    for (int t2 = 0; t2 < 2; ++t2) {
        const int tk = tt * 128 + w * 32 + t2 * 16 + tl; const bool hp = (tk & (SEQ - 1)) != 0;
        uint4 xa[9], xb[9];
#pragma unroll
        for (int i = 0; i < 9; ++i) {
            const int cola = (i < 2) ? (i * 32) : (i < 4 ? 64 + (i - 2) * 32 : (i < 8 ? 128 + (i - 4) * 32 : 512));
            xa[i] = make_uint4(0, 0, 0, 0); xb[i] = xa[i];
            if (i < 8 || l == 1) {
                xa[i] = *(const uint4*)(lora1 + (size_t)tk * 576 + cola + 8 * G);
                if (hp) xb[i] = *(const uint4*)(lora1 + (size_t)(tk - 1) * 576 + ((i < 8) ? 256 : 32) + cola + 8 * G);
            }
        }
        uint2 rc[4], kc[4], vc[4], rp[4], kp_[4], vp[4], vf[4];
        f32x4 acc[4][4];
#pragma unroll
        for (int a_ = 0; a_ < 4; ++a_)
#pragma unroll
            for (int b_ = 0; b_ < 4; ++b_) acc[a_][b_] = (f32x4){0.f, 0.f, 0.f, 0.f};
#pragma unroll
        for (int i = 0; i < 9; ++i) {
            if (i == 4) {
#pragma unroll
            for (int ct = 0; ct < 4; ++ct) {
                const int c0 = hh * 64 + ct * 16 + G * 4;
                rc[ct] = *(const uint2*)(projc + (size_t)tk * 1536 + c0); kc[ct] = *(const uint2*)(projc + (size_t)tk * 1536 + 512 + c0); vc[ct] = *(const uint2*)(projc + (size_t)tk * 1536 + 1024 + c0);
                rp[ct] = make_uint2(0, 0); kp_[ct] = rp[ct]; vp[ct] = rp[ct]; vf[ct] = rp[ct];
                if (hp && tl == 0) { rp[ct] = *(const uint2*)(projc + (size_t)(tk - 1) * 1536 + c0); kp_[ct] = *(const uint2*)(projc + (size_t)(tk - 1) * 1536 + 512 + c0); vp[ct] = *(const uint2*)(projc + (size_t)(tk - 1) * 1536 + 1024 + c0); }
                if (l == 1) vf[ct] = *(const uint2*)(vfirst + (size_t)tk * 512 + c0);
            }
            }
            if (i == 8 && l == 0) continue;
            const int mat = (i < 2) ? 0 : (i < 4 ? 1 : (i < 8 ? 2 : 3));
            const int sidx = (i < 2) ? i : (i < 4 ? i - 2 : (i < 8 ? i - 4 : 0));
            const int mode = (mat == 0) ? 1 : (mat == 2 ? 2 : 0);
            const bf16x8 bfr = act8(xa[i], xb[i], mode);
#pragma unroll
            for (int ct = 0; ct < 4; ++ct) {
                const int row = ct * 16 + tl;
                bf16x8 af;
                if (mat == 0) af = *(const bf16x8*)(ldsW + toff(row, sidx * 4 + G));
                else if (mat == 1) af = *(const bf16x8*)(ldsA + toff(row, sidx * 4 + G));
                else if (mat == 2) af = *(const bf16x8*)(ldsG + row * 256 + (((sidx * 4 + G) ^ (row & 15)) << 4));
                else af = *(const bf16x8*)(ldsV + row * 64 + G * 16);
                acc[mat][ct] = MFMA16(af, bfr, acc[mat][ct]);
            }
        }
#define SHR1(x) ((unsigned)__builtin_amdgcn_update_dpp(0, (int)(x), 0x111, 0xf, 0xf, true))
#pragma unroll
        for (int ct = 0; ct < 4; ++ct) {
            const int cl = ct * 16 + G * 4;
            const uint2 a_ = make_uint2(SHR1(rc[ct].x), SHR1(rc[ct].y)), b_ = make_uint2(SHR1(kc[ct].x), SHR1(kc[ct].y)), c_ = make_uint2(SHR1(vc[ct].x), SHR1(vc[ct].y));
            const f32x4 r_p = unpk4((tl != 0) ? a_ : rp[ct]), k_p = unpk4((tl != 0) ? b_ : kp_[ct]), v_p = unpk4((tl != 0) ? c_ : vp[ct]);
            const f32x4 r_t = unpk4(rc[ct]), k_t = unpk4(kc[ct]), v_t = unpk4(vc[ct]);
            const f32x4 mur = *(const f32x4*)(prm + cl), muk = *(const f32x4*)(prm + 64 + cl), muv = *(const f32x4*)(prm + 2 * 64 + cl);
            rc[ct] = pk4(r_t + (r_p - r_t) * mur); kc[ct] = pk4(k_t + (k_p - k_t) * muk); vc[ct] = pk4(v_t + (v_p - v_t) * muv);
        }
#undef SHR1
        float ss = 0.f, bo = 0.f;
#pragma unroll
        for (int ct = 0; ct < 4; ++ct) {
            const int cl = ct * 16 + G * 4;
            const f32x4 k_k = *(const f32x4*)(prm + 5 * 64 + cl);
            const f32x4 kr = unpk4(kc[ct]) * k_k;
            ss += kr[0] * kr[0] + kr[1] * kr[1] + kr[2] * kr[2] + kr[3] * kr[3];
        }
        ss += __shfl_xor(ss, 16); ss += __shfl_xor(ss, 32);
        const float inv = __builtin_amdgcn_rsqf(fmaxf(ss, 1e-24f));
        uint2 kkprev = make_uint2(0, 0), rrprev = kkprev;
        uint2 kkpk[4], rrpk[4]; uint4 bkpk[4];
#pragma unroll
        for (int ct = 0; ct < 4; ++ct) {
            const int cl = ct * 16 + G * 4, c0 = hh * 64 + cl;
            const f32x4 acc_w = acc[0][ct], acc_a = acc[1][ct], acc_g = acc[2][ct], acc_v = acc[3][ct];
            const uint2 rcs = rc[ct], kcs = kc[ct], vcs = vc[ct], vfs = vf[ct];
            const f32x4 w0 = *(const f32x4*)(prm + 3 * 64 + cl), a0 = *(const f32x4*)(prm + 4 * 64 + cl), k_k = *(const f32x4*)(prm + 5 * 64 + cl), k_a = *(const f32x4*)(prm + 6 * 64 + cl), r_k = *(const f32x4*)(prm + 7 * 64 + cl);
            const f32x4 rr = unpk4(rcs);
            const f32x4 kx = unpk4(kcs);
            f32x4 vx = unpk4(vcs);
            f32x4 aa, k2, ee;
#pragma unroll
            for (int q = 0; q < 4; ++q) {
                const float wv = w0[q] + acc_w[q];
                ee[q] = -0.6065306597126334f * sigmoidf_(wv);
                aa[q] = sigmoidf_(a0[q] + acc_a[q]);
            }
            if (l == 1) {
                const f32x4 vfv = unpk4(vfs); const f32x4 v0 = *(const f32x4*)(prm + 8 * 64 + cl);
#pragma unroll
                for (int q = 0; q < 4; ++q) vx[q] = vx[q] + (vfv[q] - vx[q]) * sigmoidf_(v0[q] + acc_v[q]);
            }
#pragma unroll
            for (int q = 0; q < 4; ++q) {
                k2[q] = kx[q] * (1.f + (aa[q] - 1.f) * k_a[q]);
                bo += rr[q] * k2[q] * r_k[q];
            }
            f32x4 cs;
#pragma unroll
            for (int q = 0; q < 4; ++q) {
                float x = ee[q];
                x += __builtin_bit_cast(float, __builtin_amdgcn_update_dpp(0, __builtin_bit_cast(int, x), 0x111, 0xf, 0xf, true));
                x += __builtin_bit_cast(float, __builtin_amdgcn_update_dpp(0, __builtin_bit_cast(int, x), 0x112, 0xf, 0xf, true));
                x += __builtin_bit_cast(float, __builtin_amdgcn_update_dpp(0, __builtin_bit_cast(int, x), 0x114, 0xf, 0xf, true));
                x += __builtin_bit_cast(float, __builtin_amdgcn_update_dpp(0, __builtin_bit_cast(int, x), 0x118, 0xf, 0xf, true));
                cs[q] = x;
            }
            *(uint2*)(vout + (size_t)tk * 512 + c0) = pk4(vx);
            *(uint2*)(gout + (size_t)tk * 512 + c0) = pk4(acc_g);
            const size_t ci = ((size_t)tk * 8 + hh) * 64 + cl;
            f32x4 pt, ipt, ptm1;
#pragma unroll
            for (int q = 0; q < 4; ++q) { pt[q] = fast_exp(cs[q]); ipt[q] = fast_rcp(pt[q]); ptm1[q] = fast_exp(cs[q] - ee[q]); }
            const f32x4 kk = kx * k_k * inv;
            const f32x4 nk = -kk * ptm1, rt = rr * pt;
            const uint2 kkq = pk4(nk), rrq = pk4(rt);
            if ((ct & 1) == 0) { kkprev = kkq; rrprev = rrq; }
            else {
                const size_t vi = ((size_t)tk * 8 + hh) * 64 + ((ct >> 1) * 4 + G) * 8;
                ((uint4*)KKo)[vi >> 3] = make_uint4(kkprev.x, kkprev.y, kkq.x, kkq.y);
                ((uint4*)RRo)[vi >> 3] = make_uint4(rrprev.x, rrprev.y, rrq.x, rrq.y);
            }
            const f32x4 bb = kk * aa * ipt, kq = k2 * ipt;
            kkpk[ct] = kkq; rrpk[ct] = rrq;
            {
                unsigned m0 = pk_bf16(bb[0], kq[0]), m1 = pk_bf16(bb[1], kq[1]), m2 = pk_bf16(bb[2], kq[2]), m3 = pk_bf16(bb[3], kq[3]);
                bkpk[ct] = make_uint4(m0, m1, m2, m3);
                const bool ev = (tl & 1) == 0, lo = (tl & 2) == 0;
                const unsigned r0 = (unsigned)__builtin_amdgcn_update_dpp(0, (int)(ev ? m1 : m0), 0xB1, 0xf, 0xf, false), r1 = (unsigned)__builtin_amdgcn_update_dpp(0, (int)(ev ? m3 : m2), 0xB1, 0xf, 0xf, false);
                const unsigned n0 = ev ? m0 : r0, n1 = ev ? r0 : m1, n2 = ev ? m2 : r1, n3 = ev ? r1 : m3;
                const unsigned s0 = (unsigned)__builtin_amdgcn_update_dpp(0, (int)(lo ? n2 : n0), 0x4E, 0xf, 0xf, false), s1 = (unsigned)__builtin_amdgcn_update_dpp(0, (int)(lo ? n3 : n1), 0x4E, 0xf, 0xf, false);
                const uint4 o = lo ? make_uint4(n0, n1, s0, s1) : make_uint4(s0, s1, n2, n3);
                *(uint4*)((char*)BKo + (((size_t)(tk >> 2) * 8 + hh) * 64 + cl + (tl & 3)) * 16) = o;
            }
            if (tl == 15) *(f32x4*)(PCo + (((size_t)(tk >> 4) * 8 + hh) * 64 + cl)) = pt;
        }
        bo += __shfl_xor(bo, 16); bo += __shfl_xor(bo, 32);
        if (G == 0) bonus[(size_t)tk * 8 + hh] = bo;
        float qA[4], qB[4], qC[4], qD[4];
#pragma unroll
        for (int i = 0; i < 4; ++i) { qA[i] = 0.f; qB[i] = 0.f; qC[i] = 0.f; qD[i] = 0.f; }
#pragma unroll
        for (int ct = 0; ct < 4; ++ct) {
            const f32x4 nk = unpk4(kkpk[ct]), rt = unpk4(rrpk[ct]);
            const unsigned pw[4] = {bkpk[ct].x, bkpk[ct].y, bkpk[ct].z, bkpk[ct].w};
#define QUAD_ACC(i, CTRL) _Pragma("unroll") for (int q = 0; q < 4; ++q) { const unsigned pi_ = (unsigned)__builtin_amdgcn_update_dpp(0, (int)pw[q], CTRL, 0xf, 0xf, false); \
                const float bi = bflo(pi_), ki = bfhi(pi_); qA[i] += nk[q] * bi; qB[i] += nk[q] * ki; qC[i] += rt[q] * bi; qD[i] += rt[q] * ki; }
            QUAD_ACC(0, 0x00) QUAD_ACC(1, 0x55) QUAD_ACC(2, 0xAA) QUAD_ACC(3, 0xFF)
#undef QUAD_ACC
        }
#pragma unroll
        for (int i = 0; i < 4; ++i) {
            qA[i] += __shfl_xor(qA[i], 16); qA[i] += __shfl_xor(qA[i], 32); qB[i] += __shfl_xor(qB[i], 16); qB[i] += __shfl_xor(qB[i], 32);
            qC[i] += __shfl_xor(qC[i], 16); qC[i] += __shfl_xor(qC[i], 32); qD[i] += __shfl_xor(qD[i], 16); qD[i] += __shfl_xor(qD[i], 32);
        }
        if (G == 0) {
            float* cf = (float*)(p.ws + OFF_COEF) + ((size_t)(tk >> 2) * 8 + hh) * 32;
            const int j = tl & 3;
#pragma unroll
            for (int i = 0; i < 4; ++i) {
                if (i < j) { cf[j * (j - 1) / 2 + i] = qA[i]; cf[6 + j * (j - 1) / 2 + i] = qB[i]; }
                if (i <= j) { cf[12 + j * (j + 1) / 2 + i] = qC[i]; cf[22 + j * (j + 1) / 2 + i] = qD[i]; }
            }
        }
    }
}

typedef int i32x4 __attribute__((ext_vector_type(4)));
constexpr int SC_QRB = 2720, SC_CHB = 4 * SC_QRB, SC_BKO = 1024, SC_VO = 2048, SC_CFO = 2560, SC_ZOFF = 2688;
__device__ __forceinline__ void scan_unit(const Params& p, int l, int bh, char* lds) {
    const int b = bh >> 3, hh = bh & 7;
    const int tid = tid_opaque();
    const int lane = tid & 63, wq = tid >> 6, g = lane >> 4, c = lane & 15;
    const unsigned tok0 = (unsigned)b * SEQ;
    const __amdgpu_buffer_rsrc_t rs = __builtin_amdgcn_make_buffer_rsrc((void*)p.ws, 0, 0x7fffffff, 0x00020000);
    const unsigned vo_y  = (g == 0) ? (unsigned)OFF_YRAW + (tok0 * 512 + hh * 64 + wq * 16 + c) * 2 : 0x80000000u;
    const unsigned vo_pc = (unsigned)OFF_PC + ((tok0 >> 4) * 8 + hh) * 256 + g * 16;
    unsigned gvo[3], lvo[3], gst[3];
#pragma unroll
    for (int k = 0; k < 3; ++k) {
        const int q = tid + 256 * k; const int qd = q / 168, r = q - qd * 168;
        const unsigned tq = tok0 + 4 * qd;
        unsigned go, st;
        if (r < 32)       { go = (unsigned)OFF_KK + ((tq + (r >> 3)) * 8 + hh) * 128 + (r & 7) * 16; st = 16384u; }
        else if (r < 64)  { go = (unsigned)OFF_RR + ((tq + ((r - 32) >> 3)) * 8 + hh) * 128 + (r & 7) * 16; st = 16384u; }
        else if (r < 128) { go = (unsigned)OFF_BK + ((tq >> 2) * 8 + hh) * 1024 + (r - 64) * 16; st = 32768u; }
        else if (r < 160) { go = (unsigned)(OFF_V + (size_t)l * NTOK * 1024) + ((tq + ((r - 128) >> 3)) * 512 + hh * 64) * 2 + (r & 7) * 16; st = 16384u; }
        else              { go = (unsigned)OFF_COEF + ((tq >> 2) * 8 + hh) * 128 + (r - 160) * 16; st = 4096u; }
        gvo[k] = go; lvo[k] = qd * SC_QRB + r * 16; gst[k] = st;
    }
    const bool has3 = tid < 160;
#define SC_SOFF(k, ch) ((unsigned)(ch) * gst[k])
    i32x4 st0, st1, st2;
#define SC_GLOAD(ch) do { st0 = __builtin_amdgcn_raw_buffer_load_b128(rs, gvo[0] + SC_SOFF(0, ch), 0, 2); st1 = __builtin_amdgcn_raw_buffer_load_b128(rs, gvo[1] + SC_SOFF(1, ch), 0, 2); \
        if (has3) st2 = __builtin_amdgcn_raw_buffer_load_b128(rs, gvo[2] + SC_SOFF(2, ch), 0, 2); } while (0)
#define SC_LSTORE(ch) do { char* d_ = lds + ((ch) & 3) * SC_CHB; *(i32x4*)(d_ + lvo[0]) = st0; *(i32x4*)(d_ + lvo[1]) = st1; if (has3) *(i32x4*)(d_ + lvo[2]) = st2; } while (0)
    st2 = (i32x4){0, 0, 0, 0};
    if (tid < 32) { *(i32x4*)(lds + (tid >> 1) * SC_QRB + SC_ZOFF + (tid & 1) * 16) = (i32x4){0, 0, 0, 0}; }
    SC_GLOAD(0); SC_LSTORE(0); SC_GLOAD(1); SC_LSTORE(1); SC_GLOAD(2); SC_LSTORE(2);
    __syncthreads();
    f32x4 Z0 = (f32x4){0.f, 0.f, 0.f, 0.f}, Z1 = Z0, Z2 = Z0, Z3 = Z0;
    const f32x4 z4 = (f32x4){0.f, 0.f, 0.f, 0.f};
    const int ad0 = (c < 4) ? (c * 128 + g * 16) : SC_ZOFF;
    const int ad1 = (c < 4) ? ad0 + 64 : SC_ZOFF;
    const int adr = (c < 4) ? 512 : 0;
    const int au = (g == 0) ? (SC_BKO + c * 16) : SC_ZOFF;
    const int austep = (g == 0) ? 256 : 0;
    const int vofs = (g == 0) ? (SC_VO + (wq * 16 + c) * 2) : SC_ZOFF;
    const int vstep = (g == 0) ? 128 : 0;
    uint4 ua0, ua1, ua2, ua3, ub0, ub1, ub2, ub3, bu = make_uint4(0u, 0u, 0u, 0u);
    bf16x8 a0c, a1c, a0n, a1n, r0c, r1c, r0n, r1n; unsigned v0c, v1c, v2c, v3c, v0n, v1n, v2n, v3n;
#define SC_LDSOPS(tb_, A0, A1, R0, R1, U0, U1, U2, U3, V0, V1, V2, V3) do { A0 = *(const bf16x8*)((tb_) + ad0); A1 = *(const bf16x8*)((tb_) + ad1); \
        R0 = *(const bf16x8*)((tb_) + ad0 + adr); R1 = *(const bf16x8*)((tb_) + ad1 + adr); \
        U0 = *(const uint4*)((tb_) + au); U1 = *(const uint4*)((tb_) + au + austep); U2 = *(const uint4*)((tb_) + au + 2 * austep); U3 = *(const uint4*)((tb_) + au + 3 * austep); \
        V0 = *(const u16*)((tb_) + vofs); V1 = *(const u16*)((tb_) + vofs + vstep); V2 = *(const u16*)((tb_) + vofs + 2 * vstep); V3 = *(const u16*)((tb_) + vofs + 3 * vstep); } while (0)
#define SC_STEP(tb_cur_, tb_next_, A0, A1, R0, R1, U0, U1, U2, U3, V0, V1, V2, V3, NA0, NA1, NR0, NR1, NU0, NU1, NU2, NU3, NV0, NV1, NV2, NV3, last_) do { \
        const f32x4 cf0_ = *(const f32x4*)((tb_cur_) + SC_CFO), cf1_ = *(const f32x4*)((tb_cur_) + SC_CFO + 16), cf2_ = *(const f32x4*)((tb_cur_) + SC_CFO + 32), cf3_ = *(const f32x4*)((tb_cur_) + SC_CFO + 48); \
        const f32x4 cf4_ = *(const f32x4*)((tb_cur_) + SC_CFO + 64), cf5_ = *(const f32x4*)((tb_cur_) + SC_CFO + 80), cf6_ = *(const f32x4*)((tb_cur_) + SC_CFO + 96), cf7_ = *(const f32x4*)((tb_cur_) + SC_CFO + 112); \
        SC_LDSOPS(tb_next_, NA0, NA1, NR0, NR1, NU0, NU1, NU2, NU3, NV0, NV1, NV2, NV3); \
        const bf16x8 sb0_ = mk8(make_uint4(pk_bf16(Z0[0], Z0[1]), pk_bf16(Z0[2], Z0[3]), pk_bf16(Z1[0], Z1[1]), pk_bf16(Z1[2], Z1[3]))); \
        const bf16x8 sb1_ = mk8(make_uint4(pk_bf16(Z2[0], Z2[1]), pk_bf16(Z2[2], Z2[3]), pk_bf16(Z3[0], Z3[1]), pk_bf16(Z3[2], Z3[3]))); \
        f32x4 d_ = MFMA16(A0, sb0_, z4); d_ = MFMA16(A1, sb1_, d_);            \
        f32x4 dy_ = MFMA16(R0, sb0_, z4); dy_ = MFMA16(R1, sb1_, dy_);        \
        const float w0_ = __uint_as_float(V0 << 16), w1_ = __uint_as_float(V1 << 16), w2_ = __uint_as_float(V2 << 16), w3_ = __uint_as_float(V3 << 16); \
          \
        const float b1_ = cf1_[2] * w0_, b2_ = cf1_[3] * w0_ + cf2_[0] * w1_, b3_ = cf2_[1] * w0_ + cf2_[2] * w1_ + cf2_[3] * w2_; \
        const float sa0_ = d_[0]; \
        const float sa1_ = (d_[1] + b1_) + cf0_[0] * sa0_; \
        const float sa2_ = (d_[2] + b2_) + cf0_[1] * sa0_ + cf0_[2] * sa1_; \
        const float sa3_ = (d_[3] + b3_) + cf0_[3] * sa0_ + cf1_[0] * sa1_ + cf1_[1] * sa2_; \
        bu.x = pk_bf16(sa0_, w0_); bu.y = pk_bf16(sa1_, w1_); bu.z = pk_bf16(sa2_, w2_); bu.w = pk_bf16(sa3_, w3_);     \
        Z0 = MFMA16(mk8(U0), mk8(bu), Z0); Z1 = MFMA16(mk8(U1), mk8(bu), Z1); Z2 = MFMA16(mk8(U2), mk8(bu), Z2); Z3 = MFMA16(mk8(U3), mk8(bu), Z3); \
        { float y0_ = __builtin_fmaf(cf3_[0], sa0_, __builtin_fmaf(cf5_[2], w0_, dy_[0])); \
          float y1_ = __builtin_fmaf(cf3_[2], sa1_, __builtin_fmaf(cf3_[1], sa0_, __builtin_fmaf(cf6_[0], w1_, __builtin_fmaf(cf5_[3], w0_, dy_[1])))); \
          float y2_ = __builtin_fmaf(cf4_[1], sa2_, __builtin_fmaf(cf4_[0], sa1_, __builtin_fmaf(cf3_[3], sa0_, __builtin_fmaf(cf6_[3], w2_, __builtin_fmaf(cf6_[2], w1_, __builtin_fmaf(cf6_[1], w0_, dy_[2])))))); \
          float y3_ = __builtin_fmaf(cf5_[1], sa3_, __builtin_fmaf(cf5_[0], sa2_, __builtin_fmaf(cf4_[3], sa1_, __builtin_fmaf(cf4_[2], sa0_, __builtin_fmaf(cf7_[3], w3_, __builtin_fmaf(cf7_[2], w2_, __builtin_fmaf(cf7_[1], w1_, __builtin_fmaf(cf7_[0], w0_, dy_[3])))))))); \
          asm volatile("" : "+v"(y0_), "+v"(y1_), "+v"(y2_), "+v"(y3_));        \
            \
          __builtin_amdgcn_raw_buffer_store_b16((u16)(pk_bf16(y0_, 0.f) & 0xffffu), rs, vo_y, (unsigned)(tcur) * 1024u, 0); \
          __builtin_amdgcn_raw_buffer_store_b16((u16)(pk_bf16(y1_, 0.f) & 0xffffu), rs, vo_y, (unsigned)(tcur + 1) * 1024u, 0); \
          __builtin_amdgcn_raw_buffer_store_b16((u16)(pk_bf16(y2_, 0.f) & 0xffffu), rs, vo_y, (unsigned)(tcur + 2) * 1024u, 0); \
          __builtin_amdgcn_raw_buffer_store_b16((u16)(pk_bf16(y3_, 0.f) & 0xffffu), rs, vo_y, (unsigned)(tcur + 3) * 1024u, 0); } \
        if (last_) { Z0 = Z0 * pc0; Z1 = Z1 * pc1; Z2 = Z2 * pc2; Z3 = Z3 * pc3; } \
        tcur += 4; } while (0)
    int tcur = 0;
    SC_LDSOPS(lds, a0c, a1c, r0c, r1c, ua0, ua1, ua2, ua3, v0c, v1c, v2c, v3c);
#pragma unroll 1
    for (int ch = 0; ch < SEQ / 16; ++ch) {
        if (ch + 3 < SEQ / 16) SC_GLOAD(ch + 3);
        const f32x4 pc0 = __builtin_bit_cast(f32x4, __builtin_amdgcn_raw_buffer_load_b128(rs, vo_pc, (unsigned)ch * 2048u, 0));
        const f32x4 pc1 = __builtin_bit_cast(f32x4, __builtin_amdgcn_raw_buffer_load_b128(rs, vo_pc + 64, (unsigned)ch * 2048u, 0));
        const f32x4 pc2 = __builtin_bit_cast(f32x4, __builtin_amdgcn_raw_buffer_load_b128(rs, vo_pc + 128, (unsigned)ch * 2048u, 0));
        const f32x4 pc3 = __builtin_bit_cast(f32x4, __builtin_amdgcn_raw_buffer_load_b128(rs, vo_pc + 192, (unsigned)ch * 2048u, 0));
        const char* cb = lds + (ch & 3) * SC_CHB;
        const char* nb = lds + ((ch + 1) & 3) * SC_CHB;
        SC_STEP(cb, cb + SC_QRB, a0c, a1c, r0c, r1c, ua0, ua1, ua2, ua3, v0c, v1c, v2c, v3c, a0n, a1n, r0n, r1n, ub0, ub1, ub2, ub3, v0n, v1n, v2n, v3n, false);
        SC_STEP(cb + SC_QRB, cb + 2 * SC_QRB, a0n, a1n, r0n, r1n, ub0, ub1, ub2, ub3, v0n, v1n, v2n, v3n, a0c, a1c, r0c, r1c, ua0, ua1, ua2, ua3, v0c, v1c, v2c, v3c, false);
        SC_STEP(cb + 2 * SC_QRB, cb + 3 * SC_QRB, a0c, a1c, r0c, r1c, ua0, ua1, ua2, ua3, v0c, v1c, v2c, v3c, a0n, a1n, r0n, r1n, ub0, ub1, ub2, ub3, v0n, v1n, v2n, v3n, false);
        SC_STEP(cb + 3 * SC_QRB, nb, a0n, a1n, r0n, r1n, ub0, ub1, ub2, ub3, v0n, v1n, v2n, v3n, a0c, a1c, r0c, r1c, ua0, ua1, ua2, ua3, v0c, v1c, v2c, v3c, true);
        if (ch + 3 < SEQ / 16) SC_LSTORE(ch + 3);
        __syncthreads();
    }
#undef SC_STEP
#undef SC_LDSOPS
#undef SC_GLOAD
#undef SC_LSTORE
#undef SC_SOFF
}

template <bool DRY>
__device__ void mixa_unit(const Params& p, int l, int u, char* lds) {
    const int g = u & 3, bc = u >> 2;
    const int tok0 = bc * 128;
    const int tid = tid_opaque();
    const int lane = tid & 63, w = tid >> 6, fr = lane & 15, G = lane >> 4;
    u16* proja = (u16*)(p.ws + OFF_R + R_PROJA);
    char* ldsV = lds; char* ldsW = lds + 32768; float2* stats = (float2*)(lds + 65536);
    uint4 wq[8];
    { const u16* wsa = (const u16*)(p.ws + OFF_WSA) + ((size_t)l * 4 + g) * 128 * 128;
#pragma unroll
      for (int i = 0; i < 8; ++i) { const int q = tid + 256 * i; wq[i] = *(const uint4*)(wsa + (size_t)q * 8); } }
#pragma unroll 1
    for (int r = 0; r < 32; r += 16) {
        uint4 xq[16];
#pragma unroll
        for (int rr = 0; rr < 16; ++rr) xq[rr] = *(const uint4*)(proja + (size_t)(tok0 + w * 32 + r + rr) * 1024 + 512 + lane * 8);
#pragma unroll
        for (int rr = 0; rr < 16; ++rr) {
            const unsigned xv[4] = {xq[rr].x, xq[rr].y, xq[rr].z, xq[rr].w};
            float s_ = 0.f, q_ = 0.f;
#pragma unroll
            for (int i = 0; i < 4; ++i) { const float a = bflo(xv[i]), b2 = bfhi(xv[i]); s_ += a + b2; q_ += a * a + b2 * b2; }
            s_ = rowsum16(s_); q_ = rowsum16(q_);
            s_ += __shfl_xor(s_, 16); q_ += __shfl_xor(q_, 16); s_ += __shfl_xor(s_, 32); q_ += __shfl_xor(q_, 32);
            const float mu = s_ * (1.f / 512.f); const float var = fmaxf(q_ * (1.f / 512.f) - mu * mu, 0.f);
            if (lane == 0) stats[w * 32 + r + rr] = make_float2(mu, rsqrtf(var + 1e-5f));
        }
    }
#pragma unroll
    for (int i = 0; i < 8; ++i) { const int q = tid + 256 * i, row = q >> 4, ch = q & 15; *(uint4*)(ldsW + row * 256 + ((ch ^ (row & 15)) << 4)) = wq[i]; }
    __syncthreads();
    const float* lng = (const float*)p.in[4] + (size_t)l * 512 + g * 128;
    const float* lnb = (const float*)p.in[5] + (size_t)l * 512 + g * 128;
#pragma unroll
    for (int i = 0; i < 8; ++i) {
        const int q = tid + 256 * i, row = q >> 4, ch = q & 15;
        const uint4 x = *(const uint4*)(proja + (size_t)(tok0 + row) * 1024 + 512 + g * 128 + ch * 8);
        const float2 st = stats[row];
        const f32x4 g0 = *(const f32x4*)(lng + ch * 8), g1 = *(const f32x4*)(lng + ch * 8 + 4), b0 = *(const f32x4*)(lnb + ch * 8), b1 = *(const f32x4*)(lnb + ch * 8 + 4);
        const unsigned xv[4] = {x.x, x.y, x.z, x.w}; unsigned o[4];
#pragma unroll
        for (int k = 0; k < 4; ++k) {
            const float ga = (k < 2) ? g0[2 * k] : g1[2 * k - 4], gb = (k < 2) ? g0[2 * k + 1] : g1[2 * k - 3];
            const float ba = (k < 2) ? b0[2 * k] : b1[2 * k - 4], bb = (k < 2) ? b0[2 * k + 1] : b1[2 * k - 3];
            o[k] = pk_bf16((bflo(xv[k]) - st.x) * st.y * ga + ba, (bfhi(xv[k]) - st.x) * st.y * gb + bb);
        }
        const int f = (row & 3) | (((row >> 3) & 1) << 2);
        *(uint4*)(ldsV + row * 256 + (((ch >> 1) ^ f) << 5) + ((ch & 1) << 4)) = make_uint4(o[0], o[1], o[2], o[3]);
    }
    __syncthreads();
    uint2 uq[2][8];
#pragma unroll
    for (int t2 = 0; t2 < 2; ++t2)
#pragma unroll
        for (int ct = 0; ct < 8; ++ct) uq[t2][ct] = *(const uint2*)(proja + (size_t)(tok0 + w * 32 + t2 * 16 + fr) * 1024 + g * 128 + ct * 16 + G * 4);
    f32x4 acc[2][8];
#pragma unroll
    for (int a = 0; a < 2; ++a)
#pragma unroll
        for (int b = 0; b < 8; ++b) acc[a][b] = (f32x4){0.f, 0.f, 0.f, 0.f};
    const int qrow = (lane & 15) >> 2, pcol = lane & 3;
    for (int ss = 0; ss <= w; ++ss) {
        bf16x8 bw[2];
#pragma unroll
        for (int t2 = 0; t2 < 2; ++t2) { const int t = w * 32 + t2 * 16 + fr; bw[t2] = *(const bf16x8*)(ldsW + t * 256 + (((ss * 4 + G) ^ (t & 15)) << 4)); }
#pragma unroll
        for (int ct = 0; ct < 8; ++ct) {
            const int ra = ss * 32 + 8 * G + qrow, rb2 = ra + 4;
            const int fa = (ra & 3) | (((ra >> 3) & 1) << 2), fb = (rb2 & 3) | (((rb2 >> 3) & 1) << 2);
            const v4i16_t lo = __builtin_amdgcn_ds_read_tr16_b64_v4i16((LAS v4i16_t*)(ldsV + ra * 256 + ((ct ^ fa) << 5) + pcol * 8));
            const v4i16_t hi = __builtin_amdgcn_ds_read_tr16_b64_v4i16((LAS v4i16_t*)(ldsV + rb2 * 256 + ((ct ^ fb) << 5) + pcol * 8));
            bf16x8 af; af[0] = lo[0]; af[1] = lo[1]; af[2] = lo[2]; af[3] = lo[3]; af[4] = hi[0]; af[5] = hi[1]; af[6] = hi[2]; af[7] = hi[3];
            acc[0][ct] = MFMA16(af, bw[0], acc[0][ct]);
            acc[1][ct] = MFMA16(af, bw[1], acc[1][ct]);
        }
    }
    const float* bs = (const float*)p.in[7] + ((size_t)l * 4 + g) * 128;
#pragma unroll
    for (int t2 = 0; t2 < 2; ++t2) {
        const int t = w * 32 + t2 * 16 + fr; const float bias = bs[t];
#pragma unroll
        for (int ct = 0; ct < 8; ++ct) {
            u16* pu = proja + (size_t)(tok0 + t) * 1024 + g * 128 + ct * 16 + G * 4;
            const f32x4 uu = unpk4(uq[t2][ct]);
            f32x4 y;
#pragma unroll
            for (int q = 0; q < 4; ++q) y[q] = uu[q] * (acc[t2][ct][q] + bias);
            if (!DRY) *(uint2*)pu = pk4(y); else asm volatile("" :: "v"(y[0] + y[1] + y[2] + y[3]));
        }
    }
    __syncthreads();
}

template <bool DRY>
__device__ void attn_unit(const Params& p, int u, char* lds) {
    const int hq = u & 3, combo = (u >> 2) % 48, b = (u >> 2) / 48;
    int g, r, n, dil;
    if (combo < 16) { g = 0; r = 0; n = combo; dil = 1; } else if (combo < 32) { g = 1; r = (combo - 16) >> 2; n = (combo - 16) & 3; dil = 4; } else { g = 2; r = combo - 32; n = 0; dil = 16; }
    const int head = g * 4 + hq;
    const int tid = tid_opaque();
    const int lane = tid & 63, w = tid >> 6, fr = lane & 15, G = lane >> 4;
    u16* projb = (u16*)(p.ws + OFF_R + R_PROJB);
    char* ldsK = lds; char* ldsV = lds + 32768;
    const size_t tokb = (size_t)b * SEQ + r;
#pragma unroll
    for (int i = 0; i < 8; ++i) {
        const int q = tid + 256 * i, row = q >> 3, ch = q & 7;
        const int idx = (n - 1) * 128 + row;
        uint4 kx = make_uint4(0, 0, 0, 0), vx = kx;
        if (idx >= 0) {
            const u16* src = projb + (tokb + (size_t)idx * dil) * 2304 + head * 64 + ch * 8;
            kx = *(const uint4*)(src + 768); vx = *(const uint4*)(src + 1536);
        }
        *(uint4*)(ldsK + toff(row, ch)) = kx;
        *(uint4*)(ldsV + row * 128 + (((ch >> 1) ^ ((row >> 1) & 3)) << 5) + ((ch & 1) << 4)) = vx;
    }
    bf16x8 qf[2][2]; size_t qtok[2];
#pragma unroll
    for (int qt = 0; qt < 2; ++qt) {
        qtok[qt] = tokb + (size_t)(n * 128 + w * 32 + qt * 16 + fr) * dil;
#pragma unroll
        for (int s = 0; s < 2; ++s) qf[qt][s] = mk8(*(const uint4*)(projb + qtok[qt] * 2304 + head * 64 + s * 32 + 8 * G));
    }
    __syncthreads();
    f32x4 sc[2][10];
#pragma unroll
    for (int qt = 0; qt < 2; ++qt)
#pragma unroll
        for (int uu = 0; uu < 10; ++uu) sc[qt][uu] = (f32x4){0.f, 0.f, 0.f, 0.f};
#pragma unroll
    for (int uu = 0; uu < 10; ++uu)
#pragma unroll
        for (int s = 0; s < 2; ++s) {
            const bf16x8 kf = *(const bf16x8*)(ldsK + toff((2 * w + uu) * 16 + fr, s * 4 + G));
            sc[0][uu] = MFMA16(kf, qf[0][s], sc[0][uu]);
            sc[1][uu] = MFMA16(kf, qf[1][s], sc[1][uu]);
        }
    float mx[2], sm[2];
#pragma unroll
    for (int qt = 0; qt < 2; ++qt) {
        const int qi = w * 32 + qt * 16 + fr;
        float m = -1e30f;
#pragma unroll
        for (int uu = 0; uu < 10; ++uu)
#pragma unroll
            for (int q = 0; q < 4; ++q) {
                const int kj = (2 * w + uu) * 16 + G * 4 + q;
                const bool valid = (kj >= qi) && (kj <= qi + 128) && (n > 0 || kj >= 128);
                const float v = valid ? sc[qt][uu][q] : -1e30f;
                sc[qt][uu][q] = v; m = fmaxf(m, v);
            }
        m = fmaxf(m, __shfl_xor(m, 16)); m = fmaxf(m, __shfl_xor(m, 32));
        float s = 0.f;
#pragma unroll
        for (int uu = 0; uu < 10; ++uu)
#pragma unroll
            for (int q = 0; q < 4; ++q) { const float e = __builtin_amdgcn_exp2f(sc[qt][uu][q] - m); sc[qt][uu][q] = e; s += e; }
        s += __shfl_xor(s, 16); s += __shfl_xor(s, 32);
        mx[qt] = m; sm[qt] = s;
    }
    f32x4 oc[2][4];
#pragma unroll
    for (int qt = 0; qt < 2; ++qt)
#pragma unroll
        for (int dt = 0; dt < 4; ++dt) oc[qt][dt] = (f32x4){0.f, 0.f, 0.f, 0.f};
    const int qrow = (lane & 15) >> 2, pcol = lane & 3;
#pragma unroll
    for (int ks = 0; ks < 5; ++ks) {
        bf16x8 pf[2];
#pragma unroll
        for (int qt = 0; qt < 2; ++qt)
            pf[qt] = mk8(make_uint4(pk_bf16(sc[qt][2 * ks][0], sc[qt][2 * ks][1]), pk_bf16(sc[qt][2 * ks][2], sc[qt][2 * ks][3]),
                                    pk_bf16(sc[qt][2 * ks + 1][0], sc[qt][2 * ks + 1][1]), pk_bf16(sc[qt][2 * ks + 1][2], sc[qt][2 * ks + 1][3])));
        const int ra = (2 * w + 2 * ks) * 16 + 4 * G + qrow, rb2 = ra + 16;
#pragma unroll
        for (int dt = 0; dt < 4; ++dt) {
            const v4i16_t lo = __builtin_amdgcn_ds_read_tr16_b64_v4i16((LAS v4i16_t*)(ldsV + ra * 128 + ((dt ^ ((ra >> 1) & 3)) << 5) + pcol * 8));
            const v4i16_t hi = __builtin_amdgcn_ds_read_tr16_b64_v4i16((LAS v4i16_t*)(ldsV + rb2 * 128 + ((dt ^ ((rb2 >> 1) & 3)) << 5) + pcol * 8));
            bf16x8 vf; vf[0] = lo[0]; vf[1] = lo[1]; vf[2] = lo[2]; vf[3] = lo[3]; vf[4] = hi[0]; vf[5] = hi[1]; vf[6] = hi[2]; vf[7] = hi[3];
            oc[0][dt] = MFMA16(vf, pf[0], oc[0][dt]);
            oc[1][dt] = MFMA16(vf, pf[1], oc[1][dt]);
        }
    }
    float* lse = (float*)(p.ws + OFF_LSE);
#pragma unroll
    for (int qt = 0; qt < 2; ++qt) {
        const float inv = fast_rcp(sm[qt]);
#pragma unroll
        for (int dt = 0; dt < 4; ++dt) { if (!DRY) *(uint2*)(projb + qtok[qt] * 2304 + head * 64 + dt * 16 + G * 4) = pk4(oc[qt][dt] * inv); else asm volatile("" :: "v"(oc[qt][dt][0] + oc[qt][dt][1] + oc[qt][dt][2] + oc[qt][dt][3])); }
        if (G == 0 && !DRY) lse[((size_t)g * NTOK + qtok[qt]) * 4 + hq] = (mx[qt] + __builtin_amdgcn_logf(sm[qt])) * 0.6931471805599453f;
    }
    __syncthreads();
}

template <bool DRY>
__device__ void phase_post_yc(const Params& p, int l) {
    const int tid_ = tid_opaque();
    const int lane = tid_ & 63, j = lane & 15;
    const int gw = blockIdx.x * 4 + (tid_ >> 6), nw = gridDim.x * 4;
    const u16* yraw = (const u16*)(p.ws + OFF_YRAW); u16* gy = (u16*)(p.ws + OFF_G);
    const u16* vv = (const u16*)(p.ws + OFF_V + (size_t)l * NTOK * 1024);
    const float* bonus = (const float*)(p.ws + OFF_BONUS);
    const float* lnw = (const float*)p.in[21] + (size_t)l * 512; const float* lnb = (const float*)p.in[22] + (size_t)l * 512;
    for (int it0 = gw; it0 < NTOK * 8 / 4; it0 += 4 * nw) {
        uint2 yq[4], vq[4], gq[4]; float bq[4]; size_t offq[4]; int hq[4];
#pragma unroll
        for (int k = 0; k < 4; ++k) {
            const int it = min(it0 + k * nw, NTOK * 8 / 4 - 1);
            const int pr = it * 4 + (lane >> 4);
            const int tok = pr >> 3, hh = pr & 7;
            offq[k] = (size_t)tok * 512 + hh * 64 + j * 4; hq[k] = hh;
            yq[k] = *(const uint2*)(yraw + offq[k]); vq[k] = *(const uint2*)(vv + offq[k]); gq[k] = *(const uint2*)(gy + offq[k]); bq[k] = bonus[pr];
        }
#pragma unroll
        for (int k = 0; k < 4; ++k) {
            const f32x4 y = unpk4(yq[k]);
            const float mu = rowsum16(y[0] + y[1] + y[2] + y[3]) * (1.f / 64.f);
            const f32x4 d = y - mu;
            const float var = rowsum16(d[0] * d[0] + d[1] * d[1] + d[2] * d[2] + d[3] * d[3]) * (1.f / 64.f);
            const float rstd = rsqrtf(var + 64e-5f);
            const f32x4 w4 = *(const f32x4*)(lnw + hq[k] * 64 + j * 4), b4 = *(const f32x4*)(lnb + hq[k] * 64 + j * 4);
            const f32x4 v4 = unpk4(vq[k]), g4 = unpk4(gq[k]);
            f32x4 o;
#pragma unroll
            for (int q = 0; q < 4; ++q) o[q] = (d[q] * rstd * w4[q] + b4[q] + bq[k] * v4[q]) * g4[q];
            if (it0 + k * nw < NTOK * 8 / 4) { if (!DRY) *(uint2*)(gy + offq[k]) = pk4(o); else asm volatile("" :: "v"(o[0] + o[1] + o[2] + o[3])); }
        }
    }
}
template <bool DRY>
__device__ void phase_post(const Params& p, int l) {
    const int tid_ = tid_opaque();
    const int lane = tid_ & 63, j = lane & 15;
    const int gw = blockIdx.x * 4 + (tid_ >> 6), nw = gridDim.x * 4;
    u16* projb = (u16*)(p.ws + OFF_R + R_PROJB); const float* lse = (const float*)(p.ws + OFF_LSE);
#pragma unroll 1
    for (int it0 = gw; it0 < NTOK * 4 / 4; it0 += 4 * nw) {
        float lq[4][3]; uint2 oq[4][3]; size_t tq[4];
#pragma unroll
        for (int k = 0; k < 4; ++k) {
            const int it = min(it0 + k * nw, NTOK * 4 / 4 - 1);
            const int pr = it * 4 + (lane >> 4);
            const int tok = pr >> 2, hq = pr & 3;
            tq[k] = (size_t)tok * 2304 + hq * 64 + j * 4;
#pragma unroll
            for (int gq = 0; gq < 3; ++gq) { lq[k][gq] = lse[((size_t)gq * NTOK + tok) * 4 + hq]; oq[k][gq] = *(const uint2*)(projb + tq[k] + gq * 256); }
        }
#pragma unroll
        for (int k = 0; k < 4; ++k) {
            const float m = fmaxf(lq[k][0], fmaxf(lq[k][1], lq[k][2]));
            const float e0 = fast_exp(lq[k][0] - m), e1 = fast_exp(lq[k][1] - m), e2 = fast_exp(lq[k][2] - m); const float inv = fast_rcp(e0 + e1 + e2);
            const f32x4 o = (unpk4(oq[k][0]) * e0 + unpk4(oq[k][1]) * e1 + unpk4(oq[k][2]) * e2) * inv;
            if (it0 + k * nw < NTOK * 4 / 4) { if (!DRY) *(uint2*)(projb + tq[k] + 768) = pk4(o); else asm volatile("" :: "v"(o[0] + o[1] + o[2] + o[3])); }
        }
    }
    const uint4* hsrc = (const uint4*)(p.ws + OFF_H); uint2* h8 = (uint2*)(p.ws + OFF_YRAW);
    const int nth = gridDim.x * 256;
    for (int i0 = blockIdx.x * 256 + tid_; i0 < NTOK * 1024 / 8; i0 += 4 * nth) {
        uint4 hv[4];
#pragma unroll
        for (int k = 0; k < 4; ++k) hv[k] = hsrc[min(i0 + k * nth, NTOK * 1024 / 8 - 1)];
#pragma unroll
        for (int k = 0; k < 4; ++k) {
            const uint2 o8 = make_uint2(pk_fp8x4(bflo(hv[k].x), bfhi(hv[k].x), bflo(hv[k].y), bfhi(hv[k].y)), pk_fp8x4(bflo(hv[k].z), bfhi(hv[k].z), bflo(hv[k].w), bfhi(hv[k].w)));
            if (i0 + k * nth < NTOK * 1024 / 8) { if (!DRY) h8[i0 + k * nth] = o8; else asm volatile("" :: "v"(o8.x + o8.y)); }
        }
    }
}

__device__ void merge_unit(const Params& p, int l, int u, char* lds) {
    const int mt = u >> 3, nt = u & 7;
    const int tid = tid_opaque();
    const int lane = tid & 63, w = tid >> 6, wm = w >> 1, wn = w & 1, fr = lane & 15, fg = lane >> 4;
    const char* wne = p.ws + OFF_WNE + (size_t)l * WNE_SZ;
    const float* bgate = (const float*)p.in[31] + (size_t)l * 3072;
    u16* merged = (u16*)(p.ws + OFF_MERGED);
    uint2 tot[4][4];
#pragma unroll
    for (int i = 0; i < 4; ++i)
#pragma unroll
        for (int j = 0; j < 4; ++j) tot[i][j] = make_uint2(0u, 0u);
#pragma unroll 1
    for (int br = 0; br < 3; ++br) {
        const u16* ya; int lda, K; const u16* wb;
        if (br == 0) { ya = (const u16*)(p.ws + OFF_R + R_PROJA); lda = 1024; K = 512; wb = (const u16*)(wne + WNE_WBRA); }
        else if (br == 1) { ya = (const u16*)(p.ws + OFF_R + R_PROJB) + 768; lda = 2304; K = 256; wb = (const u16*)(wne + WNE_WBRB); }
        else { ya = (const u16*)(p.ws + OFF_G); lda = 512; K = 512; wb = (const u16*)(wne + WNE_WBRC); }
        f32x4 accg[4][4]; acc_zero<4, 4>(accg); uint2 yb[4][4];
#pragma unroll
        for (int i = 0; i < 4; ++i)
#pragma unroll
            for (int j = 0; j < 4; ++j) yb[i][j] = make_uint2(0u, 0u);
        gemm_kloop2(accg, yb, ya + (size_t)mt * 128 * lda, lda, wb + (size_t)nt * 128 * K, K, K / 64,
                    (const u16*)(p.ws + OFF_YRAW) + (size_t)mt * 128 * 512, 512, (const u16*)(wne + WNE_WGATE) + (size_t)(br * 1024 + nt * 128) * 512, 512, 8, bgate + br * 1024 + nt * 128, GATE_WSCALE, lds, tid);
#pragma unroll
        for (int i = 0; i < 4; ++i)
#pragma unroll
            for (int j = 0; j < 4; ++j) {
                const int m = mt * 128 + wm * 64 + i * 16 + fr, n = nt * 128 + wn * 64 + j * 16 + fg * 4;
                f32x4 tv = unpk4(tot[i][j]);
                const f32x4 yv = unpk4(yb[i][j]);
#pragma unroll
                for (int q = 0; q < 4; ++q) tv[q] += sigmoidf_(accg[i][j][q] * (1.f / GATE_WSCALE)) * yv[q];
                tot[i][j] = pk4(tv);
                if (br == 2) *(uint2*)(merged + (size_t)m * 1024 + n) = tot[i][j];
            }
    }
}

__device__ void outproj_unit(const Params& p, int l, int u, char* lds) {
    const int mt = u >> 3, nt = u & 7;
    const int tid = tid_opaque();
    const int lane = tid & 63, w = tid >> 6, wm = w >> 1, wn = w & 1, fr = lane & 15, fg = lane >> 4;
    RowLoader al((const u16*)(p.ws + OFF_MERGED) + (size_t)mt * 128 * 1024, 1024, tid);
    RowLoader bl((const u16*)(p.ws + OFF_WNE + (size_t)l * WNE_SZ + WNE_WOUT) + (size_t)nt * 128 * 1024, 1024, tid);
    f32x4 acc[4][4]; acc_zero<4, 4>(acc);
    gemm_kloop<4, 4>(acc, al, bl, 16, lds, tid);
    const float* xin = (l == 0) ? (const float*)p.in[0] : p.out;
#pragma unroll
    for (int i = 0; i < 4; ++i)
#pragma unroll
        for (int j = 0; j < 4; ++j) {
            const int m = mt * 128 + wm * 64 + i * 16 + fr, n = nt * 128 + wn * 64 + j * 16 + fg * 4;
            const f32x4 xo = *(const f32x4*)(xin + (size_t)m * 1024 + n);
            *(f32x4*)(p.out + (size_t)m * 1024 + n) = xo + acc[i][j];
        }
}

template <bool DRY>
__device__ void router_unit(const Params& p, int l, int u, char* lds) {
    const int tid = tid_opaque();
    const int lane = tid & 63, w = tid >> 6, fr = lane & 15, fg = lane >> 4;
    const int tok0 = u * 32;
    const float* g = (const float*)p.in[33] + (size_t)l * 1024;
    const u16* wr = (const u16*)(p.ws + OFF_WNE + (size_t)l * WNE_SZ + WNE_WR);
    uint4 bq[2][8];
#pragma unroll
    for (int j = 0; j < 2; ++j)
#pragma unroll
        for (int ks = 0; ks < 8; ++ks) bq[j][ks] = *(const uint4*)(wr + (size_t)(j * 16 + fr) * 1024 + w * 256 + ks * 32 + fg * 8);
    float4 gg[4];
#pragma unroll
    for (int i = 0; i < 4; ++i) gg[i] = ((const float4*)g)[lane + 64 * i];
    {
        float4 v[8][4]; float ss[8];
#pragma unroll
        for (int rr = 0; rr < 8; ++rr) {
            const float4* xr = (const float4*)(p.out + (size_t)(tok0 + w * 8 + rr) * 1024);
#pragma unroll
            for (int i = 0; i < 4; ++i) v[rr][i] = xr[lane + 64 * i];
        }
#pragma unroll
        for (int rr = 0; rr < 8; ++rr) {
            float s_ = 0.f;
#pragma unroll
            for (int i = 0; i < 4; ++i) s_ += v[rr][i].x * v[rr][i].x + v[rr][i].y * v[rr][i].y + v[rr][i].z * v[rr][i].z + v[rr][i].w * v[rr][i].w;
            ss[rr] = wavesum(s_);
        }
#pragma unroll
        for (int rr = 0; rr < 8; ++rr) {
            const int rl = w * 8 + rr, row = tok0 + rl;
            const float rinv = rsqrtf(ss[rr] * (1.f / 1024.f) + 1e-6f);
#pragma unroll
            for (int i = 0; i < 4; ++i) {
                const uint2 pk = make_uint2(pk_bf16(v[rr][i].x * rinv * gg[i].x, v[rr][i].y * rinv * gg[i].y), pk_bf16(v[rr][i].z * rinv * gg[i].z, v[rr][i].w * rinv * gg[i].w));
                ((unsigned*)(p.ws + OFF_H + (size_t)row * 1024))[lane + 64 * i] = pk_fp8x4(v[rr][i].x * rinv * gg[i].x, v[rr][i].y * rinv * gg[i].y, v[rr][i].z * rinv * gg[i].z, v[rr][i].w * rinv * gg[i].w);
                const int c = (lane + 64 * i) >> 1;
                *(uint2*)(lds + rl * 2048 + ((c ^ (rl & 15)) << 4) + (lane & 1) * 8) = pk;
            }
        }
    }
    __syncthreads();
    f32x4 acc[2][2]; acc_zero<2, 2>(acc);
#pragma unroll
    for (int ks = 0; ks < 8; ++ks) {
        bf16x8 af[2];
#pragma unroll
        for (int i = 0; i < 2; ++i) af[i] = *(const bf16x8*)(lds + (i * 16 + fr) * 2048 + (((w * 32 + ks * 4 + fg) ^ fr) << 4));
#pragma unroll
        for (int i = 0; i < 2; ++i)
#pragma unroll
            for (int j = 0; j < 2; ++j) acc[i][j] = MFMA16(mk8(bq[j][ks]), af[i], acc[i][j]);
    }
    __syncthreads();
    float* part = (float*)lds;
#pragma unroll
    for (int i = 0; i < 2; ++i)
#pragma unroll
        for (int j = 0; j < 2; ++j) *(f32x4*)(part + w * 1024 + (i * 16 + fr) * 32 + j * 16 + fg * 4) = acc[i][j];
    float* lg = (float*)(lds + 16384);
    int* hist = (int*)(lds + 32768); int* base = hist + 32;
    if (tid < 32) hist[tid] = 0;
    __syncthreads();
    { const f32x4 s_ = (*(const f32x4*)(part + tid * 4) + *(const f32x4*)(part + 1024 + tid * 4)) + (*(const f32x4*)(part + 2048 + tid * 4) + *(const f32x4*)(part + 3072 + tid * 4));
      *(f32x4*)(lg + tid * 4) = s_; }
    __syncthreads();
    float c_lo = 0.f, c_hi = 0.f; int c = 0, rank = 0;
    if (tid < 32) {
        const float* rgb = (const float*)p.in[35] + (size_t)l * 4; const float* reb = (const float*)p.in[37] + (size_t)l * 16;
        float gl[4]; int gi = 0;
#pragma unroll
        for (int q = 0; q < 4; ++q) { gl[q] = lg[tid * 32 + q] + rgb[q]; if (gl[q] > gl[gi]) gi = q; }
        float den = 0.f;
#pragma unroll
        for (int q = 0; q < 4; ++q) den += __expf(gl[q] - gl[gi]);
        const float gp = 1.f / den;
        float el[4];
#pragma unroll
        for (int q = 0; q < 4; ++q) {
            float v = 0.f;
#pragma unroll
            for (int gg_ = 0; gg_ < 4; ++gg_) v = (gg_ == gi) ? (lg[tid * 32 + 4 + gg_ * 4 + q] + reb[gg_ * 4 + q]) : v;
            el[q] = v;
        }
        int i1 = 0;
#pragma unroll
        for (int q = 1; q < 4; ++q) if (el[q] > el[i1]) i1 = q;
        int i2 = (i1 == 0) ? 1 : 0;
#pragma unroll
        for (int q = 0; q < 4; ++q) if (q != i1 && el[q] > el[i2]) i2 = q;
        const float w1 = 1.f / (1.f + __expf(el[i2] - el[i1])), w2 = 1.f - w1;
        const int lo = i1 < i2 ? i1 : i2, hi = i1 < i2 ? i2 : i1;
        c_lo = gp * (i1 < i2 ? w1 : w2); c_hi = gp * (i1 < i2 ? w2 : w1);
        const int pidx = (lo == 0) ? (hi - 1) : (lo == 1 ? hi + 1 : 5);
        c = gi * 6 + pidx;
        rank = atomicAdd(&hist[c], 1);
    }
    __syncthreads();
    unsigned* cnt = (unsigned*)(p.ws + OFF_CTRL) + CT_CNT + l * 32;
    if (tid < 24) base[tid] = (hist[tid] > 0 && !DRY) ? (int)atomicAdd(&cnt[tid], (unsigned)hist[tid]) : 0;
    __syncthreads();
    if (tid < 32 && !DRY) {
        const int slot = base[c] + rank;
        ((int*)(p.ws + OFF_PERM))[(size_t)c * 16384 + slot] = tok0 + tid;
        ((float2*)(p.ws + OFF_CW))[(size_t)c * 16384 + slot] = make_float2(c_lo, c_hi);
    }
    __syncthreads();
}

struct ClsInfo { int cls, rt, cnt, segrow, elo, ehi; };
__device__ __forceinline__ int moe_setup(const Params& p, int l, int* tab) {
    if (threadIdx.x == 0) {
        const unsigned* cnt = (const unsigned*)(p.ws + OFF_CTRL) + CT_CNT + l * 32;
        int tot = 0;
        for (int c = 0; c < 24; ++c) { const int n = (int)__hip_atomic_load(&cnt[c], __ATOMIC_RELAXED, __HIP_MEMORY_SCOPE_AGENT); tab[24 + c] = n; tab[c] = (n + 127) >> 7; tot += tab[c]; }
        tab[48] = tot;
    }
    __syncthreads();
    return tab[48];
}
__device__ __forceinline__ ClsInfo moe_find(const int* tab, int gt) {
    ClsInfo ci; int c = 0, seg = 0;
    while (c < 23 && gt >= tab[c]) { gt -= tab[c]; seg += tab[c]; ++c; }
    ci.cls = c; ci.rt = gt; ci.cnt = tab[24 + c]; ci.segrow = seg * 128;
    const int gi = c / 6, pi = c % 6;
    const int lo = pi < 3 ? 0 : (pi < 5 ? 1 : 2), hi = pi < 3 ? pi + 1 : (pi < 5 ? pi - 1 : 3);
    ci.elo = gi * 4 + lo; ci.ehi = gi * 4 + hi;
    return ci;
}
struct GatherLoader {
    const u16* base; int tok0, tok1, tok2, tok3;
    __device__ __forceinline__ unsigned off(int q, int row, int c) const {
        const int tk = (q == 0) ? tok0 : (q == 1 ? tok1 : (q == 2 ? tok2 : tok3));
        return (unsigned)(tk * 1024 + c * 8) * 2u;
    }
    __device__ __forceinline__ const char* ub(int kt) const { return (const char*)base + kt * 128; }
};
struct GateUpLoader {
    const u16* gsrc; const u16* usrc;
    __device__ __forceinline__ unsigned off(int q, int row, int c) const {
        const unsigned r_ = (row < 64) ? (unsigned)(row * 1024) * 2u : (unsigned)((const char*)usrc - (const char*)gsrc) + (unsigned)((row - 64) * 1024) * 2u;
        return r_ + (unsigned)c * 16u;
    }
    __device__ __forceinline__ const char* ub(int kt) const { return (const char*)gsrc + kt * 128; }
};
struct Gather8Loader {
    const char* base; int tok0, tok1, tok2, tok3;
    __device__ __forceinline__ unsigned off(int q, int row, int c) const {
        const int tk = (q == 0) ? tok0 : (q == 1 ? tok1 : (q == 2 ? tok2 : tok3));
        return (unsigned)(tk * 1024 + c * 16);
    }
    __device__ __forceinline__ const char* ub(int kt) const { return base + kt * 128; }
};
struct GateUp8Loader {
    const char* gsrc; const char* usrc;
    __device__ __forceinline__ unsigned off(int q, int row, int c) const {
        const unsigned r_ = (row < 64) ? (unsigned)(row * 1024) : (unsigned)(usrc - gsrc) + (unsigned)((row - 64) * 1024);
        return r_ + (unsigned)c * 16u;
    }
    __device__ __forceinline__ const char* ub(int kt) const { return gsrc + kt * 128; }
};
struct Down8Loader {
    const char* lo; const char* hi;
    __device__ __forceinline__ unsigned off(int q, int row, int c) const { return (unsigned)(row * 512 + c * 16); }
    __device__ __forceinline__ const char* ub(int kt) const { return ((kt < 4) ? lo : hi) + (kt & 3) * 128; }
};
struct DownLoader {
    const u16* lo; const u16* hi;
    __device__ __forceinline__ unsigned off(int q, int row, int c) const { return (unsigned)(row * 512 + c * 8) * 2u; }
    __device__ __forceinline__ const char* ub(int kt) const { return (const char*)((kt < 8) ? lo : hi) + (kt & 7) * 128; }
};
__device__ void moe_up_phase(const Params& p, int l, char* lds) {
    int* tab = (int*)(lds + LDS_BYTES - 512);
    const int ntiles = moe_setup(p, l, tab);
    const int tid = tid_opaque();
    const int lane = tid & 63, w = tid >> 6, fr = lane & 15, fg = lane >> 4;
    const char* wgate8 = wexp_base(p, l, 0); const char* wup8 = wexp_base(p, l, 1);
    const int* perm = (const int*)(p.ws + OFF_PERM); const float2* cw = (const float2*)(p.ws + OFF_CW);
    u16* hid = (u16*)(p.ws + OFF_R + R_HID);
    int tkn[4] = {0, 0, 0, 0}; float2 cwn[2]; cwn[0] = make_float2(0.f, 0.f); cwn[1] = cwn[0];
#define MU_FETCH(u_) do { if ((u_) < ntiles * 16) { const ClsInfo cj_ = moe_find(tab, (u_) >> 4); \
        const int sb_ = cj_.rt * 128 + w * 32 + ((tid & 63) >> 3), cm_ = cj_.cnt - 1; const int* pp_ = perm + (size_t)cj_.cls * 16384; \
        tkn[0] = pp_[min(sb_, cm_)]; tkn[1] = pp_[min(sb_ + 8, cm_)]; tkn[2] = pp_[min(sb_ + 16, cm_)]; tkn[3] = pp_[min(sb_ + 24, cm_)]; \
        _Pragma("unroll") for (int i_ = 0; i_ < 2; ++i_) cwn[i_] = cw[(size_t)cj_.cls * 16384 + min(cj_.rt * 128 + w * 32 + i_ * 16 + fr, cj_.cnt - 1)]; } } while (0)
    MU_FETCH((int)blockIdx.x);
    bool primed = false;
    for (int u = blockIdx.x; u < ntiles * 16; u += gridDim.x) {
        const int gt = u >> 4, nt = u & 15;
        const ClsInfo ci = moe_find(tab, gt);
        const int hc0 = nt * 64; const int e = hc0 < 512 ? ci.elo : ci.ehi; const int sel = hc0 < 512 ? 0 : 1;
        Gather8Loader al; al.base = (const char*)(p.ws + OFF_H);
        al.tok0 = tkn[0]; al.tok1 = tkn[1]; al.tok2 = tkn[2]; al.tok3 = tkn[3];
        GateUp8Loader bl{wgate8 + ((size_t)e * 512 + (hc0 & 511)) * 1024, wup8 + ((size_t)e * 512 + (hc0 & 511)) * 1024};
        f32x4 acc[2][8]; acc_zero<2, 8>(acc);
        float cwq[2];
#pragma unroll
        for (int i = 0; i < 2; ++i) cwq[i] = sel ? cwn[i].y : cwn[i].x;
        MU_FETCH(u + (int)gridDim.x);
        const int un_ = u + (int)gridDim.x; const bool hasn = un_ < ntiles * 16;
        const ClsInfo cn = moe_find(tab, hasn ? (un_ >> 4) : gt);
        const int hcn = (hasn ? (un_ & 15) : nt) * 64; const int en = hcn < 512 ? cn.elo : cn.ehi;
        Gather8Loader nal; nal.base = al.base; nal.tok0 = tkn[0]; nal.tok1 = tkn[1]; nal.tok2 = tkn[2]; nal.tok3 = tkn[3];
        GateUp8Loader nbl{wgate8 + ((size_t)en * 512 + (hcn & 511)) * 1024, wup8 + ((size_t)en * 512 + (hcn & 511)) * 1024};
        int nk8 = 8; asm volatile("" : "+s"(nk8));
        gemm_kloop<2, 8, true>(acc, al, bl, nk8, lds, tid, primed, hasn, nal, nbl); primed = hasn;
#pragma unroll
        for (int i = 0; i < 2; ++i) {
            const int slot = ci.rt * 128 + w * 32 + i * 16 + fr;
            if (slot < ci.cnt) {
                const float cwv = cwq[i];
#pragma unroll
                for (int j = 0; j < 4; ++j) {
                    f32x4 hv;
#pragma unroll
                    for (int q = 0; q < 4; ++q) { const float gq = acc[i][j][q] * (1.f / GATE_WSCALE); hv[q] = gq * sigmoidf_(gq) * (acc[i][j + 4][q] * (1.f / GATE_WSCALE)) * cwv; }
                    *(unsigned*)((char*)hid + (size_t)(ci.segrow + slot) * 1024 + hc0 + j * 16 + fg * 4) = pk_fp8x4(hv[0] * HID_SCALE, hv[1] * HID_SCALE, hv[2] * HID_SCALE, hv[3] * HID_SCALE);
                }
            }
        }
    }
}
template <bool DRY>
__device__ void moe_down_phase(const Params& p, int l, char* lds) {
    int* tab = (int*)(lds + LDS_BYTES - 512);
    const int ntiles = moe_setup(p, l, tab);
    const int tid = tid_opaque();
    const int lane = tid & 63, w = tid >> 6, wm = w >> 1, wn = w & 1, fr = lane & 15, fg = lane >> 4;
    const char* wdown = wexp_base(p, l, 2);
    const int* perm = (const int*)(p.ws + OFF_PERM);
    const u16* hid = (const u16*)(p.ws + OFF_R + R_HID);
    for (int u = blockIdx.x; u < ntiles * 8; u += gridDim.x) {
        const int gt = u >> 3, nt = u & 7;
        const ClsInfo ci = moe_find(tab, gt);
        RowLoader al(hid + (size_t)(ci.segrow + ci.rt * 128) * 512, 512, tid);
        Down8Loader bl{wdown + ((size_t)ci.elo * 1024 + nt * 128) * 512, wdown + ((size_t)ci.ehi * 1024 + nt * 128) * 512};
        f32x4 acc[4][4]; acc_zero<4, 4>(acc);
        int tkq[4];
#pragma unroll
        for (int i = 0; i < 4; ++i) tkq[i] = perm[(size_t)ci.cls * 16384 + min(ci.rt * 128 + wm * 64 + i * 16 + fr, ci.cnt - 1)];
        int nk8 = 8; asm volatile("" : "+s"(nk8));
        gemm_kloop<4, 4, true>(acc, al, bl, nk8, lds, tid);
#pragma unroll
        for (int i = 0; i < 4; ++i) {
            const int slot = ci.rt * 128 + wm * 64 + i * 16 + fr;
            if (slot < ci.cnt) {
                const int tok = tkq[i];
#pragma unroll
                for (int j = 0; j < 4; ++j) {
                    float* px = p.out + (size_t)tok * 1024 + nt * 128 + wn * 64 + j * 16 + fg * 4;
                    const f32x4 dv = acc[i][j] * (1.f / (HID_SCALE * GATE_WSCALE));
                    if (!DRY) *(f32x4*)px = *(const f32x4*)px + dv; else { const f32x4 t_ = *(const f32x4*)px + dv; asm volatile("" :: "v"(t_[0] + t_[1] + t_[2] + t_[3])); }
                }
            }
        }
    }
}

template <int S>
__device__ __forceinline__ void run_stage(const Params& p, int l, char* lds) {
    const int G = gridDim.x, bid = blockIdx.x;
    if (S == 100) { phase_conv_ne(p, lds); }
    else if (S == 101) { phase_norm<true>(p, p.out, (const float*)p.in[41]); }
    else if (S == 0) { phase_norm<false>(p, l == 0 ? (const float*)p.in[0] : p.out, (const float*)p.in[2] + (size_t)l * 1024); }
    else if (S == 1) { const int NT_ = (l == 0) ? 16 : 17, U = 128 * NT_; bool primed = false;
        for (int u = bid; u < U; u += G) { const int un = u + G; gemm2a_unit(p, l, (u & 7) * (U / 8) + (u >> 3), NT_, lds, primed, un < U ? (un & 7) * (U / 8) + (un >> 3) : -1); primed = un < U; } }
    else if (S == 2) { int hprev = -1; for (int u = bid; u < 1024; u += G) { const int uu = (u & 7) * 128 + (u >> 3); prep_unit(p, l, uu, lds, (uu & 7) != hprev); hprev = uu & 7; } }
    else if (S == 3) {
        if (bid < 64) { __builtin_amdgcn_s_setprio(3); scan_unit(p, l, bid, lds); __builtin_amdgcn_s_setprio(0); }
        unsigned* ctr = (unsigned*)(p.ws + OFF_CTRL) + CT_CNT + 64 + l;
        int* tsl = (int*)(lds + LDS_BYTES - 16);
        for (;;) {
            __syncthreads();
            if (threadIdx.x == 0) *tsl = (int)atomicAdd(ctr, 1u);
            __syncthreads();
            const int u = *tsl;
            if (u >= 128 * 26 + 768) break;
            if (u < 128 * 26) gemm2b_unit(p, l, u, lds);
            else conv_expert_run(p, l, 3072 + 4 * (u - 128 * 26), 4, 1, 6144, lds);
        }
    }
    else if (S == 33) { if (bid < 64) scan_unit(p, l, bid, lds); }
    else if (S == 34) { for (int u = bid; u < 128 * 26; u += G) gemm2b_unit(p, l, u, lds); }
    else if (S == 4) { for (int u = bid; u < 512 + 1536; u += G) { if (u < 512) mixa_unit<false>(p, l, (u & 7) * 64 + (u >> 3), lds); else attn_unit<false>(p, u - 512, lds); } phase_post_yc<false>(p, l); }
    else if (S == 44) { for (int u = bid; u < 512 + 1536; u += G) { if (u < 512) mixa_unit<true>(p, l, u, lds); else attn_unit<true>(p, u - 512, lds); } }
    else if (S == 45) { for (int u = bid; u < 512; u += G) mixa_unit<true>(p, l, u, lds); }
    else if (S == 110) { moe_down_phase<true>(p, l, lds); }
    else if (S == 5) { phase_post<false>(p, l); }
    else if (S == 55) { phase_post<true>(p, l); }
    else if (S == 6) {
        const int ncv = (3072 + G - 1) / G;
        int cv = 0, mu = bid;
        auto conv_some = [&](int n) { const int c = min(n, ncv - cv); if (c > 0) { conv_expert_run(p, l, bid + cv * G, c, G, 3072, lds); cv += c; } };
        if (bid & 1) conv_some(ncv / 2);
        for (; mu < 1024; mu += G) { merge_unit(p, l, (mu & 7) * 128 + (mu >> 3), lds); conv_some(ncv / 2); }
        conv_some(ncv);
    }
    else if (S == 66) { for (int mu = bid; mu < 1024; mu += G) merge_unit(p, l, (mu & 7) * 128 + (mu >> 3), lds); }
    else if (S == 67) { const int ncv = (6144 + G - 1) / G; conv_expert_run(p, l, bid, ncv, G, 6144, lds); }
    else if (S == 7) { for (int u = bid; u < 1024; u += G) outproj_unit(p, l, (u & 7) * 128 + (u >> 3), lds); }
    else if (S == 8) { for (int u = bid; u < 512; u += G) router_unit<false>(p, l, u, lds); }
    else if (S == 88) { for (int u = bid; u < 512; u += G) router_unit<true>(p, l, u, lds); }
    else if (S == 9) { moe_up_phase(p, l, lds); if (l == 0) { const int nt_ = ((const int*)(lds + LDS_BYTES - 512))[48]; __syncthreads(); ne_tail_fill(p, nt_ * 16, 0, NE_Q1, lds); } }
    else if (S == 10) { moe_down_phase<false>(p, l, lds); if (l == 0) { const int nt_ = ((const int*)(lds + LDS_BYTES - 512))[48]; __syncthreads(); ne_tail_fill(p, nt_ * 8, NE_Q1, NE_Q2, lds); } }
}

template <int S>
__global__ void __launch_bounds__(256, 2) stage_kernel(Params p, int l) {
    __shared__ __attribute__((aligned(16))) char lds[LDS_BYTES + 16];
    run_stage<S>(p, l, lds);
}

#if MK_FUSED
__global__ void __launch_bounds__(256, 2) mega_kernel(Params p) {
    __shared__ __attribute__((aligned(16))) char lds[LDS_BYTES + 16];
    volatile LAS unsigned* st = (volatile LAS unsigned*)(lds + LDS_BYTES);
    if (threadIdx.x == 0) { st[0] = 0u; st[1] = 0u; st[2] = 0u; st[3] = 0u; }
    __syncthreads();
    XcdBarrier xb = xcd_barrier_post((unsigned*)(p.ws + OFF_CTRL), st);
#if TIMING_PHASE >= 0
    unsigned long long t_start = __builtin_amdgcn_s_memrealtime(), t_sel = 0; int t_k = 0;
#define XBAR() do { xcd_barrier(xb); if (t_k == TIMING_PHASE) t_sel = __builtin_amdgcn_s_memrealtime() - t_start; ++t_k; } while (0)
#else
#define XBAR() xcd_barrier(xb)
#endif
    run_stage<100>(p, 0, lds); run_stage<0>(p, 0, lds); XBAR();
    if (DUP_STAGE == 999) { for (int i_ = 0; i_ < 20; ++i_) XBAR(); }
    if (DUP_STAGE == 100) { run_stage<100>(p, 0, lds); XBAR(); }
#define MK_ST(S, l) run_stage<S>(p, l, lds); XBAR(); if (DUP_STAGE == S && !(S == 7 && l == 1)) { run_stage<S>(p, l, lds); XBAR(); } if (S == 4 && DUP_STAGE == 44) { run_stage<44>(p, l, lds); XBAR(); } if (S == 4 && DUP_STAGE == 45) { run_stage<45>(p, l, lds); XBAR(); } if (S == 10 && DUP_STAGE == 110) { run_stage<110>(p, l, lds); XBAR(); } if (S == 5 && DUP_STAGE == 55) { run_stage<55>(p, l, lds); XBAR(); } if (S == 8 && DUP_STAGE == 88) { run_stage<88>(p, l, lds); XBAR(); } if (S == 3 && DUP_STAGE == 33) { run_stage<33>(p, l, lds); XBAR(); } if (S == 3 && DUP_STAGE == 34) { run_stage<34>(p, l, lds); XBAR(); } if (S == 6 && DUP_STAGE == 66) { run_stage<66>(p, l, lds); XBAR(); } if (S == 6 && DUP_STAGE == 67) { run_stage<67>(p, l, lds); XBAR(); }
#define MK_ST0(l) if (l != 0) { MK_ST(0, l) }
#define MK_LAYER(l) MK_ST0(l) MK_ST(1, l) MK_ST(2, l) MK_ST(3, l) MK_ST(4, l) MK_ST(5, l) MK_ST(6, l) MK_ST(7, l) MK_ST(8, l) MK_ST(9, l) MK_ST(10, l)
    MK_LAYER(0)
    MK_LAYER(1)
    run_stage<101>(p, 0, lds);
#if TIMING_PHASE >= 0
    if (blockIdx.x == 0 && threadIdx.x == 0) { asm volatile("s_waitcnt vmcnt(0)" ::: "memory"); p.out[0] = (float)t_sel * 0.01f; }
#endif
}
#endif

#ifndef DBG
#define DBG 0
#endif
__global__ void dump_kernel(const u16* src, size_t stride, int width, float* out) {
    const size_t i = (size_t)blockIdx.x * 256 + threadIdx.x;
    const size_t tok = i >> 10; const int c = (int)(i & 1023);
    out[i] = bf2f(src[tok * stride + (c % width)]);
}
#define DUMP(off, stride, width) dump_kernel<<<dim3(NTOK * 1024 / 256), dim3(256), 0, stream>>>((const u16*)((char*)d_ws + (off)), stride, width, (float*)d_out)
#define LAUNCH_STAGE(S, l) stage_kernel<S><<<dim3(grid_blocks), dim3(256), 0, stream>>>(p, l)
extern "C" void kernel_launch(void* const* d_in, const int* in_sizes, int n_in, void* d_out, int out_size, void* d_ws, size_t ws_size, hipStream_t stream) {
    static int grid_blocks = 0;
    if (!grid_blocks) {
        int dev = 0, cus = 0, per_cu = 2;
        (void)hipGetDevice(&dev);
        (void)hipDeviceGetAttribute(&cus, hipDeviceAttributeMultiprocessorCount, dev);
#if MK_FUSED
        (void)hipOccupancyMaxActiveBlocksPerMultiprocessor(&per_cu, mega_kernel, 256, 0);
        if (per_cu > 2) per_cu = 2;
        if (per_cu < 1) per_cu = 1;
#endif
        if (cus <= 0) cus = 256;
        grid_blocks = cus * per_cu;
    }
    if (ws_size < OFF_END || n_in < 42) { fprintf(stderr, "workspace too small or bad inputs\n"); return; }
    Params p{};
    for (int i = 0; i < 42; ++i) p.in[i] = d_in[i];
    p.out = (float*)d_out; p.ws = (char*)d_ws;
    (void)hipMemsetAsync(d_ws, 0, 65536, stream);
#if MK_FUSED
    void* args[] = {&p};
    hipError_t e = hipLaunchCooperativeKernel((void*)mega_kernel, dim3(grid_blocks), dim3(256), args, 0, stream);
    if (e != hipSuccess) fprintf(stderr, "cooperative launch failed: %s (grid %d)\n", hipGetErrorString(e), grid_blocks);
#else
    LAUNCH_STAGE(100, 0);
    for (int l = 0; l < 2; ++l) {
        LAUNCH_STAGE(0, l); LAUNCH_STAGE(1, l);
        if (DBG == 1) { DUMP(OFF_R + R_PROJC, 1536, 1024); return; }
        LAUNCH_STAGE(2, l);
        if (DBG == 2) { DUMP(OFF_KR, 1024, 1024); return; }
        LAUNCH_STAGE(3, l);
        if (DBG == 3) { DUMP(OFF_YRAW, 512, 512); return; }
        if (DBG == 4) { DUMP(OFF_R + R_PROJB, 2304, 1024); return; }
        LAUNCH_STAGE(4, l);
        if (DBG == 5) { DUMP(OFF_R + R_PROJB, 2304, 1024); return; }
        if (DBG == 6) { DUMP(OFF_R + R_PROJA, 1024, 512); return; }
        LAUNCH_STAGE(5, l);
        if (DBG == 10) { DUMP(OFF_G, 512, 512); return; }
        if (DBG == 11) { DUMP(OFF_R + R_PROJB + 768 * 2, 2304, 256); return; }
        LAUNCH_STAGE(6, l);
        if (DBG == 7) { DUMP(OFF_MERGED, 1024, 1024); return; }
        LAUNCH_STAGE(7, l);
        if (DBG == 8) return;
        LAUNCH_STAGE(8, l); LAUNCH_STAGE(9, l); LAUNCH_STAGE(10, l);
        if (DBG == 9) return;
    }
    LAUNCH_STAGE(101, 0);
#endif
}
```
